# Optimizing an MI355X kernel written in HIP

```python
import math
import jax, jax.numpy as jnp
from jax import lax
import numpy as np

D_MODEL = 1024
BATCH = 2
SEQ = 8192
DEPTH = 2

GRID_W = 64
CTX_LEN = 256
N_EVEN = (DEPTH + 1) // 2
N_ODD = DEPTH // 2
D_FF = -(-8 * D_MODEL // (3 * 256)) * 256
RMS_EPS = 1e-6
FOURIER_CH = D_MODEL // 2
FOURIER_GROUPS = 4
FOURIER_GDIM = FOURIER_CH // FOURIER_GROUPS
HY_CH = D_MODEL - FOURIER_CH
HY_ORDER = 2
HY_SHORT = 3
HY_BANDS = 16
HY_EMB = 1 + 2 * HY_BANDS
HY_FILTER_HID = 64
HY_FAST_DECAY = 0.3
HY_SLOW_DECAY = 1.5
HY_DECAY_TARGET = 1e-2
AB_IN = FOURIER_CH + (HY_ORDER + 1) * HY_CH
NA_HEADS = 16
NA_HEAD_DIM = D_MODEL // NA_HEADS
NA_KH_MAX = 8
NA_KW = 16
NA_QCOLS = NA_KW
NA_KCOLS = 2 * NA_KW

kernel_name = "hybrid_fnet_hyena_natten_dit"


def rms_norm(x, g):
    x32 = x.astype(jnp.float32)
    y = x32 * lax.rsqrt(jnp.mean(x32 * x32, axis=-1, keepdims=True) + RMS_EPS)
    return (y * g.astype(jnp.float32)).astype(x.dtype)


def ada_mod(cond, w, b):
    m = (jax.nn.silu(cond) @ w + b)[..., None, :]
    return jnp.split(m, 6, axis=-1)


def modulate(h, shift, scale):
    return h * (1.0 + scale) + shift


def swiglu(u, w_gate, w_up, w_down):
    return (jax.nn.silu(u @ w_gate) * (u @ w_up)) @ w_down


def fourier_mix(p):
    B_, L, _ = p.shape
    g = p.astype(jnp.float32).reshape(B_, L, FOURIER_GROUPS, FOURIER_GDIM).transpose(0, 2, 1, 3)
    f = jnp.fft.fft2(g, norm="ortho").real
    return f.transpose(0, 2, 1, 3).reshape(B_, L, FOURIER_CH).astype(p.dtype)


def short_conv(u, w, b):
    K, C = w.shape
    pad = K // 2
    y = lax.conv_general_dilated(u, w[:, None, :].astype(u.dtype), (1,), [(pad, K - 1 - pad)],
                                 dimension_numbers=("NWC", "WIO", "NWC"), feature_group_count=C)
    return y + b.astype(u.dtype)


def hyena_filters(L, w1, b1, freq, w2, b2, w3):
    f32 = jnp.float32
    w1, b1, freq, w2, b2, w3 = (a.astype(f32) for a in (w1, b1, freq, w2, b2, w3))
    t01 = jnp.linspace(0.0, 1.0, L, dtype=f32)[:, None]
    bands = jnp.linspace(1e-4, HY_BANDS - 1, HY_BANDS, dtype=f32)[None, :]
    ang = (2.0 * math.pi / L) * jnp.arange(L, dtype=f32)[:, None] * bands
    z = jnp.concatenate([t01, jnp.cos(ang), -jnp.sin(ang)], axis=-1)
    h = jnp.sin(freq * (z @ w1 + b1))
    h = jnp.sin(freq * (h @ w2 + b2))
    h = (h @ w3).reshape(L, 2, HY_ORDER, HY_CH)
    max_decay = math.log(HY_DECAY_TARGET) / HY_FAST_DECAY
    min_decay = math.log(HY_DECAY_TARGET) / HY_SLOW_DECAY
    deltas = jnp.abs(jnp.linspace(min_decay, max_decay, HY_CH, dtype=f32))
    h = h * jnp.exp(-t01 * deltas)[:, None, None, :]
    h = h / jnp.sum(jnp.abs(h), axis=(0, 1), keepdims=True)
    fwd, bwd = h[:, 0], h[:, 1]
    return jnp.concatenate([fwd, jnp.zeros_like(fwd[:1]), bwd[:0:-1]], axis=0)


def long_conv(u, filt, skip):
    L = u.shape[1]
    uf = jnp.fft.rfft(u, n=2 * L, axis=1)
    ff = jnp.fft.rfft(filt, n=2 * L, axis=0)
    y = jnp.fft.irfft(uf * ff[None], n=2 * L, axis=1)[:, :L]
    return y + u * skip


def hyena_mix(p, conv_w, conv_b, w1, b1, freq, w2, b2, w3, skip):
    L = p.shape[1]
    z = short_conv(p, conv_w, conv_b).astype(jnp.float32)
    x1, x2, v = jnp.split(z, 3, axis=-1)
    filt = hyena_filters(L, w1, b1, freq, w2, b2, w3)
    skip = skip.astype(jnp.float32)
    v = x1 * long_conv(v, filt[:, 0], skip[0])
    v = x2 * long_conv(v, filt[:, 1], skip[1])
    return v.astype(p.dtype)


def mixer_ab(u, w_in, w_out, conv_w, conv_b, w1, b1, freq, w2, b2, w3, skip):
    p = u @ w_in
    y_f = fourier_mix(p[..., :FOURIER_CH])
    y_h = hyena_mix(p[..., FOURIER_CH:], conv_w, conv_b, w1, b1, freq, w2, b2, w3, skip)
    return jnp.concatenate([y_f, y_h], axis=-1) @ w_out


def dense_attention(q, k, v):
    s = jnp.einsum("bqhd,bkhd->bhqk", q, k).astype(jnp.float32) * (q.shape[-1] ** -0.5)
    p = jax.nn.softmax(s, axis=-1).astype(v.dtype)
    return jnp.einsum("bhqk,bkhd->bqhd", p, v)


def neighbourhood_attention(q, k, v, kc, vc, rpb):
    B_, L, H, dh = q.shape
    rows = L // GRID_W
    kh = min(NA_KH_MAX, rows)
    scale = dh ** -0.5
    n_chunk = GRID_W // NA_QCOLS
    qcol = np.arange(GRID_W).reshape(n_chunk, NA_QCOLS)
    kstart = np.clip(qcol[:, 0] - NA_KW // 2, 0, GRID_W - NA_KCOLS)
    kcol = kstart[:, None] + np.arange(NA_KCOLS)
    wstart = np.clip(qcol - NA_KW // 2, 0, GRID_W - NA_KW)
    col_ok = (kcol[:, None, :] >= wstart[:, :, None]) & (kcol[:, None, :] < wstart[:, :, None] + NA_KW)
    dc = np.clip(kcol[:, None, :] - qcol[:, :, None] + NA_KW - 1, 0, 2 * NA_KW - 2)
    qg = q.reshape(B_, rows, GRID_W, H, dh)
    kg = k.reshape(B_, rows, GRID_W, H, dh)
    vg = v.reshape(B_, rows, GRID_W, H, dh)
    n_loc = kh * NA_KCOLS

    def row_block(r):
        rs = jnp.clip(r - kh // 2, 0, rows - kh)
        q_r = lax.dynamic_index_in_dim(qg, r, axis=1, keepdims=False).reshape(B_, n_chunk, NA_QCOLS, H, dh)
        k_b = lax.dynamic_slice_in_dim(kg, rs, kh, axis=1)[:, :, kcol]
        v_b = lax.dynamic_slice_in_dim(vg, rs, kh, axis=1)[:, :, kcol]
        dr = rs + jnp.arange(kh) - r + (NA_KH_MAX - 1)
        bias = rpb[:, dr[None, None, :, None], dc[:, :, None, :]].astype(jnp.float32)
        s_loc = jnp.einsum("bcqhd,bicjhd->bhcqij", q_r, k_b).astype(jnp.float32) * scale + bias[None]
        s_loc = jnp.where(col_ok[:, :, None, :], s_loc, -jnp.inf)
        s_ctx = jnp.einsum("bcqhd,bjhd->bhcqj", q_r, kc).astype(jnp.float32) * scale
        s = jnp.concatenate([s_loc.reshape(B_, H, n_chunk, NA_QCOLS, n_loc), s_ctx], axis=-1)
        p = jax.nn.softmax(s, axis=-1).astype(v.dtype)
        p_loc = p[..., :n_loc].reshape(B_, H, n_chunk, NA_QCOLS, kh, NA_KCOLS)
        o = (jnp.einsum("bhcqij,bicjhd->bcqhd", p_loc, v_b)
             + jnp.einsum("bhcqj,bjhd->bcqhd", p[..., n_loc:], vc))
        return o.reshape(B_, GRID_W, H, dh)

    out = lax.map(row_block, jnp.arange(rows))
    return out.transpose(1, 0, 2, 3, 4).reshape(B_, L, H, dh)


def mixer_na(u_lat, u_ctx, w_qkv, w_out, rpb, with_ctx_out):
    B_, L, _ = u_lat.shape
    heads = lambda t: t.reshape(t.shape[0], t.shape[1], NA_HEADS, NA_HEAD_DIM)
    q, k, v = (heads(t) for t in jnp.split(u_lat @ w_qkv, 3, axis=-1))
    kc, vc = (heads(t) for t in jnp.split(u_ctx @ w_qkv[:, D_MODEL:], 2, axis=-1))
    y_lat = neighbourhood_attention(q, k, v, kc, vc, rpb).reshape(B_, L, D_MODEL) @ w_out
    if not with_ctx_out:
        return y_lat, None
    qc = heads(u_ctx @ w_qkv[:, :D_MODEL])
    y_ctx = dense_attention(qc, kc, vc).reshape(u_ctx.shape) @ w_out
    return y_lat, y_ctx


def setup_inputs(seed: int = 0) -> dict:
    key = jax.random.key(seed)
    ks = jax.random.split(key, 26)
    D = D_MODEL

    def nrm(k, shape, s):
        return jax.random.normal(k, shape, jnp.float32) * s

    return {
        "x": nrm(ks[0], (BATCH, SEQ, D), 1.0),
        "c": nrm(ks[1], (BATCH, D), 1.0),
        "ctx": nrm(ks[2], (BATCH, CTX_LEN, D), 1.0),
        "c_ctx": nrm(ks[3], (D,), 1.0),
        "ada_w": nrm(ks[4], (DEPTH, D, 6 * D), 0.5 * D ** -0.5),
        "ada_b": nrm(ks[5], (DEPTH, 6 * D), 0.02),
        "norm1_g": 1.0 + nrm(ks[6], (DEPTH, D), 0.02),
        "norm2_g": 1.0 + nrm(ks[7], (DEPTH, D), 0.02),
        "ffn_w_gate": nrm(ks[8], (DEPTH, D, D_FF), D ** -0.5),
        "ffn_w_up": nrm(ks[9], (DEPTH, D, D_FF), D ** -0.5),
        "ffn_w_down": nrm(ks[10], (DEPTH, D_FF, D), D_FF ** -0.5),
        "ab_w_in": nrm(ks[11], (N_EVEN, D, AB_IN), D ** -0.5),
        "ab_w_out": nrm(ks[12], (N_EVEN, FOURIER_CH + HY_CH, D), D ** -0.5),
        "hy_conv_w": nrm(ks[13], (N_EVEN, HY_SHORT, (HY_ORDER + 1) * HY_CH), HY_SHORT ** -0.5),
        "hy_conv_b": nrm(ks[14], (N_EVEN, (HY_ORDER + 1) * HY_CH), 0.02),
        "hy_f_w1": nrm(ks[15], (N_EVEN, HY_EMB, HY_FILTER_HID), HY_EMB ** -0.5),
        "hy_f_b1": nrm(ks[16], (N_EVEN, HY_FILTER_HID), 0.02),
        "hy_f_freq": 1.0 + nrm(ks[17], (N_EVEN, HY_FILTER_HID), 0.02),
        "hy_f_w2": nrm(ks[18], (N_EVEN, HY_FILTER_HID, HY_FILTER_HID), HY_FILTER_HID ** -0.5),
        "hy_f_b2": nrm(ks[19], (N_EVEN, HY_FILTER_HID), 0.02),
        "hy_f_w3": nrm(ks[20], (N_EVEN, HY_FILTER_HID, 2 * HY_ORDER * HY_CH), HY_FILTER_HID ** -0.5),
        "hy_bias": nrm(ks[21], (N_EVEN, HY_ORDER, HY_CH), 0.5),
        "na_w_qkv": nrm(ks[22], (N_ODD, D, 3 * D), D ** -0.5),
        "na_w_out": nrm(ks[23], (N_ODD, D, D), D ** -0.5),
        "na_rpb": nrm(ks[24], (N_ODD, NA_HEADS, 2 * NA_KH_MAX - 1, 2 * NA_KW - 1), 0.1),
        "final_g": 1.0 + nrm(ks[25], (D,), 0.02),
    }


def reference(x, c, ctx, c_ctx, ada_w, ada_b, norm1_g, norm2_g, ffn_w_gate, ffn_w_up, ffn_w_down,
              ab_w_in, ab_w_out, hy_conv_w, hy_conv_b, hy_f_w1, hy_f_b1, hy_f_freq, hy_f_w2, hy_f_b2,
              hy_f_w3, hy_bias, na_w_qkv, na_w_out, na_rpb, final_g):
    h_lat, h_ctx = x, ctx
    for i in range(DEPTH):
        last = i == DEPTH - 1
        even = i % 2 == 0
        j = i // 2
        need_ctx = (not last) or (not even)
        sh1, sc1, g1, sh2, sc2, g2 = ada_mod(c, ada_w[i], ada_b[i])
        u_lat = modulate(rms_norm(h_lat, norm1_g[i]), sh1, sc1)
        if need_ctx:
            csh1, csc1, cg1, csh2, csc2, cg2 = ada_mod(c_ctx, ada_w[i], ada_b[i])
            u_ctx = modulate(rms_norm(h_ctx, norm1_g[i]), csh1, csc1)
        if even:
            ab = (ab_w_in[j], ab_w_out[j], hy_conv_w[j], hy_conv_b[j], hy_f_w1[j], hy_f_b1[j],
                  hy_f_freq[j], hy_f_w2[j], hy_f_b2[j], hy_f_w3[j], hy_bias[j])
            y_lat = mixer_ab(u_lat, *ab)
            y_ctx = None if last else mixer_ab(u_ctx, *ab)
        else:
            y_lat, y_ctx = mixer_na(u_lat, u_ctx, na_w_qkv[j], na_w_out[j], na_rpb[j], not last)
        h_lat = h_lat + g1 * y_lat
        h_lat = h_lat + g2 * swiglu(modulate(rms_norm(h_lat, norm2_g[i]), sh2, sc2),
                                    ffn_w_gate[i], ffn_w_up[i], ffn_w_down[i])
        if not last:
            h_ctx = h_ctx + cg1 * y_ctx
            h_ctx = h_ctx + cg2 * swiglu(modulate(rms_norm(h_ctx, norm2_g[i]), csh2, csc2),
                                         ffn_w_gate[i], ffn_w_up[i], ffn_w_down[i])
    return rms_norm(h_lat, final_g)
```

```cpp
#include <hip/hip_runtime.h>
#include <cstdio>
#include <cstdint>

#ifndef MK_PER_PHASE
#define MK_PER_PHASE 0
#endif

#define LAS __attribute__((address_space(3)))
#define GAS __attribute__((address_space(1)))
typedef _Float16 f16;
typedef _Float16 f16x8 __attribute__((ext_vector_type(8)));
typedef _Float16 f16x4 __attribute__((ext_vector_type(4)));
typedef _Float16 f16x2 __attribute__((ext_vector_type(2)));
typedef float f32x4 __attribute__((ext_vector_type(4)));
typedef float f32x2 __attribute__((ext_vector_type(2)));
typedef unsigned u32x4 __attribute__((ext_vector_type(4)));
typedef unsigned u32x2 __attribute__((ext_vector_type(2)));
typedef unsigned short u16;

__device__ __forceinline__ unsigned pkh(float lo, float hi) { f16x2 v = {(f16)lo, (f16)hi}; return __builtin_bit_cast(unsigned, v); }
__device__ __forceinline__ float h2f(u16 b) { return (float)__builtin_bit_cast(f16, b); }

constexpr int DM = 1024, BATCH = 2, SEQ = 8192, CTXL = 256, DFF = 2816;
constexpr int MLAT = BATCH * SEQ;
constexpr int MCTX = BATCH * CTXL;
constexpr int MALL = MLAT + MCTX;
constexpr int NHEAD = 16, HD = 64;
constexpr int FILT_T = SEQ + CTXL;
constexpr float RMS_EPS = 1e-6f;
constexpr float LOG2E = 1.4426950408889634f;

namespace pg8 {
constexpr int BM = 256, BK = 64, HALF = 128, HTB = HALF * BK * 2, STAGE_BYTES = 8 * HTB, NXCD = 8, WGM = 8;
__host__ __device__ __forceinline__ int lds_byte(int r, int c) { const int st = (r >> 4) * 2 + (c >> 5), rr = r & 15, cc = c & 31, ob = rr * 64 + cc * 2; return st * 1024 + (ob ^ (((ob >> 9) & 1) << 5)); }
__host__ __device__ __forceinline__ void stage_rc(int b, int& R, int& C) { const int st = b / 1024, sb = b % 1024, swz = sb ^ (((sb >> 9) & 1) << 5); R = (st >> 1) * 16 + swz / 64; C = (st & 1) * 32 + (swz % 64) / 2; }

struct Unit { int pm, pn; };
struct Gemm { const f16* A; const f16* Bt; int M, N, K; };

struct StaticOrder {
    int nM, nN, nwg, G, c;
    __device__ void init(int M, int N, int G_, int c_) { nM = M / BM; nN = N / BM; nwg = nM * nN; G = G_; c = c_; }
    __device__ bool next(int i, Unit& u) const {
        const long L = (long)i * G + c; if (L >= nwg) return false;
        int wgid = (int)L; { const int q = nwg / NXCD, r = nwg % NXCD, xcd = wgid % NXCD, off = wgid / NXCD; wgid = (xcd < r ? xcd * (q + 1) : r * (q + 1) + (xcd - r) * q) + off; }
        const int nig = WGM * nN, gid = wgid / nig, fm = gid * WGM, gsz = (nM - fm) < WGM ? (nM - fm) : WGM;
        u.pm = fm + ((wgid % nig) % gsz); u.pn = (wgid % nig) / gsz; return true;
    }
};
struct QkvOrder {
    int G, c;
    __device__ bool next(int i, Unit& u) const {
        const long L = (long)i * G + c; if (L >= 784) return false;
        if (L >= 768) { const int r = (int)L - 768; u.pm = 64 + (r & 1); u.pn = 4 + (r >> 1); return true; }
        int wgid = (int)L; { const int q = 768 / NXCD, xcd = wgid % NXCD, off = wgid / NXCD; wgid = xcd * q + off; }
        const int nig = WGM * 12, gid = wgid / nig, fm = gid * WGM;
        u.pm = fm + ((wgid % nig) % WGM); u.pn = (wgid % nig) / WGM; return true;
    }
};

template <class Epi, class Sched, bool SWAP>
__device__ __forceinline__ void gemm_phase(LAS unsigned char* lds, const Gemm g, const Sched& S, const Epi& E) {
    int tid = threadIdx.x; asm volatile("" : "+v"(tid));
    const int wid = __builtin_amdgcn_readfirstlane(tid >> 6), lane = tid & 63, wr = wid >> 2, wc = wid & 3, fr = lane & 15, fq = lane >> 4;
    const int K = g.K, nt = K / BK;
    unsigned voffA[2];
#pragma unroll
    for (int i = 0; i < 2; ++i) { int R, C; stage_rc(tid * 16 + i * 8192, R, C); voffA[i] = (unsigned)(R * K + C) * 2u; }
    const size_t kstep = (size_t)(BK * 2);
    const size_t hstep = (size_t)HALF * K * 2;
    const size_t tstep = 2 * hstep;
    const unsigned ldsw = (unsigned)wid * 1024u;
    const int aoff = lds_byte(wr * 64 + fr, fq * 8), boff = lds_byte(wc * 32 + fr, fq * 8);
#define PG8_SA(b, h) (((b) * 2 + (h)) * HTB)
#define PG8_SB(b, h) ((4 + (b) * 2 + (h)) * HTB)
#define PG8_STAGE(bufoff, gbase) do { _Pragma("unroll") for (int _i = 0; _i < 2; ++_i) \
        __builtin_amdgcn_global_load_lds((const unsigned*)((const char*)(gbase) + voffA[_i]), (LAS unsigned*)(lds + (bufoff) + ldsw + _i * 8192), 16, 0, 0); } while (0)
#define PG8_LDA(dst, b, h) do { _Pragma("unroll") for (int m = 0; m < 4; ++m) _Pragma("unroll") for (int k = 0; k < 2; ++k) dst[m][k] = *(const LAS f16x8*)(lds + PG8_SA(b, h) + aoff + m * 2048 + k * 1024); } while (0)
#define PG8_LDB(dst, b, h) do { _Pragma("unroll") for (int n = 0; n < 2; ++n) _Pragma("unroll") for (int k = 0; k < 2; ++k) dst[n][k] = *(const LAS f16x8*)(lds + PG8_SB(b, h) + boff + n * 2048 + k * 1024); } while (0)
#define PG8_MMA(ai, bj, At, Bt) do { __builtin_amdgcn_s_setprio(1); _Pragma("unroll") for (int m = 0; m < 4; ++m) _Pragma("unroll") for (int n = 0; n < 2; ++n) _Pragma("unroll") for (int k = 0; k < 2; ++k) \
        acc[ai][bj][m][n] = SWAP ? __builtin_amdgcn_mfma_f32_16x16x32_f16(At[m][k], Bt[n][k], acc[ai][bj][m][n], 0, 0, 0) \
                                 : __builtin_amdgcn_mfma_f32_16x16x32_f16(Bt[n][k], At[m][k], acc[ai][bj][m][n], 0, 0, 0); __builtin_amdgcn_s_setprio(0); } while (0)
#define PG8_WAIT_V(n) asm volatile("s_waitcnt vmcnt(" #n ")" ::: "memory")
#define PG8_WAIT_L(n) asm volatile("s_waitcnt lgkmcnt(" #n ")" ::: "memory")
#define PG8_BAR __builtin_amdgcn_s_barrier()
#define PG8_SCHED __builtin_amdgcn_sched_barrier(0)
    Unit cur, nxt; int ui = 0;
    if (!S.next(0, cur)) return;
    f32x4 acc[2][2][4][2];
#pragma unroll
    for (int a = 0; a < 2; ++a)
#pragma unroll
        for (int b = 0; b < 2; ++b)
#pragma unroll
            for (int m = 0; m < 4; ++m)
#pragma unroll
                for (int n = 0; n < 2; ++n) acc[a][b][m][n] = (f32x4){0.f, 0.f, 0.f, 0.f};
    f16x8 At[4][2], B0[2][2], B1[2][2];
    const char* cA = (const char*)g.A + (size_t)cur.pm * tstep; const char* cB = (const char*)g.Bt + (size_t)cur.pn * tstep;
    PG8_STAGE(PG8_SB(0, 0), cB); PG8_STAGE(PG8_SB(0, 1), cB + hstep); PG8_STAGE(PG8_SA(0, 0), cA); PG8_STAGE(PG8_SA(0, 1), cA + hstep);
    if (wr == 1) PG8_BAR;
    PG8_WAIT_V(2); PG8_BAR;
    PG8_STAGE(PG8_SB(1, 0), cB + kstep); PG8_STAGE(PG8_SA(1, 0), cA + kstep); PG8_STAGE(PG8_SB(1, 1), cB + hstep + kstep);
    PG8_WAIT_V(6); PG8_BAR;
    for (;;) {
        const bool has_next = S.next(ui + 1, nxt);
        const char* nA = has_next ? (const char*)g.A + (size_t)nxt.pm * tstep : cA; const char* nB = has_next ? (const char*)g.Bt + (size_t)nxt.pn * tstep : cB;
        for (int t = 0; t < nt; t += 2) {
            const bool last = (t == nt - 2);
            const char* a1 = cA + (size_t)(t + 1) * kstep;
            const char* a2 = last ? nA : cA + (size_t)(t + 2) * kstep; const char* b2 = last ? nB : cB + (size_t)(t + 2) * kstep;
            const char* a3 = a2 + kstep; const char* b3 = b2 + kstep;
            PG8_LDB(B0, 0, 0); PG8_LDB(B1, 0, 1); PG8_SCHED; PG8_LDA(At, 0, 0); PG8_STAGE(PG8_SA(1, 1), a1 + hstep);
            PG8_WAIT_V(8); PG8_WAIT_L(0); PG8_BAR; PG8_MMA(0, 0, At, B0); PG8_MMA(0, 1, At, B1); PG8_BAR; PG8_SCHED;
            PG8_LDA(At, 0, 1); PG8_STAGE(PG8_SB(0, 0), b2); PG8_STAGE(PG8_SB(0, 1), b2 + hstep); PG8_STAGE(PG8_SA(0, 0), a2);
            PG8_WAIT_V(8); PG8_WAIT_L(0); PG8_BAR; PG8_MMA(1, 0, At, B0); PG8_MMA(1, 1, At, B1); PG8_BAR; PG8_SCHED;
            PG8_LDB(B0, 1, 0); PG8_LDB(B1, 1, 1); PG8_SCHED; PG8_LDA(At, 1, 0); PG8_STAGE(PG8_SA(0, 1), a2 + hstep);
            PG8_WAIT_V(8); PG8_WAIT_L(0); PG8_BAR; PG8_MMA(0, 0, At, B0); PG8_MMA(0, 1, At, B1); PG8_BAR; PG8_SCHED;
            PG8_LDA(At, 1, 1); PG8_STAGE(PG8_SB(1, 0), b3); PG8_STAGE(PG8_SB(1, 1), b3 + hstep); PG8_STAGE(PG8_SA(1, 0), a3);
            PG8_WAIT_V(8); PG8_WAIT_L(0); PG8_BAR; PG8_MMA(1, 0, At, B0); PG8_MMA(1, 1, At, B1); PG8_BAR; PG8_SCHED;
        }
        if (wr == 0) PG8_BAR;
        E(acc, cur, wr, wc, fr, fq);
        if (!has_next) break;
#pragma unroll
        for (int a = 0; a < 2; ++a)
#pragma unroll
            for (int b = 0; b < 2; ++b)
#pragma unroll
                for (int m = 0; m < 4; ++m)
#pragma unroll
                    for (int n = 0; n < 2; ++n) acc[a][b][m][n] = (f32x4){0.f, 0.f, 0.f, 0.f};
        cur = nxt; cA = nA; cB = nB; ++ui;
        if (wr == 1) PG8_BAR;
    }
    PG8_WAIT_V(0);
    PG8_BAR;
#undef PG8_SA
#undef PG8_SB
#undef PG8_STAGE
#undef PG8_LDA
#undef PG8_LDB
#undef PG8_MMA
#undef PG8_WAIT_V
#undef PG8_WAIT_L
#undef PG8_BAR
#undef PG8_SCHED
}
}

constexpr size_t MiB = 1u << 20;
constexpr size_t WS_CTL = 0, CTL_ZERO_BYTES = 64 * 1024;
constexpr size_t WS_MOD  = 1 * MiB;
constexpr size_t WS_HID2 = 2 * MiB;
constexpr size_t WS_HC   = 5 * MiB;
constexpr size_t WS_WIN  = 8 * MiB;
constexpr size_t WS_WOUT0 = 12 * MiB;
constexpr size_t WS_WGU0 = 14 * MiB;
constexpr size_t WS_WD0  = 26 * MiB;
constexpr size_t WS_WGU1 = 32 * MiB;
constexpr size_t WS_WD1  = 44 * MiB;
constexpr size_t WS_WQKV = 50 * MiB;
constexpr size_t WS_WO1  = 56 * MiB;
constexpr size_t WS_PT   = 64 * MiB;
constexpr size_t WS_FILT = 130 * MiB;
constexpr size_t WS_U    = 163 * MiB;
constexpr size_t WS_HS   = 163 * MiB;
constexpr size_t WS_XS   = 228 * MiB;
constexpr size_t WS_Y    = 130 * MiB;
constexpr size_t WS_U2   = 64 * MiB;
constexpr size_t WS_ACT  = 100 * MiB;
constexpr size_t WS_U1   = 64 * MiB;
constexpr size_t WS_Q    = 100 * MiB;
constexpr size_t WS_K    = 132 * MiB;
constexpr size_t WS_VT   = 164 * MiB;
constexpr size_t WS_KC   = 198 * MiB;
constexpr size_t WS_O    = 64 * MiB;
constexpr size_t WS_U3   = 100 * MiB;
constexpr size_t WS_ACT1 = 132 * MiB;
constexpr size_t WS_END  = 256 * MiB;
constexpr int PT_LD = MALL;

constexpr int CW_BAR = 4096;

constexpr int LDS_BYTES = 147456;
constexpr int FFT_BYTES = 16384 * 33 / 32 * 8;
constexpr int SCR_OFF = FFT_BYTES;
constexpr int MISC_OFF = LDS_BYTES - 256;
constexpr int NWAVES = 8;

#define RLX_AGENT __ATOMIC_RELAXED, __HIP_MEMORY_SCOPE_AGENT
#define LDS_WAIT() asm volatile("s_waitcnt lgkmcnt(0)" ::: "memory")
#define VM_WAIT() asm volatile("s_waitcnt vmcnt(0)" ::: "memory")

#define XB_TMO      128
#define XB_XCNT(j)  (256  + 64 * (j))
#define XB_XSUB(j)  (1280 + 64 * (j))
#define XB_XGEN(j)  (2304 + 64 * (j))
#define XB_TOP      3328
#define XB_TOPGEN   3392
#define XCD_BAR_WORDS 3456
#define XB_SPIN_CAP (1u << 18)
__device__ __forceinline__ unsigned xb_ld(unsigned* p)              { return __hip_atomic_load(p, __ATOMIC_RELAXED, __HIP_MEMORY_SCOPE_AGENT); }
__device__ __forceinline__ unsigned xb_add(unsigned* p, unsigned v) { return __hip_atomic_fetch_add(p, v, __ATOMIC_RELAXED, __HIP_MEMORY_SCOPE_AGENT); }
__device__ __forceinline__ unsigned xb_xcc_id() { return (unsigned)__builtin_amdgcn_s_getreg((3 << 11) | 20) & 0xFu; }
#define XB_SPIN(cond, bar) do { unsigned _sp = 0; while (cond) { __builtin_amdgcn_s_sleep(1); \
    if ((++_sp & 255u) == 0u) { if (xb_ld(&(bar)[XB_TMO])) break; if (_sp > XB_SPIN_CAP) { atomicAdd(&(bar)[XB_TMO], 1u); break; } } } } while (0)
struct XcdBarrier { unsigned* bar; unsigned x; volatile LAS unsigned* st; };
__device__ __forceinline__ XcdBarrier xcd_barrier_post(unsigned* bar, volatile LAS unsigned* st) {
    XcdBarrier b; b.bar = bar; b.x = xb_xcc_id(); b.st = st;
    if (threadIdx.x == 0) (void)xb_add(&bar[XB_XCNT(b.x)], 1u);
    return b;
}
__device__ __forceinline__ void xcd_barrier_complete(unsigned* bar, unsigned x, unsigned& nloc, unsigned& nx) {
    const unsigned G = gridDim.x * gridDim.y * gridDim.z;
    unsigned sum, cnt, mine, sp = 0u;
    for (;;) {
        sum = 0u; cnt = 0u; mine = 0u;
#pragma unroll
        for (unsigned j = 0; j < 16; ++j) { const unsigned c = xb_ld(&bar[XB_XCNT(j)]); sum += c; cnt += (c > 0u) ? 1u : 0u; mine = (j == x) ? c : mine; }
        if (sum == G) break;
        __builtin_amdgcn_s_sleep(1);
        if ((++sp & 255u) == 0u) { if (xb_ld(&bar[XB_TMO])) break; if (sp > XB_SPIN_CAP) { atomicAdd(&bar[XB_TMO], 1u); break; } }
    }
    nloc = mine > 0u ? mine : 1u; nx = cnt > 0u ? cnt : 1u;
}
__device__ __forceinline__ void xcd_barrier(const XcdBarrier& b) {
    asm volatile("s_waitcnt vmcnt(0)" ::: "memory");
    __syncthreads();
    if (threadIdx.x == 0) {
        unsigned* bar = b.bar;
        __builtin_amdgcn_s_waitcnt(0);
        unsigned nloc = b.st[0], nx = b.st[1];
        if (nloc == 0u) { xcd_barrier_complete(bar, b.x, nloc, nx); b.st[0] = nloc; b.st[1] = nx; }
        const unsigned old = xb_add(&bar[XB_XSUB(b.x)], 1u);
        const unsigned gen = old / nloc;
        if (old + 1u == (gen + 1u) * nloc) {
            __builtin_amdgcn_fence(__ATOMIC_RELEASE, "agent");
            asm volatile("s_waitcnt vmcnt(0)" ::: "memory");
            const unsigned og = xb_add(&bar[XB_TOP], 1u);
            const unsigned tg = og / nx;
            if (og + 1u == (tg + 1u) * nx) xb_add(&bar[XB_TOPGEN], 1u);
            else XB_SPIN(xb_ld(&bar[XB_TOPGEN]) == tg, bar);
            __builtin_amdgcn_fence(__ATOMIC_ACQUIRE, "agent");
            xb_add(&bar[XB_XGEN(b.x)], 1u);
            asm volatile("s_waitcnt vmcnt(0)" ::: "memory");
        } else {
            XB_SPIN(xb_ld(&bar[XB_XGEN(b.x)]) == gen, bar);
            __builtin_amdgcn_fence(__ATOMIC_ACQUIRE, "agent");
            asm volatile("s_waitcnt vmcnt(0)" ::: "memory");
        }
    }
    __syncthreads();
}

struct Frame {
    LAS unsigned char* lds;
    int tid, lane, wave, vcu, G;
    const float* const* in;
    float* out; unsigned char* ws;
};
__device__ __forceinline__ float wave_sum(float v) {
#pragma unroll
    for (int o = 1; o < 64; o <<= 1) v += __shfl_xor(v, o);
    return v;
}
__device__ __forceinline__ float silu_f(float x) { return x / (1.f + __expf(-x)); }
__device__ __forceinline__ float sin_rev(float r) { return __builtin_amdgcn_sinf(__builtin_amdgcn_fractf(r)); }
__device__ __forceinline__ float cos_rev(float r) { return __builtin_amdgcn_cosf(__builtin_amdgcn_fractf(r)); }
__device__ __forceinline__ float sin_rad(float x) { return sin_rev(x * 0.15915494309189535f); }

__device__ __forceinline__ void transpose_item(const float* W, int N, f16* WT, int ldt, int k0, int n0, int drow0, LAS float* scr, int lane) {
#pragma unroll 8
    for (int i = 0; i < 32; ++i) { const int kk = 2 * i + (lane >> 5); scr[kk * 33 + (lane & 31)] = W[(size_t)(k0 + kk) * N + n0 + (lane & 31)]; }
    LDS_WAIT(); asm volatile("" ::: "memory");
    const int c = lane & 7;
#pragma unroll
    for (int j = 0; j < 4; ++j) { const int n = (lane >> 3) + 8 * j; const LAS float* s = scr + (8 * c) * 33 + n;
        u32x4 o; o.x = pkh(s[0 * 33], s[1 * 33]); o.y = pkh(s[2 * 33], s[3 * 33]); o.z = pkh(s[4 * 33], s[5 * 33]); o.w = pkh(s[6 * 33], s[7 * 33]);
        *(u32x4*)(WT + (size_t)(drow0 + n0 + n) * ldt + k0 + 8 * c) = o; }
    LDS_WAIT(); asm volatile("" ::: "memory");
}
__device__ __forceinline__ void fold_item(const float* Win, f16* WT, int g, int k0, LAS float* scr, int lane) {
    LAS float* wrow = scr;
    LAS float* tcs = scr + 1024;
#pragma unroll
    for (int i = 0; i < 16; ++i) { const int e = i * 64 + lane; wrow[e] = Win[(size_t)(k0 + (e >> 7)) * 2048 + 128 * g + (e & 127)]; }
    { const float r0 = (float)lane * (1.f / 128.f), r1 = (float)(lane + 64) * (1.f / 128.f);
      tcs[lane] = cos_rev(r0); tcs[lane + 64] = cos_rev(r1); tcs[128 + lane] = sin_rev(r0); tcs[128 + lane + 64] = sin_rev(r1); }
    LDS_WAIT(); asm volatile("" ::: "memory");
#pragma unroll
    for (int half = 0; half < 2; ++half) {
        const int mp = lane + 64 * half;
        const int m = (mp <= 64) ? mp : mp - 64; const int tb = (mp <= 64) ? 0 : 128;
        float acc[8];
#pragma unroll
        for (int kk = 0; kk < 8; ++kk) acc[kk] = 0.f;
        for (int c = 0; c < 128; ++c) { const float f = tcs[tb + ((m * c) & 127)];
#pragma unroll
            for (int kk = 0; kk < 8; ++kk) acc[kk] += wrow[kk * 128 + c] * f; }
        const float s = 1.f / 1024.f;
        u32x4 o; o.x = pkh(acc[0] * s, acc[1] * s); o.y = pkh(acc[2] * s, acc[3] * s); o.z = pkh(acc[4] * s, acc[5] * s); o.w = pkh(acc[6] * s, acc[7] * s);
        *(u32x4*)(WT + (size_t)(128 * g + mp) * 1024 + k0) = o;
    }
    LDS_WAIT(); asm volatile("" ::: "memory");
}
__device__ __forceinline__ void hid_rows(Frame& F, int gw, int NGW) {
    const float* w1 = F.in[15]; const float* b1 = F.in[16]; const float* fr = F.in[17]; const float* w2 = F.in[18]; const float* b2 = F.in[19];
    float* HID2 = (float*)(F.ws + WS_HID2);
    LAS float* wl = (LAS float*)F.lds;
    __syncthreads();
    for (int e = F.tid; e < 33 * 64; e += 512) wl[e] = w1[e];
    for (int e = F.tid; e < 64 * 64; e += 512) wl[33 * 64 + e] = w2[e];
    __syncthreads();
    const int j = F.lane;
    const float bb1 = b1[j], bb2 = b2[j], fq = fr[j];
    for (int t = gw; t < FILT_T; t += NGW) {
        const int L = t < SEQ ? SEQ : CTXL, tt = t < SEQ ? t : t - SEQ;
        float z = 0.f;
        if (j == 0) z = (float)tt / (float)(L - 1);
        else if (j < 33) { const int bnd = (j - 1) & 15; const float band = 1e-4f + (float)bnd * ((15.f - 1e-4f) / 15.f);
            const float rev = (float)tt * band / (float)L;
            z = (j <= 16) ? cos_rev(rev) : -sin_rev(rev); }
        float a1 = bb1;
#pragma unroll
        for (int i = 0; i < 33; ++i) a1 += __shfl(z, i) * wl[i * 64 + j];
        const float h1 = sin_rad(fq * a1);
        float a2 = bb2;
#pragma unroll
        for (int i = 0; i < 64; ++i) a2 += __shfl(h1, i) * wl[(33 + i) * 64 + j];
        HID2[(size_t)t * 64 + j] = sin_rad(fq * a2);
    }
    __syncthreads();
}
__device__ __forceinline__ void ada_items(Frame& F) {
    const float* c = F.in[1]; const float* cctx = F.in[3]; const float* aw = F.in[4]; const float* ab = F.in[5];
    float* MOD = (float*)(F.ws + WS_MOD);
    LAS float* sl = (LAS float*)F.lds;
    LAS float* red = (LAS float*)(F.lds + 16384);
    bool have = false;
    for (int it = F.vcu; it < 192; it += F.G) {
        if (!have) { for (int e = F.tid; e < 3072; e += 512) { const int r = e >> 10, k = e & 1023; const float v = r < 2 ? c[r * 1024 + k] : cctx[k]; sl[e] = silu_f(v); } have = true; __syncthreads(); }
        const int layer = it / 96, n0 = (it % 96) * 64;
        const int kq = F.tid >> 4, cq = F.tid & 15;
        f32x4 a0 = {0.f, 0.f, 0.f, 0.f}, a1 = a0, a2 = a0;
        const float* wp = aw + ((size_t)layer * 1024) * 6144 + n0 + 4 * cq;
#pragma unroll 4
        for (int kk = kq; kk < 1024; kk += 32) { const f32x4 w = *(const f32x4*)(wp + (size_t)kk * 6144);
            a0 += w * sl[kk]; a1 += w * sl[1024 + kk]; a2 += w * sl[2048 + kk]; }
#pragma unroll
        for (int e = 0; e < 4; ++e) { red[(kq * 3 + 0) * 64 + 4 * cq + e] = a0[e]; red[(kq * 3 + 1) * 64 + 4 * cq + e] = a1[e]; red[(kq * 3 + 2) * 64 + 4 * cq + e] = a2[e]; }
        __syncthreads();
        if (F.tid < 192) { const int r = F.tid >> 6, col = F.tid & 63; float s = ab[layer * 6144 + n0 + col];
            for (int q = 0; q < 32; ++q) s += red[(q * 3 + r) * 64 + col];
            MOD[(size_t)(layer * 3 + r) * 6144 + n0 + col] = s; }
        __syncthreads();
    }
}
__device__ __forceinline__ void p0_prep(Frame& F) {
    const int gw = F.vcu * NWAVES + F.wave, NGW = F.G * NWAVES;
    ada_items(F);
    __syncthreads();
    LAS float* scr = (LAS float*)(F.lds + F.wave * 16384);
    f16* Win_t = (f16*)(F.ws + WS_WIN);
    constexpr int I_WIN = 16 * 48, I_WOUT = 16 * 32, I_G = 16 * 88, I_D = 44 * 32, I_QKV = 16 * 96, I_O1 = 16 * 32;
    constexpr int NIT = I_WIN + I_WOUT + 4 * I_G + 2 * I_D + I_QKV + I_O1;
    for (int it = gw; it < NIT; it += NGW) {
        int r = it;
        if (r < I_WIN) { const int kb = r / 48, nb = r % 48; transpose_item(F.in[11], 2048, Win_t, 1024, 64 * kb, 512 + 32 * nb, 0, scr, F.lane); continue; } r -= I_WIN;
        if (r < I_WOUT) { const int kb = r / 32, nb = r % 32; transpose_item(F.in[12], 1024, (f16*)(F.ws + WS_WOUT0), 1024, 64 * kb, 32 * nb, 0, scr, F.lane); continue; } r -= I_WOUT;
        if (r < 4 * I_G) { const int which = r / I_G, rr = r % I_G, layer = which >> 1, up = which & 1; const int kb = rr / 88, nb = rr % 88, n0 = 32 * nb;
            const float* src = (up ? F.in[9] : F.in[8]) + (size_t)layer * 1024 * DFF;
            f16* dst = (f16*)(F.ws + (layer ? WS_WGU1 : WS_WGU0));
            const int drow0 = (n0 >> 7) * 256 + (up ? 128 : 0) + (n0 & 127) - n0;
            transpose_item(src, DFF, dst, 1024, 64 * kb, n0, drow0, scr, F.lane); continue; } r -= 4 * I_G;
        if (r < 2 * I_D) { const int layer = r / I_D, rr = r % I_D; const int kb = rr / 32, nb = rr % 32;
            transpose_item(F.in[10] + (size_t)layer * DFF * 1024, 1024, (f16*)(F.ws + (layer ? WS_WD1 : WS_WD0)), DFF, 64 * kb, 32 * nb, 0, scr, F.lane); continue; } r -= 2 * I_D;
        if (r < I_QKV) { const int kb = r / 96, nb = r % 96; transpose_item(F.in[22], 3072, (f16*)(F.ws + WS_WQKV), 1024, 64 * kb, 32 * nb, 0, scr, F.lane); continue; } r -= I_QKV;
        { const int kb = r / 32, nb = r % 32; transpose_item(F.in[23], 1024, (f16*)(F.ws + WS_WO1), 1024, 64 * kb, 32 * nb, 0, scr, F.lane); }
    }
    for (int it = gw; it < 512; it += NGW) fold_item(F.in[11], Win_t, it >> 7, (it & 127) * 8, scr, F.lane);
    hid_rows(F, gw, NGW);
}

__device__ __forceinline__ void norm_mod_row(const float* xrow, const float* g, const float* sh, const float* sc, f16* orow, int lane) {
    const f32x4* xr = (const f32x4*)xrow + lane;
    f32x4 v[4]; float s = 0.f;
#pragma unroll
    for (int j = 0; j < 4; ++j) { v[j] = xr[64 * j]; s += (v[j].x * v[j].x + v[j].y * v[j].y) + (v[j].z * v[j].z + v[j].w * v[j].w); }
    const float rstd = 1.f / sqrtf(wave_sum(s) * (1.f / DM) + RMS_EPS);
    u32x2* o8 = (u32x2*)orow + lane;
#pragma unroll
    for (int j = 0; j < 4; ++j) { const f32x4 gg = ((const f32x4*)g)[lane + 64 * j], s1 = ((const f32x4*)sc)[lane + 64 * j], s0 = ((const f32x4*)sh)[lane + 64 * j];
        const f32x4 y = (v[j] * rstd) * gg * (s1 + 1.f) + s0;
        u32x2 w; w.x = pkh(y.x, y.y); w.y = pkh(y.z, y.w); o8[64 * j] = w; }
}
__device__ __forceinline__ void norm_phase(Frame& F, const float* hl, const float* hc, const float* g, int layer, int sh_off, int sc_off, f16* U, int nrows) {
    const int gw = F.vcu * NWAVES + F.wave, NGW = F.G * NWAVES;
    const float* MOD = (const float*)(F.ws + WS_MOD) + (size_t)layer * 3 * 6144;
    for (int m = gw; m < nrows; m += NGW) {
        const int r = m < MLAT ? (m >> 13) : 2;
        const float* src = m < MLAT ? hl + (size_t)m * DM : hc + (size_t)(m - MLAT) * DM;
        norm_mod_row(src, g, MOD + r * 6144 + sh_off, MOD + r * 6144 + sc_off, U + (size_t)m * DM, F.lane);
    }
}
__device__ __forceinline__ void final_phase(Frame& F) {
    const int gw = F.vcu * NWAVES + F.wave, NGW = F.G * NWAVES;
    const float* g = F.in[25];
    for (int m = gw; m < MLAT; m += NGW) {
        f32x4* xr = (f32x4*)(F.out + (size_t)m * DM) + F.lane;
        f32x4 v[4]; float s = 0.f;
#pragma unroll
        for (int j = 0; j < 4; ++j) { v[j] = xr[64 * j]; s += (v[j].x * v[j].x + v[j].y * v[j].y) + (v[j].z * v[j].z + v[j].w * v[j].w); }
        const float rstd = 1.f / sqrtf(wave_sum(s) * (1.f / DM) + RMS_EPS);
#pragma unroll
        for (int j = 0; j < 4; ++j) xr[64 * j] = (v[j] * rstd) * ((const f32x4*)g)[F.lane + 64 * j];
    }
}

__device__ __forceinline__ void filt_gemm(Frame& F) {
    const int gw = F.vcu * NWAVES + F.wave, NGW = F.G * NWAVES;
    const float* HID2 = (const float*)(F.ws + WS_HID2); const float* w3 = F.in[20];
    f16* FILT = (f16*)(F.ws + WS_FILT);
    const int lane = F.lane, li = lane & 15, lg = lane >> 4;
    constexpr int NTB = FILT_T / 64;
    for (int it = gw; it < 128 * NTB; it += NGW) {
        const int cb = it / NTB, tb = it % NTB, ch0 = cb * 16, t0 = tb * 64;
        float bf[16];
#pragma unroll
        for (int kk = 0; kk < 16; ++kk) bf[kk] = w3[(size_t)(4 * kk + lg) * 2048 + ch0 + li];
        const int ch = ch0 + li, c = ch & 511;
        const float mind = -3.0701134573253945f, maxd = -15.350567286626973f;
        const float delta = fabsf(mind + (float)c * ((maxd - mind) / 511.f));
#pragma unroll
        for (int s = 0; s < 4; ++s) {
            f32x4 acc = {0.f, 0.f, 0.f, 0.f};
            const float* hp = HID2 + (size_t)(t0 + 16 * s + li) * 64 + lg;
#pragma unroll
            for (int kk = 0; kk < 16; ++kk) acc = __builtin_amdgcn_mfma_f32_16x16x4f32(hp[4 * kk], bf[kk], acc, 0, 0, 0);
            const int tq = t0 + 16 * s + 4 * lg;
            float o[4];
#pragma unroll
            for (int e = 0; e < 4; ++e) { const int t = tq + e; const float t01 = t < SEQ ? (float)t * (1.f / (SEQ - 1)) : (float)(t - SEQ) * (1.f / (CTXL - 1)); o[e] = acc[e] * __expf(-t01 * delta); }
            u32x2 w; w.x = pkh(o[0], o[1]); w.y = pkh(o[2], o[3]);
            *(u32x2*)(FILT + (size_t)ch * FILT_T + tq) = w;
        }
    }
}

struct EpiCM {
    f16* T; int ld;
    __device__ __forceinline__ void operator()(const f32x4 (&acc)[2][2][4][2], const pg8::Unit& u, int wr, int wc, int fr, int fq) const {
#pragma unroll
        for (int ai = 0; ai < 2; ++ai)
#pragma unroll
            for (int m = 0; m < 4; ++m) { const int row = u.pm * 256 + ai * 128 + wr * 64 + m * 16 + 4 * fq;
#pragma unroll
                for (int bj = 0; bj < 2; ++bj)
#pragma unroll
                    for (int n = 0; n < 2; ++n) { const int col = u.pn * 256 + bj * 128 + wc * 32 + n * 16 + fr; const f32x4 v = acc[ai][bj][m][n];
                        u32x2 w; w.x = pkh(v[0], v[1]); w.y = pkh(v[2], v[3]); *(u32x2*)(T + (size_t)col * ld + row) = w; } }
    }
};
struct EpiResid {
    const float* baseL; const float* baseC; float* dstL; float* dstC; const float* gate;
    __device__ __forceinline__ void operator()(const f32x4 (&acc)[2][2][4][2], const pg8::Unit& u, int wr, int wc, int fr, int fq) const {
#pragma unroll
        for (int ai = 0; ai < 2; ++ai)
#pragma unroll
            for (int m = 0; m < 4; ++m) { const int row = u.pm * 256 + ai * 128 + wr * 64 + m * 16 + fr;
                const bool lat = row < MLAT; const int rmod = lat ? (row >> 13) : 2;
                const size_t ro = lat ? (size_t)row * DM : (size_t)(row - MLAT) * DM;
                const float* bp = (lat ? baseL : baseC) + ro; float* dp = (lat ? dstL : dstC) + ro; const float* gp = gate + rmod * 6144;
#pragma unroll
                for (int bj = 0; bj < 2; ++bj)
#pragma unroll
                    for (int n = 0; n < 2; ++n) { const int col = u.pn * 256 + bj * 128 + wc * 32 + n * 16 + 4 * fq;
                        const f32x4 b = *(const f32x4*)(bp + col), gg = *(const f32x4*)(gp + col);
#ifdef DBG_ZERO_GATE
                        *(f32x4*)(dp + col) = b + gg * 0.f;
#else
                        *(f32x4*)(dp + col) = b + gg * acc[ai][bj][m][n];
#endif
                        } }
    }
};
struct EpiGU {
    f16* ACT;
    __device__ __forceinline__ void operator()(const f32x4 (&acc)[2][2][4][2], const pg8::Unit& u, int wr, int wc, int fr, int fq) const {
#pragma unroll
        for (int ai = 0; ai < 2; ++ai)
#pragma unroll
            for (int m = 0; m < 4; ++m) { const int row = u.pm * 256 + ai * 128 + wr * 64 + m * 16 + fr;
#pragma unroll
                for (int n = 0; n < 2; ++n) { const int col = u.pn * 128 + wc * 32 + n * 16 + 4 * fq; const f32x4 g = acc[ai][0][m][n], up = acc[ai][1][m][n];
                    float o[4];
#pragma unroll
                    for (int e = 0; e < 4; ++e) o[e] = g[e] / (1.f + __expf(-g[e])) * up[e];
                    u32x2 w; w.x = pkh(o[0], o[1]); w.y = pkh(o[2], o[3]); *(u32x2*)(ACT + (size_t)row * DFF + col) = w; } }
    }
};
struct EpiQK {
    f16* Q; f16* K; f16* KC; float qscale;
    __device__ __forceinline__ void operator()(const f32x4 (&acc)[2][2][4][2], const pg8::Unit& u, int wr, int wc, int fr, int fq) const {
        const bool isq = u.pn < 4; const float sc = isq ? qscale : 1.f;
#pragma unroll
        for (int ai = 0; ai < 2; ++ai)
#pragma unroll
            for (int m = 0; m < 4; ++m) { const int row = u.pm * 256 + ai * 128 + wr * 64 + m * 16 + fr; const bool lat = row < MLAT;
                if (!lat && isq) continue;
                const int b = lat ? (row >> 13) : ((row - MLAT) >> 8), t = lat ? (row & 8191) : ((row - MLAT) & 255);
#pragma unroll
                for (int bj = 0; bj < 2; ++bj)
#pragma unroll
                    for (int n = 0; n < 2; ++n) { const int col = (u.pn & 3) * 256 + bj * 128 + wc * 32 + n * 16 + 4 * fq; const int h = col >> 6, d = col & 63;
                        f16* dst = lat ? (isq ? Q : K) + (((size_t)(b * NHEAD + h) * SEQ + t) * HD + d) : KC + (((size_t)(b * NHEAD + h) * CTXL + t) * HD + d);
                        const f32x4 v = acc[ai][bj][m][n] * sc; u32x2 w; w.x = pkh(v[0], v[1]); w.y = pkh(v[2], v[3]); *(u32x2*)dst = w; } }
    }
};

__device__ constexpr float C32T[16] = {1.f, 0.98078528040323f, 0.92387953251129f, 0.83146961230255f, 0.70710678118655f, 0.55557023301960f, 0.38268343236509f, 0.19509032201613f,
                                       0.f, -0.19509032201613f, -0.38268343236509f, -0.55557023301960f, -0.70710678118655f, -0.83146961230255f, -0.92387953251129f, -0.98078528040323f};
__device__ constexpr float S32T[16] = {0.f, 0.19509032201613f, 0.38268343236509f, 0.55557023301960f, 0.70710678118655f, 0.83146961230255f, 0.92387953251129f, 0.98078528040323f,
                                       1.f, 0.98078528040323f, 0.92387953251129f, 0.83146961230255f, 0.70710678118655f, 0.55557023301960f, 0.38268343236509f, 0.19509032201613f};
__device__ constexpr int BR5[32] = {0,16,8,24,4,20,12,28,2,18,10,26,6,22,14,30,1,17,9,25,5,21,13,29,3,19,11,27,7,23,15,31};
__device__ constexpr int BR4[16] = {0,8,4,12,2,10,6,14,1,9,5,13,3,11,7,15};
__device__ constexpr int BR3[8] = {0,4,2,6,1,5,3,7};
__device__ __forceinline__ constexpr int brev(int i, int bits) { return bits == 5 ? BR5[i] : (bits == 4 ? BR4[i] : BR3[i]); }
template <int R> __device__ __forceinline__ void dif_fwd(float (&re)[R], float (&im)[R]) {
    constexpr int LG = R == 32 ? 5 : (R == 16 ? 4 : (R == 8 ? 3 : (R == 4 ? 2 : 1)));
#pragma unroll
    for (int st = 0; st < LG; ++st) {
        const int m = R >> st, hm = m >> 1, ts = 32 / m;
#pragma unroll
        for (int b = 0; b < R; b += m)
#pragma unroll
            for (int j = 0; j < hm; ++j) {
                const int i0 = b + j, i1 = b + j + hm, tw = j * ts;
                const float ar = re[i0], ai = im[i0], cr = re[i1], ci = im[i1];
                re[i0] = ar + cr; im[i0] = ai + ci;
                const float dr = ar - cr, di = ai - ci;
                if (tw == 0) { re[i1] = dr; im[i1] = di; }
                else if (tw == 8) { re[i1] = di; im[i1] = -dr; }
                else { const float c = C32T[tw], s = S32T[tw]; re[i1] = dr * c + di * s; im[i1] = di * c - dr * s; }
            }
    }
}
template <int R> __device__ __forceinline__ void dit_inv(float (&re)[R], float (&im)[R]) {
    constexpr int LG = R == 32 ? 5 : (R == 16 ? 4 : (R == 8 ? 3 : (R == 4 ? 2 : 1)));
#pragma unroll
    for (int st = LG - 1; st >= 0; --st) {
        const int m = R >> st, hm = m >> 1, ts = 32 / m;
#pragma unroll
        for (int b = 0; b < R; b += m)
#pragma unroll
            for (int j = 0; j < hm; ++j) {
                const int i0 = b + j, i1 = b + j + hm, tw = j * ts;
                const float ar = re[i0], ai = im[i0], cr = re[i1], ci = im[i1];
                float tr, ti;
                if (tw == 0) { tr = cr; ti = ci; }
                else if (tw == 8) { tr = -ci; ti = cr; }
                else { const float c = C32T[tw], s = S32T[tw]; tr = cr * c - ci * s; ti = ci * c + cr * s; }
                re[i0] = ar + tr; im[i0] = ai + ti; re[i1] = ar - tr; im[i1] = ai - ti;
            }
    }
}
__device__ __forceinline__ int fpad(int i) { return i + (i >> 5); }
__device__ __forceinline__ void tw_fwd(float& x, float& y, float rev) { const float c = __builtin_amdgcn_cosf(rev), s = __builtin_amdgcn_sinf(rev); const float a = x * c + y * s, b = y * c - x * s; x = a; y = b; }
__device__ __forceinline__ void tw_inv(float& x, float& y, float rev) { const float c = __builtin_amdgcn_cosf(rev), s = __builtin_amdgcn_sinf(rev); const float a = x * c - y * s, b = y * c + x * s; x = a; y = b; }

__device__ __forceinline__ void fft_s2_fwd(LAS f32x2* buf, int tid) {
    asm volatile("" : "+v"(tid));
    const int kk = tid >> 5, n3 = tid & 31;
    LAS f32x2* pb = buf + fpad(kk * 1024 + n3);
    float re[32], im[32];
#pragma unroll
    for (int n2 = 0; n2 < 32; ++n2) { const f32x2 v = pb[33 * n2]; re[n2] = v.x; im[n2] = v.y; }
    dif_fwd<32>(re, im);
#pragma unroll
    for (int p = 0; p < 32; ++p) { const int k2 = brev(p, 5); tw_fwd(re[p], im[p], (float)(n3 * k2) * (1.f / 1024.f)); pb[33 * k2] = (f32x2){re[p], im[p]}; }
}
__device__ __forceinline__ void fft_s2_inv(LAS f32x2* buf, int tid) {
    asm volatile("" : "+v"(tid));
    const int k1 = tid >> 5, n3 = tid & 31;
    LAS f32x2* pb = buf + fpad(k1 * 1024 + n3);
    float re[32], im[32];
#pragma unroll
    for (int p = 0; p < 32; ++p) { const f32x2 v = pb[33 * brev(p, 5)]; re[p] = v.x; im[p] = v.y; }
    dit_inv<32>(re, im);
#pragma unroll
    for (int n2 = 0; n2 < 32; ++n2) { tw_inv(re[n2], im[n2], (float)((n2 * 32 + n3) * k1) * (1.f / 16384.f)); pb[33 * n2] = (f32x2){re[n2], im[n2]}; }
}
__device__ __forceinline__ void fft_s3_conv(LAS f32x2* buf, int tid, const f32x2* H) {
    asm volatile("" : "+v"(tid));
    const int k2 = tid & 31;
    LAS f32x2* pb = buf + fpad((tid >> 5) * 1024 + k2 * 32);
    const f32x2* hp = H + tid;
    float re[32], im[32];
#pragma unroll
    for (int n3 = 0; n3 < 32; ++n3) { const f32x2 v = pb[n3]; re[n3] = v.x; im[n3] = v.y; }
    dif_fwd<32>(re, im);
#pragma unroll
    for (int p = 0; p < 32; ++p) { const f32x2 h = hp[p * 512]; const float a = re[p] * h.x - im[p] * h.y, b = re[p] * h.y + im[p] * h.x; re[p] = a; im[p] = b; }
    dit_inv<32>(re, im);
#pragma unroll
    for (int n3 = 0; n3 < 32; ++n3) { tw_inv(re[n3], im[n3], (float)(n3 * k2) * (1.f / 1024.f)); pb[n3] = (f32x2){re[n3], im[n3]}; }
}

__device__ __forceinline__ void hyena_task(Frame& F, int c) {
    LAS f32x2* buf = (LAS f32x2*)F.lds;
    LAS float* scr = (LAS float*)(F.lds + SCR_OFF);
    int tid = threadIdx.x; asm volatile("" : "+v"(tid));
    const int lane = tid & 63, wave = __builtin_amdgcn_readfirstlane(tid >> 6);
    u16* PT = (u16*)(F.ws + WS_PT);
    const u16* FILT = (const u16*)(F.ws + WS_FILT);
    f32x2* HS = (f32x2*)(F.ws + WS_HS) + (size_t)blockIdx.x * 32768;
    unsigned* XS = (unsigned*)(F.ws + WS_XS) + (size_t)blockIdx.x * (32 * 512);
    const float* cw = F.in[13]; const float* cb = F.in[14]; const float* skip = F.in[21];
    {
        const u16* f1 = FILT + (size_t)(c) * FILT_T; const u16* f2 = FILT + (size_t)(512 + c) * FILT_T;
        const u16* b1 = FILT + (size_t)(1024 + c) * FILT_T; const u16* b2 = FILT + (size_t)(1536 + c) * FILT_T;
        float a1 = 0.f, a2 = 0.f;
        if (tid == 0) { a1 = fabsf(h2f(b1[0])); a2 = fabsf(h2f(b2[0])); }
#pragma unroll
        for (int jj = 0; jj < 2; ++jj) {
            __builtin_amdgcn_sched_barrier(0); int j = tid + 512 * jj; asm volatile("" : "+v"(j));
            float re[16], im[16];
#pragma unroll
            for (int n1 = 0; n1 < 16; ++n1) { const int n = n1 * 1024 + j;
                if (n1 < 8) { re[n1] = h2f(f1[n]); im[n1] = h2f(f2[n]); }
                else if (n == 8192) { re[n1] = 0.f; im[n1] = 0.f; }
                else { re[n1] = h2f(b1[16384 - n]); im[n1] = h2f(b2[16384 - n]); }
                a1 += fabsf(re[n1]); a2 += fabsf(im[n1]); }
            dif_fwd<16>(re, im);
#pragma unroll
            for (int p = 0; p < 16; ++p) { const int k1 = brev(p, 4); tw_fwd(re[p], im[p], (float)(j * k1) * (1.f / 16384.f)); (buf + fpad(j))[1056 * k1] = (f32x2){re[p], im[p]}; }
        }
        a1 = wave_sum(a1); a2 = wave_sum(a2);
        if (lane == 0) { scr[wave * 2] = a1; scr[wave * 2 + 1] = a2; }
        __syncthreads();
        float n1s = 0.f, n2s = 0.f;
#pragma unroll
        for (int w = 0; w < 8; ++w) { n1s += scr[2 * w]; n2s += scr[2 * w + 1]; }
        const float inv1 = 0.5f / (n1s * 16384.f), inv2 = 0.5f / (n2s * 16384.f);
        const float ska = skip[c] * (1.f / 16384.f), skb = skip[512 + c] * (1.f / 16384.f);
        fft_s2_fwd(buf, tid);
        __syncthreads();
        {
            const int k1 = tid >> 5, k2 = tid & 31;
            LAS f32x2* pb = buf + fpad(k1 * 1024 + k2 * 32);
            float re[32], im[32];
#pragma unroll
            for (int n3 = 0; n3 < 32; ++n3) { const f32x2 v = pb[n3]; re[n3] = v.x; im[n3] = v.y; }
            dif_fwd<32>(re, im);
#pragma unroll
            for (int p = 0; p < 32; ++p) pb[brev(p, 5)] = (f32x2){re[p], im[p]};
            __syncthreads();
            f32x2* hp = HS + tid;
#pragma unroll
            for (int p = 0; p < 32; ++p) {
                const int k = k1 + 16 * k2 + 512 * brev(p, 5), km = (16384 - k) & 16383;
                const f32x2 zm = buf[fpad((km & 15) * 1024 + ((km >> 4) & 31) * 32 + (km >> 9))];
                const float sr = re[p] + zm.x, si = im[p] - zm.y;
                const float dr = re[p] - zm.x, di = im[p] + zm.y;
                hp[p * 512] = (f32x2){sr * inv1 + ska, si * inv1};
                hp[16384 + p * 512] = (f32x2){di * inv2 + skb, -dr * inv2};
            }
        }
        __syncthreads();
    }
    unsigned vpk[16];
    {
        LAS u16* raw = (LAS u16*)F.lds;
#pragma unroll
        for (int w = 0; w < 3; ++w) {
            const u16* row = PT + (size_t)(512 + 512 * w + c) * PT_LD;
#pragma unroll
            for (int i = 0; i < 4; ++i) { const int e = (i * 512 + tid) * 8;
                *(LAS u32x4*)(raw + w * 16384 + e) = *(const u32x4*)(row + e); }
        }
        __syncthreads();
#pragma unroll
        for (int w = 0; w < 3; ++w) {
            const int ch = 512 * w + c;
            const float w0 = cw[ch], w1 = cw[1536 + ch], w2 = cw[3072 + ch], bias = cb[ch];
#pragma unroll
            for (int idx = 0; idx < 16; ++idx) { const int n = (idx & 7) * 1024 + tid + 512 * (idx >> 3);
                const LAS u16* p0 = raw + w * 16384 + n; const LAS u16* p1 = p0 + SEQ;
                const float a0 = n > 0 ? h2f(p0[-1]) : 0.f, a1 = h2f(p0[0]), a2 = n < SEQ - 1 ? h2f(p0[1]) : 0.f;
                const float c0 = n > 0 ? h2f(p1[-1]) : 0.f, c1 = h2f(p1[0]), c2 = n < SEQ - 1 ? h2f(p1[1]) : 0.f;
                const unsigned pk = pkh(w0 * a0 + w1 * a1 + w2 * a2 + bias, w0 * c0 + w1 * c1 + w2 * c2 + bias);
                if (w < 2) XS[(w * 16 + idx) * 512 + tid] = pk; else vpk[idx] = pk; }
        }
        __syncthreads();
    }
#define XS_LD(w, idx, lo, hi) do { const f16x2 _v = __builtin_bit_cast(f16x2, XS[((w) * 16 + (idx)) * 512 + tid]); lo = (float)_v[0]; hi = (float)_v[1]; } while (0)
#pragma unroll
    for (int jj = 0; jj < 2; ++jj) {
        __builtin_amdgcn_sched_barrier(0); int j = tid + 512 * jj; asm volatile("" : "+v"(j));
        float re[16], im[16];
#pragma unroll
        for (int n1 = 0; n1 < 8; ++n1) { const f16x2 v = __builtin_bit_cast(f16x2, vpk[jj * 8 + n1]); re[n1] = (float)v[0]; im[n1] = (float)v[1]; }
#pragma unroll
        for (int n1 = 8; n1 < 16; ++n1) { re[n1] = 0.f; im[n1] = 0.f; }
        dif_fwd<16>(re, im);
#pragma unroll
        for (int p = 0; p < 16; ++p) { const int k1 = brev(p, 4); tw_fwd(re[p], im[p], (float)(j * k1) * (1.f / 16384.f)); (buf + fpad(j))[1056 * k1] = (f32x2){re[p], im[p]}; }
    }
    __syncthreads();
    fft_s2_fwd(buf, tid); __syncthreads();
    fft_s3_conv(buf, tid, HS); __syncthreads();
    fft_s2_inv(buf, tid); __syncthreads();
#pragma unroll
    for (int jj = 0; jj < 2; ++jj) {
        __builtin_amdgcn_sched_barrier(0); int j = tid + 512 * jj; asm volatile("" : "+v"(j));
        float re[16], im[16];
#pragma unroll
        for (int p = 0; p < 16; ++p) { const f32x2 v = (buf + fpad(j))[1056 * brev(p, 4)]; re[p] = v.x; im[p] = v.y; }
        dit_inv<16>(re, im);
#pragma unroll
        for (int n1 = 0; n1 < 8; ++n1) { float x0, x1; XS_LD(0, jj * 8 + n1, x0, x1); re[n1] *= x0; im[n1] *= x1; }
#pragma unroll
        for (int n1 = 8; n1 < 16; ++n1) { re[n1] = 0.f; im[n1] = 0.f; }
        dif_fwd<16>(re, im);
#pragma unroll
        for (int p = 0; p < 16; ++p) { const int k1 = brev(p, 4); tw_fwd(re[p], im[p], (float)(j * k1) * (1.f / 16384.f)); (buf + fpad(j))[1056 * k1] = (f32x2){re[p], im[p]}; }
    }
    __syncthreads();
    fft_s2_fwd(buf, tid); __syncthreads();
    fft_s3_conv(buf, tid, HS + 16384); __syncthreads();
    fft_s2_inv(buf, tid); __syncthreads();
    u16* yrow = PT + (size_t)(512 + c) * PT_LD;
#pragma unroll
    for (int jj = 0; jj < 2; ++jj) {
        __builtin_amdgcn_sched_barrier(0); int j = tid + 512 * jj; asm volatile("" : "+v"(j));
        float re[16], im[16];
#pragma unroll
        for (int p = 0; p < 16; ++p) { const f32x2 v = (buf + fpad(j))[1056 * brev(p, 4)]; re[p] = v.x; im[p] = v.y; }
        dit_inv<16>(re, im);
#pragma unroll
        for (int n1 = 0; n1 < 8; ++n1) { float x0, x1; XS_LD(1, jj * 8 + n1, x0, x1);
            yrow[n1 * 1024 + j] = __builtin_bit_cast(u16, (f16)(x0 * re[n1])); yrow[SEQ + n1 * 1024 + j] = __builtin_bit_cast(u16, (f16)(x1 * im[n1])); }
    }
#undef XS_LD
    __syncthreads();
}

__device__ __forceinline__ void fourier_task(Frame& F, int task) {
    LAS f32x2* buf = (LAS f32x2*)F.lds;
    int tid = threadIdx.x; asm volatile("" : "+v"(tid));
    const int b = task >> 7, g = (task >> 5) & 3, q = task & 31;
    u16* PT = (u16*)(F.ws + WS_PT);
    const int mA[2] = {q, q == 0 ? 32 : 64 - q};
    const size_t tok0 = (size_t)b * SEQ;
#pragma unroll
    for (int f = 0; f < 2; ++f) {
        const u16* rA = PT + (size_t)(128 * g + mA[f]) * PT_LD + tok0; const u16* rB = PT + (size_t)(128 * g + 64 + mA[f]) * PT_LD + tok0;
        const float sg = (f == 0 && q == 0) ? 1.f : -1.f;
#pragma unroll
        for (int jj = 0; jj < 2; ++jj) {
            __builtin_amdgcn_sched_barrier(0); int j = tid + 512 * jj; asm volatile("" : "+v"(j));
            float re[8], im[8];
#pragma unroll
            for (int n1 = 0; n1 < 8; ++n1) { re[n1] = h2f(rA[n1 * 1024 + j]); im[n1] = sg * h2f(rB[n1 * 1024 + j]); }
            dif_fwd<8>(re, im);
#pragma unroll
            for (int p = 0; p < 8; ++p) { const int k1 = brev(p, 3); tw_fwd(re[p], im[p], (float)(j * k1) * (1.f / 8192.f)); (buf + fpad(j))[1056 * (f * 8 + k1)] = (f32x2){re[p], im[p]}; }
        }
    }
    __syncthreads();
    fft_s2_fwd(buf, tid);
    __syncthreads();
    {
        const int kk = tid >> 5, k2 = tid & 31, f = kk >> 3, k1 = kk & 7;
        LAS f32x2* pb = buf + fpad(kk * 1024 + k2 * 32);
        float re[32], im[32];
#pragma unroll
        for (int n3 = 0; n3 < 32; ++n3) { const f32x2 v = pb[n3]; re[n3] = v.x; im[n3] = v.y; }
        dif_fwd<32>(re, im);
        __syncthreads();
        { LAS f32x2* pn = buf + fpad(f * 8192 + k1 + 8 * k2);
#pragma unroll
        for (int p = 0; p < 32; ++p) pn[264 * brev(p, 5)] = (f32x2){re[p], im[p]}; }
    }
    __syncthreads();
#pragma unroll
    for (int f = 0; f < 2; ++f) {
        const bool packed = (f == 0 && q == 0);
        const int m = mA[f];
        u16* o1 = PT + (size_t)(128 * g + (packed ? 0 : m)) * PT_LD + tok0;
        u16* o2 = PT + (size_t)(128 * g + (packed ? 64 : 128 - m)) * PT_LD + tok0;
        for (int l = tid; l < SEQ; l += 512) {
            const f32x2 a = buf[fpad(f * 8192 + l)], c = buf[fpad(f * 8192 + ((SEQ - l) & (SEQ - 1)))];
            const float y1 = packed ? 0.5f * (a.x + c.x) : a.x, y2 = packed ? 0.5f * (a.y + c.y) : c.x;
            o1[l] = __builtin_bit_cast(u16, (f16)y1); o2[l] = __builtin_bit_cast(u16, (f16)y2);
        }
    }
    __syncthreads();
}

__device__ __forceinline__ void fourier_ctx_task(Frame& F, int task) {
    LAS float* zr = (LAS float*)F.lds;
    LAS float* zi = zr + 512;
    LAS float* tc = zr + 1024;
    LAS float* ts = zr + 1280;
    LAS float* fr = zr + 1536;
    LAS float* fi = zr + 2048;
    int tid = threadIdx.x; asm volatile("" : "+v"(tid));
    const int f = tid >> 8, k = tid & 255;
    const int b = task >> 7, g = (task >> 5) & 3, q = task & 31;
    u16* PT = (u16*)(F.ws + WS_PT);
    const int m = f == 0 ? q : (q == 0 ? 32 : 64 - q);
    const bool packed = (f == 0 && q == 0);
    const size_t tok0 = (size_t)MLAT + (size_t)b * CTXL;
    const u16* rA = PT + (size_t)(128 * g + m) * PT_LD + tok0; const u16* rB = PT + (size_t)(128 * g + 64 + m) * PT_LD + tok0;
    zr[tid] = h2f(rA[k]); zi[tid] = (packed ? 1.f : -1.f) * h2f(rB[k]);
    if (tid < 256) { tc[tid] = cos_rev((float)tid * (1.f / 256.f)); ts[tid] = sin_rev((float)tid * (1.f / 256.f)); }
    __syncthreads();
    float ar = 0.f, ai = 0.f;
    for (int l = 0; l < 256; ++l) { const float x = zr[f * 256 + l], y = zi[f * 256 + l]; const int e = (k * l) & 255; const float c = tc[e], s = ts[e];
        ar += x * c + y * s; ai += y * c - x * s; }
    fr[tid] = ar; fi[tid] = ai;
    __syncthreads();
    const int km = f * 256 + ((256 - k) & 255);
    const float sc = 5.656854249492381f;
    const float y1 = packed ? 0.5f * (ar + fr[km]) : ar, y2 = packed ? 0.5f * (ai + fi[km]) : fr[km];
    u16* o1 = PT + (size_t)(128 * g + (packed ? 0 : m)) * PT_LD + tok0; u16* o2 = PT + (size_t)(128 * g + (packed ? 64 : 128 - m)) * PT_LD + tok0;
    o1[k] = __builtin_bit_cast(u16, (f16)(y1 * sc)); o2[k] = __builtin_bit_cast(u16, (f16)(y2 * sc));
    __syncthreads();
}
__device__ __forceinline__ void hyena_ctx_task(Frame& F, int c) {
    LAS float* fw = (LAS float*)F.lds;
    LAS float* bw = fw + 512;
    LAS float* vv = fw + 1024;
    LAS float* scr = fw + 1536;
    int tid = threadIdx.x; asm volatile("" : "+v"(tid));
    const int b = tid >> 8, t = tid & 255;
    u16* PT = (u16*)(F.ws + WS_PT);
    const u16* FILT = (const u16*)(F.ws + WS_FILT);
    const float* cw = F.in[13]; const float* cb = F.in[14]; const float* skip = F.in[21];
    const float fwv = h2f(FILT[(size_t)(b * 512 + c) * FILT_T + SEQ + t]), bwv = h2f(FILT[(size_t)(1024 + b * 512 + c) * FILT_T + SEQ + t]);
    float a = wave_sum(fabsf(fwv) + fabsf(bwv));
    if (F.lane == 0) scr[F.wave] = a;
    fw[tid] = fwv; bw[tid] = bwv;
    const size_t tok = (size_t)MLAT + (size_t)b * CTXL + t;
    auto sc3 = [&](int ch) { const u16* p = PT + (size_t)(512 + ch) * PT_LD + tok;
        const float a0 = t > 0 ? h2f(p[-1]) : 0.f, a1 = h2f(p[0]), a2 = t < CTXL - 1 ? h2f(p[1]) : 0.f;
        return cw[ch] * a0 + cw[1536 + ch] * a1 + cw[3072 + ch] * a2 + cb[ch]; };
    const float x1 = sc3(c), x2 = sc3(512 + c), v0 = sc3(1024 + c);
    vv[tid] = v0;
    __syncthreads();
    const float nr0 = scr[0] + scr[1] + scr[2] + scr[3], nr1 = scr[4] + scr[5] + scr[6] + scr[7];
    float y = 0.f;
    for (int s = 0; s < 256; ++s) { const float u = vv[b * 256 + s]; const float h = s <= t ? fw[t - s] : bw[s - t]; y += u * h; }
    const float v1 = x1 * (y / nr0 + skip[c] * v0);
    __syncthreads();
    vv[tid] = v1;
    __syncthreads();
    y = 0.f;
    for (int s = 0; s < 256; ++s) { const float u = vv[b * 256 + s]; const float h = s <= t ? fw[256 + t - s] : bw[256 + s - t]; y += u * h; }
    const float o = x2 * (y / nr1 + skip[512 + c] * v1);
    __syncthreads();
    PT[(size_t)(512 + c) * PT_LD + tok] = __builtin_bit_cast(u16, (f16)o);
    __syncthreads();
}
__device__ __forceinline__ void p3_fft(Frame& F) {
    for (int c = F.vcu; c < 512; c += F.G) hyena_task(F, c);
    for (int t = F.vcu; t < 256; t += F.G) fourier_task(F, t);
    for (int t = F.vcu; t < 256; t += F.G) fourier_ctx_task(F, t);
    for (int c = F.vcu; c < 512; c += F.G) hyena_ctx_task(F, c);
}

__device__ __forceinline__ void p4_transpose(Frame& F) {
    const int gw = F.vcu * NWAVES + F.wave, NGW = F.G * NWAVES, lane = F.lane;
    const u16* YT = (const u16*)(F.ws + WS_PT); u16* Y = (u16*)(F.ws + WS_Y);
    LAS u16* scr = (LAS u16*)(F.lds + F.wave * 16384);
    constexpr int NRB = MALL / 64;
    for (int it = gw; it < 16 * NRB; it += NGW) {
        const int cb = it / NRB, rb = it % NRB;
#pragma unroll
        for (int i = 0; i < 8; ++i) { const int ch = (lane >> 3) + 8 * i, seg = lane & 7;
            const u32x4 v = *(const u32x4*)(YT + (size_t)(cb * 64 + ch) * PT_LD + rb * 64 + 8 * seg);
            *(LAS u32x4*)(scr + ch * 72 + 8 * seg) = v; }
        LDS_WAIT(); asm volatile("" ::: "memory");
#pragma unroll
        for (int i = 0; i < 8; ++i) { const int tk = (lane >> 3) + 8 * i, seg = lane & 7;
            unsigned w[4];
#pragma unroll
            for (int e = 0; e < 4; ++e) { const unsigned lo = scr[(8 * seg + 2 * e) * 72 + tk], hi = scr[(8 * seg + 2 * e + 1) * 72 + tk]; w[e] = lo | (hi << 16); }
            *(u32x4*)(Y + (size_t)(rb * 64 + tk) * DM + cb * 64 + 8 * seg) = (u32x4){w[0], w[1], w[2], w[3]}; }
        LDS_WAIT(); asm volatile("" ::: "memory");
    }
}

__device__ __forceinline__ void na_task(Frame& F, int bh, int r, int chunk) {
    int lane = threadIdx.x & 63; asm volatile("" : "+v"(lane));
    const int q = lane & 15, g = lane >> 4;
    const int b = bh >> 4, h = bh & 15;
    const f16* Q = (const f16*)(F.ws + WS_Q); const f16* K = (const f16*)(F.ws + WS_K); const f16* KC = (const f16*)(F.ws + WS_KC);
    const f16* VT = (const f16*)(F.ws + WS_VT); f16* O = (f16*)(F.ws + WS_O);
    const LAS float* rpb = (const LAS float*)F.lds;
    const int kstart = chunk == 0 ? 0 : (chunk == 1 ? 8 : (chunk == 2 ? 24 : 32));
    const int off = chunk == 0 ? 15 : (chunk == 3 ? -1 : 7);
    const int ws = chunk == 0 ? (q > 8 ? q - 8 : 0) : (chunk == 3 ? (q + 8 < 16 ? q + 8 : 16) : q);
    const int rs = r - 4 < 0 ? 0 : (r - 4 > 120 ? 120 : r - 4);
    const f16* Qp = Q + ((size_t)bh * SEQ + r * 64 + 16 * chunk + q) * HD + 8 * g;
    const f16x8 q0 = *(const f16x8*)Qp, q1 = *(const f16x8*)(Qp + 32);
    f32x4 o[4];
#pragma unroll
    for (int db = 0; db < 4; ++db) o[db] = (f32x4){0.f, 0.f, 0.f, 0.f};
    float m = -INFINITY, l = 0.f;
    const __amdgpu_buffer_rsrc_t rK = __builtin_amdgcn_make_buffer_rsrc((void*)K, 0, (int)(2u * 16 * 8192 * 64 * 2), 0x00020000);
    const __amdgpu_buffer_rsrc_t rKC = __builtin_amdgcn_make_buffer_rsrc((void*)KC, 0, (int)(2u * 16 * 256 * 64 * 2), 0x00020000);
    const __amdgpu_buffer_rsrc_t rV = __builtin_amdgcn_make_buffer_rsrc((void*)VT, 0, (int)(1024u * PT_LD * 2), 0x00020000);
    const unsigned voKL = (unsigned)((((bh * SEQ) + rs * 64 + kstart + q) * HD + 8 * g) * 2);
    const unsigned voKC = (unsigned)((((bh * CTXL) + q) * HD + 8 * g) * 2);
    const unsigned voVL = (unsigned)((((h * 64 + q) * PT_LD) + b * SEQ + rs * 64 + kstart + 4 * g) * 2);
    const unsigned voVC = (unsigned)((((h * 64 + q) * PT_LD) + MLAT + b * CTXL + 4 * g) * 2);
#pragma unroll
    for (int st = 0; st < 16; ++st) {
        const bool loc = st < 8; const int i = st & 7;
        const unsigned sok = loc ? (unsigned)(i * 64 * HD * 2) : (unsigned)(i * 32 * HD * 2);
        const unsigned sov = loc ? (unsigned)(i * 64 * 2) : (unsigned)(i * 32 * 2);
        const unsigned vok = loc ? voKL : voKC, vov = loc ? voVL : voVC;
        f32x4 s0, s1;
        if (loc) {
            const int dr = rs + i - r + 7;
#pragma unroll
            for (int e = 0; e < 4; ++e) { const int kc0 = 4 * g + e, kc1 = 16 + 4 * g + e;
                int d0 = kc0 - q + off; d0 = d0 < 0 ? 0 : (d0 > 30 ? 30 : d0); int d1 = kc1 - q + off; d1 = d1 < 0 ? 0 : (d1 > 30 ? 30 : d1);
                s0[e] = (kc0 >= ws && kc0 < ws + 16) ? rpb[dr * 31 + d0] : -INFINITY; s1[e] = (kc1 >= ws && kc1 < ws + 16) ? rpb[dr * 31 + d1] : -INFINITY; }
        } else { s0 = (f32x4){0.f, 0.f, 0.f, 0.f}; s1 = s0; }
#define LDK16(o_) __builtin_bit_cast(f16x8, loc ? __builtin_amdgcn_raw_buffer_load_b128(rK, vok, sok + (o_), 0) : __builtin_amdgcn_raw_buffer_load_b128(rKC, vok, sok + (o_), 0))
        s0 = __builtin_amdgcn_mfma_f32_16x16x32_f16(LDK16(0), q0, s0, 0, 0, 0);
        s0 = __builtin_amdgcn_mfma_f32_16x16x32_f16(LDK16(64), q1, s0, 0, 0, 0);
        s1 = __builtin_amdgcn_mfma_f32_16x16x32_f16(LDK16(16 * HD * 2), q0, s1, 0, 0, 0);
        s1 = __builtin_amdgcn_mfma_f32_16x16x32_f16(LDK16(16 * HD * 2 + 64), q1, s1, 0, 0, 0);
#undef LDK16
        float mx = fmaxf(fmaxf(fmaxf(s0[0], s0[1]), fmaxf(s0[2], s0[3])), fmaxf(fmaxf(s1[0], s1[1]), fmaxf(s1[2], s1[3])));
        mx = fmaxf(mx, __shfl_xor(mx, 16)); mx = fmaxf(mx, __shfl_xor(mx, 32));
        const float mn = fmaxf(m, mx);
        const float alpha = __builtin_amdgcn_exp2f(m - mn);
        m = mn;
        f16x8 pf; float ps = 0.f;
#pragma unroll
        for (int e = 0; e < 4; ++e) { const float p0 = __builtin_amdgcn_exp2f(s0[e] - mn), p1 = __builtin_amdgcn_exp2f(s1[e] - mn); ps += p0 + p1; pf[e] = (f16)p0; pf[4 + e] = (f16)p1; }
        l = l * alpha + ps;
#pragma unroll
        for (int db = 0; db < 4; ++db) {
            const unsigned so = sov + (unsigned)(16 * db) * (unsigned)(PT_LD * 2);
            const f16x4 v0 = __builtin_bit_cast(f16x4, __builtin_amdgcn_raw_buffer_load_b64(rV, vov, so, 0)), v1 = __builtin_bit_cast(f16x4, __builtin_amdgcn_raw_buffer_load_b64(rV, vov, so + 32, 0));
            const f16x8 vv = {v0[0], v0[1], v0[2], v0[3], v1[0], v1[1], v1[2], v1[3]};
            o[db] = __builtin_amdgcn_mfma_f32_16x16x32_f16(vv, pf, o[db] * alpha, 0, 0, 0);
        }
    }
    l += __shfl_xor(l, 16); l += __shfl_xor(l, 32);
    { const float rinv = 1.f / l;
#pragma unroll
      for (int db = 0; db < 4; ++db) o[db] = o[db] * rinv; }
    f16* op = O + ((size_t)b * SEQ + r * 64 + 16 * chunk + q) * DM + h * 64 + 4 * g;
#pragma unroll
    for (int db = 0; db < 4; ++db) { const f32x4 v = o[db]; u32x2 w; w.x = pkh(v[0], v[1]); w.y = pkh(v[2], v[3]); *(u32x2*)(op + 16 * db) = w; }
}
__device__ __forceinline__ void p11_na(Frame& F) {
    for (int it = F.vcu * 8; it < 2048; it += F.G * 8) {
        { const int h = (it >> 6) & 15; const float* src = F.in[24] + (size_t)h * 465; LAS float* tb = (LAS float*)F.lds;
          __syncthreads();
          if (F.tid < 465) tb[F.tid] = src[F.tid] * LOG2E;
          __syncthreads(); }
#pragma unroll 1
        for (int i = 0; i < 8; ++i) { const int item = it + i; if (item >= 2048) break; const int bh = item >> 6, rp = item & 63;
            na_task(F, bh, 2 * rp + (F.wave >> 2), F.wave & 3); }
    }
}

struct Args { const float* in[26]; float* out; unsigned char* ws; int ph_lo, ph_hi; };
constexpr int NPHASE = 17;

__global__ void __launch_bounds__(NWAVES * 64, 2) fwd_kernel(Args args) {
    extern __shared__ __attribute__((aligned(16))) unsigned char lds[];
    Frame F;
    F.lds = (LAS unsigned char*)lds;
    F.tid = threadIdx.x; F.lane = F.tid & 63; F.wave = __builtin_amdgcn_readfirstlane(F.tid >> 6);
    F.G = gridDim.x; { const int bx = blockIdx.x; F.vcu = (F.G % 8 == 0) ? (bx % 8) * (F.G / 8) + bx / 8 : bx; }
    F.in = args.in;
    F.out = args.out; F.ws = args.ws;
    volatile LAS unsigned* MISC = (volatile LAS unsigned*)(F.lds + MISC_OFF);
    if (F.tid < 64) MISC[F.tid] = 0u;
    __syncthreads();
    unsigned* ctl = (unsigned*)(F.ws + WS_CTL);
    XcdBarrier bar; bar.bar = ctl + CW_BAR; bar.x = 0; bar.st = nullptr;
    const int lo = args.ph_lo, hi = args.ph_hi;
    if (hi - lo > 1) bar = xcd_barrier_post(ctl + CW_BAR, MISC + 8);
#define REFRESH() do { F.tid = threadIdx.x; asm volatile("" : "+v"(F.tid)); F.lane = F.tid & 63; F.wave = __builtin_amdgcn_readfirstlane(F.tid >> 6); \
        { int z_ = 0; asm volatile("" : "+s"(z_)); F.in = args.in + z_; F.ws = args.ws + z_; F.out = args.out + z_; } \
        ws = F.ws; MOD = (const float*)(ws + WS_MOD); HC = (float*)(ws + WS_HC); } while (0)
#ifndef PH_MASK
#define PH_MASK 0x1FFFF
#endif
#define IN(k) (((PH_MASK >> (k)) & 1) && lo <= (k) && (k) < hi)
#define SEAM(k) do { if (lo <= (k) && (k) + 1 < hi) xcd_barrier(bar); } while (0)
    unsigned char* ws; const float* MOD; float* HC;
    LAS unsigned char* ring = F.lds;

    for (int ph = lo; ph < hi; ++ph) {
        REFRESH();
        switch (ph) {
    case 0: if (!((PH_MASK >> 0) & 1)) break; { p0_prep(F); } break;
    case 1: if (!((PH_MASK >> 1) & 1)) break; { norm_phase(F, F.in[0], F.in[2], F.in[6], 0, 0, 1024, (f16*)(ws + WS_U), MALL); filt_gemm(F); } break;
    case 2: if (!((PH_MASK >> 2) & 1)) break; {
        pg8::Gemm g{(const f16*)(ws + WS_U), (const f16*)(ws + WS_WIN), MALL, 2048, 1024}; pg8::StaticOrder S; S.init(MALL, 2048, F.G, (int)blockIdx.x);
        EpiCM E{(f16*)(ws + WS_PT), PT_LD};
        pg8::gemm_phase<EpiCM, pg8::StaticOrder, true>(ring, g, S, E);
    } break;
    case 3: if (!((PH_MASK >> 3) & 1)) break; { p3_fft(F); } break;
    case 4: if (!((PH_MASK >> 4) & 1)) break; { p4_transpose(F); } break;
    case 5: if (!((PH_MASK >> 5) & 1)) break; {
        pg8::Gemm g{(const f16*)(ws + WS_Y), (const f16*)(ws + WS_WOUT0), MALL, 1024, 1024}; pg8::StaticOrder S; S.init(MALL, 1024, F.G, (int)blockIdx.x);
        EpiResid E{F.in[0], F.in[2], F.out, HC, MOD + 2048};
        pg8::gemm_phase<EpiResid, pg8::StaticOrder, false>(ring, g, S, E);
    } break;
    case 6: if (!((PH_MASK >> 6) & 1)) break; { norm_phase(F, F.out, HC, F.in[7], 0, 3072, 4096, (f16*)(ws + WS_U2), MALL); } break;
    case 7: if (!((PH_MASK >> 7) & 1)) break; {
        pg8::Gemm g{(const f16*)(ws + WS_U2), (const f16*)(ws + WS_WGU0), MALL, 2 * DFF, 1024}; pg8::StaticOrder S; S.init(MALL, 2 * DFF, F.G, (int)blockIdx.x);
        EpiGU E{(f16*)(ws + WS_ACT)};
        pg8::gemm_phase<EpiGU, pg8::StaticOrder, false>(ring, g, S, E);
    } break;
    case 8: if (!((PH_MASK >> 8) & 1)) break; {
        pg8::Gemm g{(const f16*)(ws + WS_ACT), (const f16*)(ws + WS_WD0), MALL, 1024, DFF}; pg8::StaticOrder S; S.init(MALL, 1024, F.G, (int)blockIdx.x);
        EpiResid E{F.out, HC, F.out, HC, MOD + 5120};
        pg8::gemm_phase<EpiResid, pg8::StaticOrder, false>(ring, g, S, E);
    } break;
    case 9: if (!((PH_MASK >> 9) & 1)) break; { norm_phase(F, F.out, HC, F.in[6] + 1024, 1, 0, 1024, (f16*)(ws + WS_U1), MALL); } break;
    case 10: if (!((PH_MASK >> 10) & 1)) break; {
        { pg8::Gemm g{(const f16*)(ws + WS_U1), (const f16*)(ws + WS_WQKV), MALL, 2048, 1024}; pg8::StaticOrder S; S.init(MALL, 2048, F.G, (int)blockIdx.x);
          EpiQK E{(f16*)(ws + WS_Q), (f16*)(ws + WS_K), (f16*)(ws + WS_KC), 0.125f * LOG2E};
          pg8::gemm_phase<EpiQK, pg8::StaticOrder, false>(ring, g, S, E); }
        { pg8::Gemm g{(const f16*)(ws + WS_U1), (const f16*)(ws + WS_WQKV) + (size_t)2048 * 1024, MALL, 1024, 1024}; pg8::StaticOrder S; S.init(MALL, 1024, F.G, (int)blockIdx.x);
          EpiCM E{(f16*)(ws + WS_VT), PT_LD};
          pg8::gemm_phase<EpiCM, pg8::StaticOrder, true>(ring, g, S, E); }
    } break;
    case 11: if (!((PH_MASK >> 11) & 1)) break; { p11_na(F); } break;
    case 12: if (!((PH_MASK >> 12) & 1)) break; {
        pg8::Gemm g{(const f16*)(ws + WS_O), (const f16*)(ws + WS_WO1), MLAT, 1024, 1024}; pg8::StaticOrder S; S.init(MLAT, 1024, F.G, (int)blockIdx.x);
        EpiResid E{F.out, HC, F.out, HC, MOD + 3 * 6144 + 2048};
        pg8::gemm_phase<EpiResid, pg8::StaticOrder, false>(ring, g, S, E);
    } break;
    case 13: if (!((PH_MASK >> 13) & 1)) break; { norm_phase(F, F.out, HC, F.in[7] + 1024, 1, 3072, 4096, (f16*)(ws + WS_U3), MLAT); } break;
    case 14: if (!((PH_MASK >> 14) & 1)) break; {
        pg8::Gemm g{(const f16*)(ws + WS_U3), (const f16*)(ws + WS_WGU1), MLAT, 2 * DFF, 1024}; pg8::StaticOrder S; S.init(MLAT, 2 * DFF, F.G, (int)blockIdx.x);
        EpiGU E{(f16*)(ws + WS_ACT1)};
        pg8::gemm_phase<EpiGU, pg8::StaticOrder, false>(ring, g, S, E);
    } break;
    case 15: if (!((PH_MASK >> 15) & 1)) break; {
        pg8::Gemm g{(const f16*)(ws + WS_ACT1), (const f16*)(ws + WS_WD1), MLAT, 1024, DFF}; pg8::StaticOrder S; S.init(MLAT, 1024, F.G, (int)blockIdx.x);
        EpiResid E{F.out, HC, F.out, HC, MOD + 3 * 6144 + 5120};
        pg8::gemm_phase<EpiResid, pg8::StaticOrder, false>(ring, g, S, E);
    } break;
    case 16: if (!((PH_MASK >> 16) & 1)) break; { final_phase(F); } break;
        default: break;
        }
        if (ph + 1 < hi) xcd_barrier(bar);
    }
#undef IN
#undef SEAM
}

#ifdef DBG_STOP
__global__ void dbg_dump(const u16* src, float* out, size_t n, size_t nvalid) { for (size_t i = (size_t)blockIdx.x * blockDim.x + threadIdx.x; i < n; i += (size_t)gridDim.x * blockDim.x) out[i] = i < nvalid ? h2f(src[i]) : 0.f; }
__global__ void dbg_dump32(const float* src, float* out, size_t n, size_t nvalid) { for (size_t i = (size_t)blockIdx.x * blockDim.x + threadIdx.x; i < n; i += (size_t)gridDim.x * blockDim.x) out[i] = i < nvalid ? src[i] : 0.f; }
#endif
extern "C" void kernel_launch(void* const* d_in, const int* in_sizes, int n_in, void* d_out, int out_size, void* d_ws, size_t ws_size, hipStream_t stream) {
    static int grid = 0;
    if (grid == 0) {
        if (n_in != 26 || out_size != MLAT * DM || ws_size < WS_END) { fprintf(stderr, "kernel_launch: unexpected shapes (n_in %d out %d ws %zu)\n", n_in, out_size, ws_size); grid = -1; return; }
        int dev = 0, cus = 0;
        if (hipGetDevice(&dev) != hipSuccess || hipDeviceGetAttribute(&cus, hipDeviceAttributeMultiprocessorCount, dev) != hipSuccess) { grid = -1; return; }
        if (hipFuncSetAttribute((const void*)fwd_kernel, hipFuncAttributeMaxDynamicSharedMemorySize, LDS_BYTES) != hipSuccess) { fprintf(stderr, "kernel_launch: hipFuncSetAttribute failed\n"); grid = -1; return; }
        int per_cu = 0;
        if (hipOccupancyMaxActiveBlocksPerMultiprocessor(&per_cu, (const void*)fwd_kernel, NWAVES * 64, LDS_BYTES) != hipSuccess || per_cu < 1) fprintf(stderr, "kernel_launch: occupancy query reports %d\n", per_cu);
        (void)hipGetLastError();
        grid = cus;
    }
    if (grid < 0) return;
    (void)hipMemsetAsync((char*)d_ws + WS_CTL, 0, CTL_ZERO_BYTES, stream);
    Args a{};
    for (int i = 0; i < 26; ++i) a.in[i] = (const float*)d_in[i];
    a.out = (float*)d_out; a.ws = (unsigned char*)d_ws;
#ifdef DBG_STOP
    for (int p = 0; p <= DBG_STOP; ++p) { a.ph_lo = p; a.ph_hi = p + 1; hipLaunchKernelGGL(fwd_kernel, dim3(grid), dim3(NWAVES * 64), LDS_BYTES, stream, a); }
#if DBG_F32 == 2
#elif DBG_F32
    hipLaunchKernelGGL(dbg_dump32, dim3(2048), dim3(256), 0, stream, (const float*)((const char*)d_ws + DBG_OFF), (float*)d_out, (size_t)MLAT * DM, (size_t)DBG_N);
#else
    hipLaunchKernelGGL(dbg_dump, dim3(2048), dim3(256), 0, stream, (const u16*)((const char*)d_ws + DBG_OFF), (float*)d_out, (size_t)MLAT * DM, (size_t)DBG_N);
#endif
#elif MK_PER_PHASE
    for (int p = 0; p < NPHASE; ++p) { a.ph_lo = p; a.ph_hi = p + 1; hipLaunchKernelGGL(fwd_kernel, dim3(grid), dim3(NWAVES * 64), LDS_BYTES, stream, a); }
#else
    a.ph_lo = 0; a.ph_hi = NPHASE;
    hipLaunchKernelGGL(fwd_kernel, dim3(grid), dim3(NWAVES * 64), LDS_BYTES, stream, a);
#endif
}
```

```cpp
#include <hip/hip_runtime.h>
#include <cstdio>
#include <cstdint>

#ifndef MK_PER_PHASE
#define MK_PER_PHASE 0
#endif

#define LAS __attribute__((address_space(3)))
#define GAS __attribute__((address_space(1)))
typedef _Float16 f16;
typedef _Float16 f16x8 __attribute__((ext_vector_type(8)));
typedef _Float16 f16x4 __attribute__((ext_vector_type(4)));
typedef _Float16 f16x2 __attribute__((ext_vector_type(2)));
typedef float f32x4 __attribute__((ext_vector_type(4)));
typedef float f32x2 __attribute__((ext_vector_type(2)));
typedef unsigned u32x4 __attribute__((ext_vector_type(4)));
typedef unsigned u32x2 __attribute__((ext_vector_type(2)));
typedef unsigned short u16;

__device__ __forceinline__ unsigned pkh(float lo, float hi) { f16x2 v = {(f16)lo, (f16)hi}; return __builtin_bit_cast(unsigned, v); }
__device__ __forceinline__ float h2f(u16 b) { return (float)__builtin_bit_cast(f16, b); }

constexpr int DM = 1024, BATCH = 2, SEQ = 8192, CTXL = 256, DFF = 2816;
constexpr int MLAT = BATCH * SEQ;
constexpr int MCTX = BATCH * CTXL;
constexpr int MALL = MLAT + MCTX;
constexpr int NHEAD = 16, HD = 64;
constexpr int FILT_T = SEQ + CTXL;
constexpr float RMS_EPS = 1e-6f;
constexpr float LOG2E = 1.4426950408889634f;

namespace pg8 {
constexpr int BM = 256, BK = 64, HALF = 128, HTB = HALF * BK * 2, STAGE_BYTES = 8 * HTB, NXCD = 8, WGM = 8;
__host__ __device__ __forceinline__ int lds_byte(int r, int c) { const int st = (r >> 4) * 2 + (c >> 5), rr = r & 15, cc = c & 31, ob = rr * 64 + cc * 2; return st * 1024 + (ob ^ (((ob >> 9) & 1) << 5)); }
__host__ __device__ __forceinline__ void stage_rc(int b, int& R, int& C) { const int st = b / 1024, sb = b % 1024, swz = sb ^ (((sb >> 9) & 1) << 5); R = (st >> 1) * 16 + swz / 64; C = (st & 1) * 32 + (swz % 64) / 2; }

struct Unit { int pm, pn; };
struct Gemm { const f16* A; const f16* Bt; int M, N, K; };

struct StaticOrder {
    int nM, nN, nwg, G, c;
    __device__ void init(int M, int N, int G_, int c_) { nM = M / BM; nN = N / BM; nwg = nM * nN; G = G_; c = c_; }
    __device__ bool next(int i, Unit& u) const {
        const long L = (long)i * G + c; if (L >= nwg) return false;
        int wgid = (int)L; { const int q = nwg / NXCD, r = nwg % NXCD, xcd = wgid % NXCD, off = wgid / NXCD; wgid = (xcd < r ? xcd * (q + 1) : r * (q + 1) + (xcd - r) * q) + off; }
        const int nig = WGM * nN, gid = wgid / nig, fm = gid * WGM, gsz = (nM - fm) < WGM ? (nM - fm) : WGM;
        u.pm = fm + ((wgid % nig) % gsz); u.pn = (wgid % nig) / gsz; return true;
    }
};
struct QkvOrder {
    int G, c;
    __device__ bool next(int i, Unit& u) const {
        const long L = (long)i * G + c; if (L >= 784) return false;
        if (L >= 768) { const int r = (int)L - 768; u.pm = 64 + (r & 1); u.pn = 4 + (r >> 1); return true; }
        int wgid = (int)L; { const int q = 768 / NXCD, xcd = wgid % NXCD, off = wgid / NXCD; wgid = xcd * q + off; }
        const int nig = WGM * 12, gid = wgid / nig, fm = gid * WGM;
        u.pm = fm + ((wgid % nig) % WGM); u.pn = (wgid % nig) / WGM; return true;
    }
};

template <class Epi, class Sched, bool SWAP>
__device__ __forceinline__ void gemm_phase(LAS unsigned char* lds, const Gemm g, const Sched& S, const Epi& E) {
    int tid = threadIdx.x; asm volatile("" : "+v"(tid));
    const int wid = __builtin_amdgcn_readfirstlane(tid >> 6), lane = tid & 63, wr = wid >> 2, wc = wid & 3, fr = lane & 15, fq = lane >> 4;
    const int K = g.K, nt = K / BK;
    unsigned voffA[2];
#pragma unroll
    for (int i = 0; i < 2; ++i) { int R, C; stage_rc(tid * 16 + i * 8192, R, C); voffA[i] = (unsigned)(R * K + C) * 2u; }
    const size_t kstep = (size_t)(BK * 2);
    const size_t hstep = (size_t)HALF * K * 2;
    const size_t tstep = 2 * hstep;
    const unsigned ldsw = (unsigned)wid * 1024u;
    const int aoff = lds_byte(wr * 64 + fr, fq * 8), boff = lds_byte(wc * 32 + fr, fq * 8);
#define PG8_SA(b, h) (((b) * 2 + (h)) * HTB)
#define PG8_SB(b, h) ((4 + (b) * 2 + (h)) * HTB)
#define PG8_STAGE(bufoff, gbase) do { _Pragma("unroll") for (int _i = 0; _i < 2; ++_i) \
        __builtin_amdgcn_global_load_lds((const unsigned*)((const char*)(gbase) + voffA[_i]), (LAS unsigned*)(lds + (bufoff) + ldsw + _i * 8192), 16, 0, 0); } while (0)
#define PG8_LDA(dst, b, h) do { _Pragma("unroll") for (int m = 0; m < 4; ++m) _Pragma("unroll") for (int k = 0; k < 2; ++k) dst[m][k] = *(const LAS f16x8*)(lds + PG8_SA(b, h) + aoff + m * 2048 + k * 1024); } while (0)
#define PG8_LDB(dst, b, h) do { _Pragma("unroll") for (int n = 0; n < 2; ++n) _Pragma("unroll") for (int k = 0; k < 2; ++k) dst[n][k] = *(const LAS f16x8*)(lds + PG8_SB(b, h) + boff + n * 2048 + k * 1024); } while (0)
#define PG8_MMA(ai, bj, At, Bt) do { __builtin_amdgcn_s_setprio(1); _Pragma("unroll") for (int m = 0; m < 4; ++m) _Pragma("unroll") for (int n = 0; n < 2; ++n) _Pragma("unroll") for (int k = 0; k < 2; ++k) \
        acc[ai][bj][m][n] = SWAP ? __builtin_amdgcn_mfma_f32_16x16x32_f16(At[m][k], Bt[n][k], acc[ai][bj][m][n], 0, 0, 0) \
                                 : __builtin_amdgcn_mfma_f32_16x16x32_f16(Bt[n][k], At[m][k], acc[ai][bj][m][n], 0, 0, 0); __builtin_amdgcn_s_setprio(0); } while (0)
#define PG8_WAIT_V(n) asm volatile("s_waitcnt vmcnt(" #n ")" ::: "memory")
#define PG8_WAIT_L(n) asm volatile("s_waitcnt lgkmcnt(" #n ")" ::: "memory")
#define PG8_BAR __builtin_amdgcn_s_barrier()
#define PG8_SCHED __builtin_amdgcn_sched_barrier(0)
    Unit cur, nxt; int ui = 0;
    if (!S.next(0, cur)) return;
    f32x4 acc[2][2][4][2];
#pragma unroll
    for (int a = 0; a < 2; ++a)
#pragma unroll
        for (int b = 0; b < 2; ++b)
#pragma unroll
            for (int m = 0; m < 4; ++m)
#pragma unroll
                for (int n = 0; n < 2; ++n) acc[a][b][m][n] = (f32x4){0.f, 0.f, 0.f, 0.f};
    f16x8 At[4][2], B0[2][2], B1[2][2];
    const char* cA = (const char*)g.A + (size_t)cur.pm * tstep; const char* cB = (const char*)g.Bt + (size_t)cur.pn * tstep;
    PG8_STAGE(PG8_SB(0, 0), cB); PG8_STAGE(PG8_SB(0, 1), cB + hstep); PG8_STAGE(PG8_SA(0, 0), cA); PG8_STAGE(PG8_SA(0, 1), cA + hstep);
    if (wr == 1) PG8_BAR;
    PG8_WAIT_V(2); PG8_BAR;
    PG8_STAGE(PG8_SB(1, 0), cB + kstep); PG8_STAGE(PG8_SA(1, 0), cA + kstep); PG8_STAGE(PG8_SB(1, 1), cB + hstep + kstep);
    PG8_WAIT_V(6); PG8_BAR;
    for (;;) {
        const bool has_next = S.next(ui + 1, nxt);
        const char* nA = has_next ? (const char*)g.A + (size_t)nxt.pm * tstep : cA; const char* nB = has_next ? (const char*)g.Bt + (size_t)nxt.pn * tstep : cB;
        for (int t = 0; t < nt; t += 2) {
            const bool last = (t == nt - 2);
            const char* a1 = cA + (size_t)(t + 1) * kstep;
            const char* a2 = last ? nA : cA + (size_t)(t + 2) * kstep; const char* b2 = last ? nB : cB + (size_t)(t + 2) * kstep;
            const char* a3 = a2 + kstep; const char* b3 = b2 + kstep;
            PG8_LDB(B0, 0, 0); PG8_LDB(B1, 0, 1); PG8_SCHED; PG8_LDA(At, 0, 0); PG8_STAGE(PG8_SA(1, 1), a1 + hstep);
            PG8_WAIT_V(8); PG8_WAIT_L(0); PG8_BAR; PG8_MMA(0, 0, At, B0); PG8_MMA(0, 1, At, B1); PG8_BAR; PG8_SCHED;
            PG8_LDA(At, 0, 1); PG8_STAGE(PG8_SB(0, 0), b2); PG8_STAGE(PG8_SB(0, 1), b2 + hstep); PG8_STAGE(PG8_SA(0, 0), a2);
            PG8_WAIT_V(8); PG8_WAIT_L(0); PG8_BAR; PG8_MMA(1, 0, At, B0); PG8_MMA(1, 1, At, B1); PG8_BAR; PG8_SCHED;
            PG8_LDB(B0, 1, 0); PG8_LDB(B1, 1, 1); PG8_SCHED; PG8_LDA(At, 1, 0); PG8_STAGE(PG8_SA(0, 1), a2 + hstep);
            PG8_WAIT_V(8); PG8_WAIT_L(0); PG8_BAR; PG8_MMA(0, 0, At, B0); PG8_MMA(0, 1, At, B1); PG8_BAR; PG8_SCHED;
            PG8_LDA(At, 1, 1); PG8_STAGE(PG8_SB(1, 0), b3); PG8_STAGE(PG8_SB(1, 1), b3 + hstep); PG8_STAGE(PG8_SA(1, 0), a3);
            PG8_WAIT_V(8); PG8_WAIT_L(0); PG8_BAR; PG8_MMA(1, 0, At, B0); PG8_MMA(1, 1, At, B1); PG8_BAR; PG8_SCHED;
        }
        if (wr == 0) PG8_BAR;
        E(acc, cur, wr, wc, fr, fq);
        if (!has_next) break;
#pragma unroll
        for (int a = 0; a < 2; ++a)
#pragma unroll
            for (int b = 0; b < 2; ++b)
#pragma unroll
                for (int m = 0; m < 4; ++m)
#pragma unroll
                    for (int n = 0; n < 2; ++n) acc[a][b][m][n] = (f32x4){0.f, 0.f, 0.f, 0.f};
        cur = nxt; cA = nA; cB = nB; ++ui;
        if (wr == 1) PG8_BAR;
    }
    PG8_WAIT_V(0);
    PG8_BAR;
#undef PG8_SA
#undef PG8_SB
#undef PG8_STAGE
#undef PG8_LDA
#undef PG8_LDB
#undef PG8_MMA
#undef PG8_WAIT_V
#undef PG8_WAIT_L
#undef PG8_BAR
#undef PG8_SCHED
}
}

constexpr size_t MiB = 1u << 20;
constexpr size_t WS_CTL = 0, CTL_ZERO_BYTES = 64 * 1024;
constexpr size_t WS_MOD  = 1 * MiB;
constexpr size_t WS_HID2 = 2 * MiB;
constexpr size_t WS_HC   = 5 * MiB;
constexpr size_t WS_WIN  = 8 * MiB;
constexpr size_t WS_WOUT0 = 12 * MiB;
constexpr size_t WS_WGU0 = 14 * MiB;
constexpr size_t WS_WD0  = 26 * MiB;
constexpr size_t WS_WGU1 = 32 * MiB;
constexpr size_t WS_WD1  = 44 * MiB;
constexpr size_t WS_WQKV = 50 * MiB;
constexpr size_t WS_WO1  = 56 * MiB;
constexpr size_t WS_PT   = 64 * MiB;
constexpr size_t WS_FILT = 130 * MiB;
constexpr size_t WS_U    = 163 * MiB;
constexpr size_t WS_HS   = 163 * MiB;
constexpr size_t WS_XS   = 228 * MiB;
constexpr size_t WS_Y    = 130 * MiB;
constexpr size_t WS_U2   = 64 * MiB;
constexpr size_t WS_ACT  = 100 * MiB;
constexpr size_t WS_U1   = 64 * MiB;
constexpr size_t WS_Q    = 100 * MiB;
constexpr size_t WS_K    = 132 * MiB;
constexpr size_t WS_V    = 164 * MiB;
constexpr size_t WS_KC   = 198 * MiB;
constexpr size_t WS_VC   = 199 * MiB;
constexpr size_t WS_O    = 64 * MiB;
constexpr size_t WS_U3   = 100 * MiB;
constexpr size_t WS_ACT1 = 132 * MiB;
constexpr size_t WS_END  = 256 * MiB;
constexpr int PT_LD = MALL;

constexpr int CW_BAR = 4096;

constexpr int LDS_BYTES = 163840;
constexpr int FFT_BYTES = 16384 * 33 / 32 * 8;
constexpr int SCR_OFF = FFT_BYTES;
constexpr int MISC_OFF = LDS_BYTES - 256;
constexpr int NWAVES = 8;

#define RLX_AGENT __ATOMIC_RELAXED, __HIP_MEMORY_SCOPE_AGENT
#define LDS_WAIT() asm volatile("s_waitcnt lgkmcnt(0)" ::: "memory")
#define VM_WAIT() asm volatile("s_waitcnt vmcnt(0)" ::: "memory")

#define XB_TMO      128
#define XB_XCNT(j)  (256  + 64 * (j))
#define XB_XSUB(j)  (1280 + 64 * (j))
#define XB_XGEN(j)  (2304 + 64 * (j))
#define XB_TOP      3328
#define XB_TOPGEN   3392
#define XCD_BAR_WORDS 3456
#define XB_SPIN_CAP (1u << 18)
__device__ __forceinline__ unsigned xb_ld(unsigned* p)              { return __hip_atomic_load(p, __ATOMIC_RELAXED, __HIP_MEMORY_SCOPE_AGENT); }
__device__ __forceinline__ unsigned xb_add(unsigned* p, unsigned v) { return __hip_atomic_fetch_add(p, v, __ATOMIC_RELAXED, __HIP_MEMORY_SCOPE_AGENT); }
__device__ __forceinline__ unsigned xb_xcc_id() { return (unsigned)__builtin_amdgcn_s_getreg((3 << 11) | 20) & 0xFu; }
#define XB_SPIN(cond, bar) do { unsigned _sp = 0; while (cond) { __builtin_amdgcn_s_sleep(1); \
    if ((++_sp & 255u) == 0u) { if (xb_ld(&(bar)[XB_TMO])) break; if (_sp > XB_SPIN_CAP) { atomicAdd(&(bar)[XB_TMO], 1u); break; } } } } while (0)
struct XcdBarrier { unsigned* bar; unsigned x; volatile LAS unsigned* st; };
__device__ __forceinline__ XcdBarrier xcd_barrier_post(unsigned* bar, volatile LAS unsigned* st) {
    XcdBarrier b; b.bar = bar; b.x = xb_xcc_id(); b.st = st;
    if (threadIdx.x == 0) (void)xb_add(&bar[XB_XCNT(b.x)], 1u);
    return b;
}
__device__ __forceinline__ void xcd_barrier_complete(unsigned* bar, unsigned x, unsigned& nloc, unsigned& nx) {
    const unsigned G = gridDim.x * gridDim.y * gridDim.z;
    unsigned sum, cnt, mine, sp = 0u;
    for (;;) {
        sum = 0u; cnt = 0u; mine = 0u;
#pragma unroll
        for (unsigned j = 0; j < 16; ++j) { const unsigned c = xb_ld(&bar[XB_XCNT(j)]); sum += c; cnt += (c > 0u) ? 1u : 0u; mine = (j == x) ? c : mine; }
        if (sum == G) break;
        __builtin_amdgcn_s_sleep(1);
        if ((++sp & 255u) == 0u) { if (xb_ld(&bar[XB_TMO])) break; if (sp > XB_SPIN_CAP) { atomicAdd(&bar[XB_TMO], 1u); break; } }
    }
    nloc = mine > 0u ? mine : 1u; nx = cnt > 0u ? cnt : 1u;
}
__device__ __forceinline__ void xcd_barrier(const XcdBarrier& b) {
    asm volatile("s_waitcnt vmcnt(0)" ::: "memory");
    __syncthreads();
    if (threadIdx.x == 0) {
        unsigned* bar = b.bar;
        __builtin_amdgcn_s_waitcnt(0);
        unsigned nloc = b.st[0], nx = b.st[1];
        if (nloc == 0u) { xcd_barrier_complete(bar, b.x, nloc, nx); b.st[0] = nloc; b.st[1] = nx; }
        const unsigned old = xb_add(&bar[XB_XSUB(b.x)], 1u);
        const unsigned gen = old / nloc;
        if (old + 1u == (gen + 1u) * nloc) {
            __builtin_amdgcn_fence(__ATOMIC_RELEASE, "agent");
            asm volatile("s_waitcnt vmcnt(0)" ::: "memory");
            const unsigned og = xb_add(&bar[XB_TOP], 1u);
            const unsigned tg = og / nx;
            if (og + 1u == (tg + 1u) * nx) xb_add(&bar[XB_TOPGEN], 1u);
            else XB_SPIN(xb_ld(&bar[XB_TOPGEN]) == tg, bar);
            __builtin_amdgcn_fence(__ATOMIC_ACQUIRE, "agent");
            xb_add(&bar[XB_XGEN(b.x)], 1u);
            asm volatile("s_waitcnt vmcnt(0)" ::: "memory");
        } else {
            XB_SPIN(xb_ld(&bar[XB_XGEN(b.x)]) == gen, bar);
            __builtin_amdgcn_fence(__ATOMIC_ACQUIRE, "agent");
            asm volatile("s_waitcnt vmcnt(0)" ::: "memory");
        }
    }
    __syncthreads();
}

struct Frame {
    LAS unsigned char* lds;
    int vcu, G;
    const float* const* in;
    float* out; unsigned char* ws;
};
#define LOCAL_IDS() int tid = threadIdx.x; asm volatile("" : "+v"(tid)); const int lane = tid & 63; const int wave = __builtin_amdgcn_readfirstlane(tid >> 6); (void)lane; (void)wave
__device__ __forceinline__ float wave_sum(float v) {
#pragma unroll
    for (int o = 1; o < 64; o <<= 1) v += __shfl_xor(v, o);
    return v;
}
__device__ __forceinline__ float silu_f(float x) { return x / (1.f + __expf(-x)); }
__device__ __forceinline__ float sin_rev(float r) { return __builtin_amdgcn_sinf(__builtin_amdgcn_fractf(r)); }
__device__ __forceinline__ float cos_rev(float r) { return __builtin_amdgcn_cosf(__builtin_amdgcn_fractf(r)); }
__device__ __forceinline__ float sin_rad(float x) { return sin_rev(x * 0.15915494309189535f); }

__device__ __forceinline__ void transpose_item(const float* W, int N, f16* WT, int ldt, int k0, int n0, int drow0, LAS float* scr, int lane) {
#pragma unroll 8
    for (int i = 0; i < 32; ++i) { const int kk = 2 * i + (lane >> 5); scr[kk * 33 + (lane & 31)] = W[(size_t)(k0 + kk) * N + n0 + (lane & 31)]; }
    LDS_WAIT(); asm volatile("" ::: "memory");
    const int c = lane & 7;
#pragma unroll
    for (int j = 0; j < 4; ++j) { const int n = (lane >> 3) + 8 * j; const LAS float* s = scr + (8 * c) * 33 + n;
        u32x4 o; o.x = pkh(s[0 * 33], s[1 * 33]); o.y = pkh(s[2 * 33], s[3 * 33]); o.z = pkh(s[4 * 33], s[5 * 33]); o.w = pkh(s[6 * 33], s[7 * 33]);
        *(u32x4*)(WT + (size_t)(drow0 + n0 + n) * ldt + k0 + 8 * c) = o; }
    LDS_WAIT(); asm volatile("" ::: "memory");
}
__device__ __forceinline__ void fold_item(const float* Win, f16* WT, int g, int k0, LAS float* scr, int lane) {
    LAS float* wrow = scr;
    LAS float* tcs = scr + 1024;
#pragma unroll
    for (int i = 0; i < 16; ++i) { const int e = i * 64 + lane; wrow[e] = Win[(size_t)(k0 + (e >> 7)) * 2048 + 128 * g + (e & 127)]; }
    { const float r0 = (float)lane * (1.f / 128.f), r1 = (float)(lane + 64) * (1.f / 128.f);
      tcs[lane] = cos_rev(r0); tcs[lane + 64] = cos_rev(r1); tcs[128 + lane] = sin_rev(r0); tcs[128 + lane + 64] = sin_rev(r1); }
    LDS_WAIT(); asm volatile("" ::: "memory");
#pragma unroll
    for (int half = 0; half < 2; ++half) {
        const int mp = lane + 64 * half;
        const int m = (mp <= 64) ? mp : mp - 64; const int tb = (mp <= 64) ? 0 : 128;
        float acc[8];
#pragma unroll
        for (int kk = 0; kk < 8; ++kk) acc[kk] = 0.f;
        for (int c = 0; c < 128; ++c) { const float f = tcs[tb + ((m * c) & 127)];
#pragma unroll
            for (int kk = 0; kk < 8; ++kk) acc[kk] += wrow[kk * 128 + c] * f; }
        const float s = 1.f / 1024.f;
        u32x4 o; o.x = pkh(acc[0] * s, acc[1] * s); o.y = pkh(acc[2] * s, acc[3] * s); o.z = pkh(acc[4] * s, acc[5] * s); o.w = pkh(acc[6] * s, acc[7] * s);
        *(u32x4*)(WT + (size_t)(128 * g + mp) * 1024 + k0) = o;
    }
    LDS_WAIT(); asm volatile("" ::: "memory");
}
__device__ __forceinline__ void hid_rows(Frame& F, int gw, int NGW) {
    LOCAL_IDS();
    const float* w1 = F.in[15]; const float* b1 = F.in[16]; const float* fr = F.in[17]; const float* w2 = F.in[18]; const float* b2 = F.in[19];
    float* HID2 = (float*)(F.ws + WS_HID2);
    LAS float* wl = (LAS float*)F.lds;
    __syncthreads();
    for (int e = tid; e < 33 * 64; e += 512) wl[e] = w1[e];
    for (int e = tid; e < 64 * 64; e += 512) wl[33 * 64 + e] = w2[e];
    __syncthreads();
    const int j = lane;
    const float bb1 = b1[j], bb2 = b2[j], fq = fr[j];
    for (int t = gw; t < FILT_T; t += NGW) {
        const int L = t < SEQ ? SEQ : CTXL, tt = t < SEQ ? t : t - SEQ;
        float z = 0.f;
        if (j == 0) z = (float)tt / (float)(L - 1);
        else if (j < 33) { const int bnd = (j - 1) & 15; const float band = 1e-4f + (float)bnd * ((15.f - 1e-4f) / 15.f);
            const float rev = (float)tt * band / (float)L;
            z = (j <= 16) ? cos_rev(rev) : -sin_rev(rev); }
        float a1 = bb1;
#pragma unroll
        for (int i = 0; i < 33; ++i) a1 += __shfl(z, i) * wl[i * 64 + j];
        const float h1 = sin_rad(fq * a1);
        float a2 = bb2;
#pragma unroll
        for (int i = 0; i < 64; ++i) a2 += __shfl(h1, i) * wl[(33 + i) * 64 + j];
        HID2[(size_t)t * 64 + j] = sin_rad(fq * a2);
    }
    __syncthreads();
}
__device__ __forceinline__ void ada_items(Frame& F) {
    LOCAL_IDS();
    const float* c = F.in[1]; const float* cctx = F.in[3]; const float* aw = F.in[4]; const float* ab = F.in[5];
    float* MOD = (float*)(F.ws + WS_MOD);
    LAS float* sl = (LAS float*)F.lds;
    LAS float* red = (LAS float*)(F.lds + 16384);
    bool have = false;
    for (int it = F.vcu; it < 192; it += F.G) {
        if (!have) { for (int e = tid; e < 3072; e += 512) { const int r = e >> 10, k = e & 1023; const float v = r < 2 ? c[r * 1024 + k] : cctx[k]; sl[e] = silu_f(v); } have = true; __syncthreads(); }
        const int layer = it / 96, n0 = (it % 96) * 64;
        const int kq = tid >> 4, cq = tid & 15;
        f32x4 a0 = {0.f, 0.f, 0.f, 0.f}, a1 = a0, a2 = a0;
        const float* wp = aw + ((size_t)layer * 1024) * 6144 + n0 + 4 * cq;
#pragma unroll 4
        for (int kk = kq; kk < 1024; kk += 32) { const f32x4 w = *(const f32x4*)(wp + (size_t)kk * 6144);
            a0 += w * sl[kk]; a1 += w * sl[1024 + kk]; a2 += w * sl[2048 + kk]; }
#pragma unroll
        for (int e = 0; e < 4; ++e) { red[(kq * 3 + 0) * 64 + 4 * cq + e] = a0[e]; red[(kq * 3 + 1) * 64 + 4 * cq + e] = a1[e]; red[(kq * 3 + 2) * 64 + 4 * cq + e] = a2[e]; }
        __syncthreads();
        if (tid < 192) { const int r = tid >> 6, col = tid & 63; float s = ab[layer * 6144 + n0 + col];
            for (int q = 0; q < 32; ++q) s += red[(q * 3 + r) * 64 + col];
            MOD[(size_t)(layer * 3 + r) * 6144 + n0 + col] = s; }
        __syncthreads();
    }
}
__device__ __forceinline__ void p0_prep(Frame& F) {
    LOCAL_IDS();
    const int gw = F.vcu * NWAVES + wave, NGW = F.G * NWAVES;
    ada_items(F);
    __syncthreads();
    LAS float* scr = (LAS float*)(F.lds + wave * 16384);
    f16* Win_t = (f16*)(F.ws + WS_WIN);
    constexpr int I_WIN = 16 * 48, I_WOUT = 16 * 32, I_G = 16 * 88, I_D = 44 * 32, I_QKV = 16 * 96, I_O1 = 16 * 32;
    constexpr int NIT = I_WIN + I_WOUT + 4 * I_G + 2 * I_D + I_QKV + I_O1;
    for (int it = gw; it < NIT; it += NGW) {
        int r = it;
        if (r < I_WIN) { const int kb = r / 48, nb = r % 48; transpose_item(F.in[11], 2048, Win_t, 1024, 64 * kb, 512 + 32 * nb, 0, scr, lane); continue; } r -= I_WIN;
        if (r < I_WOUT) { const int kb = r / 32, nb = r % 32; transpose_item(F.in[12], 1024, (f16*)(F.ws + WS_WOUT0), 1024, 64 * kb, 32 * nb, 0, scr, lane); continue; } r -= I_WOUT;
        if (r < 4 * I_G) { const int which = r / I_G, rr = r % I_G, layer = which >> 1, up = which & 1; const int kb = rr / 88, nb = rr % 88, n0 = 32 * nb;
            const float* src = (up ? F.in[9] : F.in[8]) + (size_t)layer * 1024 * DFF;
            f16* dst = (f16*)(F.ws + (layer ? WS_WGU1 : WS_WGU0));
            const int drow0 = (n0 >> 7) * 256 + (up ? 128 : 0) + (n0 & 127) - n0;
            transpose_item(src, DFF, dst, 1024, 64 * kb, n0, drow0, scr, lane); continue; } r -= 4 * I_G;
        if (r < 2 * I_D) { const int layer = r / I_D, rr = r % I_D; const int kb = rr / 32, nb = rr % 32;
            transpose_item(F.in[10] + (size_t)layer * DFF * 1024, 1024, (f16*)(F.ws + (layer ? WS_WD1 : WS_WD0)), DFF, 64 * kb, 32 * nb, 0, scr, lane); continue; } r -= 2 * I_D;
        if (r < I_QKV) { const int kb = r / 96, nb = r % 96; transpose_item(F.in[22], 3072, (f16*)(F.ws + WS_WQKV), 1024, 64 * kb, 32 * nb, 0, scr, lane); continue; } r -= I_QKV;
        { const int kb = r / 32, nb = r % 32; transpose_item(F.in[23], 1024, (f16*)(F.ws + WS_WO1), 1024, 64 * kb, 32 * nb, 0, scr, lane); }
    }
    for (int it = gw; it < 512; it += NGW) fold_item(F.in[11], Win_t, it >> 7, (it & 127) * 8, scr, lane);
    hid_rows(F, gw, NGW);
}

__device__ __forceinline__ void norm_mod_row(const float* xrow, const float* g, const float* sh, const float* sc, f16* orow, int lane) {
    const f32x4* xr = (const f32x4*)xrow + lane;
    f32x4 v[4]; float s = 0.f;
#pragma unroll
    for (int j = 0; j < 4; ++j) { v[j] = xr[64 * j]; s += (v[j].x * v[j].x + v[j].y * v[j].y) + (v[j].z * v[j].z + v[j].w * v[j].w); }
    const float rstd = 1.f / sqrtf(wave_sum(s) * (1.f / DM) + RMS_EPS);
    u32x2* o8 = (u32x2*)orow + lane;
#pragma unroll
    for (int j = 0; j < 4; ++j) { const f32x4 gg = ((const f32x4*)g)[lane + 64 * j], s1 = ((const f32x4*)sc)[lane + 64 * j], s0 = ((const f32x4*)sh)[lane + 64 * j];
        const f32x4 y = (v[j] * rstd) * gg * (s1 + 1.f) + s0;
        u32x2 w; w.x = pkh(y.x, y.y); w.y = pkh(y.z, y.w); o8[64 * j] = w; }
}
__device__ __forceinline__ void norm_phase(Frame& F, const float* hl, const float* hc, const float* g, int layer, int sh_off, int sc_off, f16* U, int nrows) {
    LOCAL_IDS();
    const int gw = F.vcu * NWAVES + wave, NGW = F.G * NWAVES;
    const float* MOD = (const float*)(F.ws + WS_MOD) + (size_t)layer * 3 * 6144;
    for (int m = gw; m < nrows; m += NGW) {
        const int r = m < MLAT ? (m >> 13) : 2;
        const float* src = m < MLAT ? hl + (size_t)m * DM : hc + (size_t)(m - MLAT) * DM;
        norm_mod_row(src, g, MOD + r * 6144 + sh_off, MOD + r * 6144 + sc_off, U + (size_t)m * DM, lane);
    }
}
__device__ __forceinline__ void final_phase(Frame& F) {
    LOCAL_IDS();
    const int gw = F.vcu * NWAVES + wave, NGW = F.G * NWAVES;
    const float* g = F.in[25];
    for (int m = gw; m < MLAT; m += NGW) {
        f32x4* xr = (f32x4*)(F.out + (size_t)m * DM) + lane;
        f32x4 v[4]; float s = 0.f;
#pragma unroll
        for (int j = 0; j < 4; ++j) { v[j] = xr[64 * j]; s += (v[j].x * v[j].x + v[j].y * v[j].y) + (v[j].z * v[j].z + v[j].w * v[j].w); }
        const float rstd = 1.f / sqrtf(wave_sum(s) * (1.f / DM) + RMS_EPS);
#pragma unroll
        for (int j = 0; j < 4; ++j) xr[64 * j] = (v[j] * rstd) * ((const f32x4*)g)[lane + 64 * j];
    }
}

__device__ __forceinline__ void filt_gemm(Frame& F) {
    LOCAL_IDS();
    const int gw = F.vcu * NWAVES + wave, NGW = F.G * NWAVES;
    const float* HID2 = (const float*)(F.ws + WS_HID2); const float* w3 = F.in[20];
    f16* FILT = (f16*)(F.ws + WS_FILT);
    const int li = lane & 15, lg = lane >> 4;
    constexpr int NTB = FILT_T / 64;
    const int cb = gw & 127, ch0 = cb * 16;
    float bf[16];
#pragma unroll
    for (int kk = 0; kk < 16; ++kk) bf[kk] = w3[(size_t)(16 * lg + kk) * 2048 + ch0 + li];
    const int ch = ch0 + li, c = ch & 511;
    const float mind = -3.0701134573253945f, maxd = -15.350567286626973f;
    const float delta = fabsf(mind + (float)c * ((maxd - mind) / 511.f));
    for (int tb = gw >> 7; tb < NTB; tb += NGW >> 7) {
        const int t0 = tb * 64;
#pragma unroll
        for (int s = 0; s < 4; ++s) {
            f32x4 acc = {0.f, 0.f, 0.f, 0.f};
            const f32x4* hp = (const f32x4*)(HID2 + (size_t)(t0 + 16 * s + li) * 64 + 16 * lg);
            const f32x4 h0 = hp[0], h1 = hp[1], h2 = hp[2], h3 = hp[3];
#pragma unroll
            for (int kk = 0; kk < 4; ++kk) acc = __builtin_amdgcn_mfma_f32_16x16x4f32(h0[kk], bf[kk], acc, 0, 0, 0);
#pragma unroll
            for (int kk = 0; kk < 4; ++kk) acc = __builtin_amdgcn_mfma_f32_16x16x4f32(h1[kk], bf[4 + kk], acc, 0, 0, 0);
#pragma unroll
            for (int kk = 0; kk < 4; ++kk) acc = __builtin_amdgcn_mfma_f32_16x16x4f32(h2[kk], bf[8 + kk], acc, 0, 0, 0);
#pragma unroll
            for (int kk = 0; kk < 4; ++kk) acc = __builtin_amdgcn_mfma_f32_16x16x4f32(h3[kk], bf[12 + kk], acc, 0, 0, 0);
            const int tq = t0 + 16 * s + 4 * lg;
            float o[4];
#pragma unroll
            for (int e = 0; e < 4; ++e) { const int t = tq + e; const float t01 = t < SEQ ? (float)t * (1.f / (SEQ - 1)) : (float)(t - SEQ) * (1.f / (CTXL - 1)); o[e] = acc[e] * __expf(-t01 * delta); }
            u32x2 w; w.x = pkh(o[0], o[1]); w.y = pkh(o[2], o[3]);
            *(u32x2*)(FILT + (size_t)ch * FILT_T + tq) = w;
        }
    }
}

struct EpiCM {
    f16* T; int ld;
    __device__ __forceinline__ void operator()(const f32x4 (&acc)[2][2][4][2], const pg8::Unit& u, int wr, int wc, int fr, int fq) const {
#pragma unroll
        for (int ai = 0; ai < 2; ++ai)
#pragma unroll
            for (int m = 0; m < 4; ++m) { const int row = u.pm * 256 + ai * 128 + wr * 64 + m * 16 + 4 * fq;
#pragma unroll
                for (int bj = 0; bj < 2; ++bj)
#pragma unroll
                    for (int n = 0; n < 2; ++n) { const int col = u.pn * 256 + bj * 128 + wc * 32 + n * 16 + fr; const f32x4 v = acc[ai][bj][m][n];
                        u32x2 w; w.x = pkh(v[0], v[1]); w.y = pkh(v[2], v[3]); *(u32x2*)(T + (size_t)col * ld + row) = w; } }
    }
};
struct EpiResid {
    const float* baseL; const float* baseC; float* dstL; float* dstC; const float* gate;
    __device__ __forceinline__ void operator()(const f32x4 (&acc)[2][2][4][2], const pg8::Unit& u, int wr, int wc, int fr, int fq) const {
#pragma unroll
        for (int ai = 0; ai < 2; ++ai)
#pragma unroll
            for (int m = 0; m < 4; ++m) { const int row = u.pm * 256 + ai * 128 + wr * 64 + m * 16 + fr;
                const bool lat = row < MLAT; const int rmod = lat ? (row >> 13) : 2;
                const size_t ro = lat ? (size_t)row * DM : (size_t)(row - MLAT) * DM;
                const float* bp = (lat ? baseL : baseC) + ro; float* dp = (lat ? dstL : dstC) + ro; const float* gp = gate + rmod * 6144;
#pragma unroll
                for (int bj = 0; bj < 2; ++bj)
#pragma unroll
                    for (int n = 0; n < 2; ++n) { const int col = u.pn * 256 + bj * 128 + wc * 32 + n * 16 + 4 * fq;
                        const f32x4 b = *(const f32x4*)(bp + col), gg = *(const f32x4*)(gp + col);
#ifdef DBG_ZERO_GATE
                        *(f32x4*)(dp + col) = b + gg * 0.f;
#else
                        *(f32x4*)(dp + col) = b + gg * acc[ai][bj][m][n];
#endif
                        } }
    }
};
struct EpiGU {
    f16* ACT;
    __device__ __forceinline__ void operator()(const f32x4 (&acc)[2][2][4][2], const pg8::Unit& u, int wr, int wc, int fr, int fq) const {
#pragma unroll
        for (int ai = 0; ai < 2; ++ai)
#pragma unroll
            for (int m = 0; m < 4; ++m) { const int row = u.pm * 256 + ai * 128 + wr * 64 + m * 16 + fr;
#pragma unroll
                for (int n = 0; n < 2; ++n) { const int col = u.pn * 128 + wc * 32 + n * 16 + 4 * fq; const f32x4 g = acc[ai][0][m][n], up = acc[ai][1][m][n];
                    float o[4];
#pragma unroll
                    for (int e = 0; e < 4; ++e) o[e] = g[e] / (1.f + __expf(-g[e])) * up[e];
                    u32x2 w; w.x = pkh(o[0], o[1]); w.y = pkh(o[2], o[3]); *(u32x2*)(ACT + (size_t)row * DFF + col) = w; } }
    }
};
struct EpiQKV {
    f16* Q; f16* KC; float qscale;
    __device__ __forceinline__ void operator()(const f32x4 (&acc)[2][2][4][2], const pg8::Unit& u, int wr, int wc, int fr, int fq) const {
        const int which = u.pn >> 2; const float sc = which == 0 ? qscale : 1.f;
        f16* latp = Q + (size_t)which * (16u << 20); f16* ctxp = KC + (size_t)(which > 0 ? which - 1 : 0) * (512u << 10);
#pragma unroll
        for (int ai = 0; ai < 2; ++ai)
#pragma unroll
            for (int m = 0; m < 4; ++m) { const int row = u.pm * 256 + ai * 128 + wr * 64 + m * 16 + fr; const bool lat = row < MLAT;
                if (!lat && which == 0) continue;
                const int b = lat ? (row >> 13) : ((row - MLAT) >> 8), t = lat ? (row & 8191) : ((row - MLAT) & 255);
#pragma unroll
                for (int bj = 0; bj < 2; ++bj)
#pragma unroll
                    for (int n = 0; n < 2; ++n) { const int col = (u.pn & 3) * 256 + bj * 128 + wc * 32 + n * 16 + 4 * fq; const int h = col >> 6, d = col & 63;
                        f16* dst = lat ? latp + (((size_t)(b * NHEAD + h) * SEQ + t) * HD + d) : ctxp + (((size_t)(b * NHEAD + h) * CTXL + t) * HD + d);
                        const f32x4 v = acc[ai][bj][m][n] * sc; u32x2 w; w.x = pkh(v[0], v[1]); w.y = pkh(v[2], v[3]); *(u32x2*)dst = w; } }
    }
};

__device__ constexpr float C32T[16] = {1.f, 0.98078528040323f, 0.92387953251129f, 0.83146961230255f, 0.70710678118655f, 0.55557023301960f, 0.38268343236509f, 0.19509032201613f,
                                       0.f, -0.19509032201613f, -0.38268343236509f, -0.55557023301960f, -0.70710678118655f, -0.83146961230255f, -0.92387953251129f, -0.98078528040323f};
__device__ constexpr float S32T[16] = {0.f, 0.19509032201613f, 0.38268343236509f, 0.55557023301960f, 0.70710678118655f, 0.83146961230255f, 0.92387953251129f, 0.98078528040323f,
                                       1.f, 0.98078528040323f, 0.92387953251129f, 0.83146961230255f, 0.70710678118655f, 0.55557023301960f, 0.38268343236509f, 0.19509032201613f};
__device__ constexpr int BR5[32] = {0,16,8,24,4,20,12,28,2,18,10,26,6,22,14,30,1,17,9,25,5,21,13,29,3,19,11,27,7,23,15,31};
__device__ constexpr int BR4[16] = {0,8,4,12,2,10,6,14,1,9,5,13,3,11,7,15};
__device__ constexpr int BR3[8] = {0,4,2,6,1,5,3,7};
__device__ __forceinline__ constexpr int brev(int i, int bits) { return bits == 5 ? BR5[i] : (bits == 4 ? BR4[i] : BR3[i]); }
template <int R> __device__ __forceinline__ void dif_fwd(float (&re)[R], float (&im)[R]) {
    constexpr int LG = R == 32 ? 5 : (R == 16 ? 4 : (R == 8 ? 3 : (R == 4 ? 2 : 1)));
#pragma unroll
    for (int st = 0; st < LG; ++st) {
        const int m = R >> st, hm = m >> 1, ts = 32 / m;
#pragma unroll
        for (int b = 0; b < R; b += m)
#pragma unroll
            for (int j = 0; j < hm; ++j) {
                const int i0 = b + j, i1 = b + j + hm, tw = j * ts;
                const float ar = re[i0], ai = im[i0], cr = re[i1], ci = im[i1];
                re[i0] = ar + cr; im[i0] = ai + ci;
                const float dr = ar - cr, di = ai - ci;
                if (tw == 0) { re[i1] = dr; im[i1] = di; }
                else if (tw == 8) { re[i1] = di; im[i1] = -dr; }
                else { const float c = C32T[tw], s = S32T[tw]; re[i1] = dr * c + di * s; im[i1] = di * c - dr * s; }
            }
    }
}
template <int R> __device__ __forceinline__ void dit_inv(float (&re)[R], float (&im)[R]) {
    constexpr int LG = R == 32 ? 5 : (R == 16 ? 4 : (R == 8 ? 3 : (R == 4 ? 2 : 1)));
#pragma unroll
    for (int st = LG - 1; st >= 0; --st) {
        const int m = R >> st, hm = m >> 1, ts = 32 / m;
#pragma unroll
        for (int b = 0; b < R; b += m)
#pragma unroll
            for (int j = 0; j < hm; ++j) {
                const int i0 = b + j, i1 = b + j + hm, tw = j * ts;
                const float ar = re[i0], ai = im[i0], cr = re[i1], ci = im[i1];
                float tr, ti;
                if (tw == 0) { tr = cr; ti = ci; }
                else if (tw == 8) { tr = -ci; ti = cr; }
                else { const float c = C32T[tw], s = S32T[tw]; tr = cr * c - ci * s; ti = ci * c + cr * s; }
                re[i0] = ar + tr; im[i0] = ai + ti; re[i1] = ar - tr; im[i1] = ai - ti;
            }
    }
}
__device__ __forceinline__ int fpad(int i) { return i + (i >> 5); }
__device__ __forceinline__ void tw_fwd(float& x, float& y, float rev) { const float c = __builtin_amdgcn_cosf(rev), s = __builtin_amdgcn_sinf(rev); const float a = x * c + y * s, b = y * c - x * s; x = a; y = b; }
__device__ __forceinline__ void tw_inv(float& x, float& y, float rev) { const float c = __builtin_amdgcn_cosf(rev), s = __builtin_amdgcn_sinf(rev); const float a = x * c - y * s, b = y * c + x * s; x = a; y = b; }

__device__ __forceinline__ void fft_s2_fwd(LAS f32x2* buf, int tid) {
    asm volatile("" : "+v"(tid));
    const int kk = tid >> 5, n3 = tid & 31;
    LAS f32x2* pb = buf + fpad(kk * 1024 + n3);
    float re[32], im[32];
#pragma unroll
    for (int n2 = 0; n2 < 32; ++n2) { const f32x2 v = pb[33 * n2]; re[n2] = v.x; im[n2] = v.y; }
    dif_fwd<32>(re, im);
#pragma unroll
    for (int p = 0; p < 32; ++p) { const int k2 = brev(p, 5); tw_fwd(re[p], im[p], (float)(n3 * k2) * (1.f / 1024.f)); pb[33 * k2] = (f32x2){re[p], im[p]}; }
}
__device__ __forceinline__ void fft_s2_inv(LAS f32x2* buf, int tid) {
    asm volatile("" : "+v"(tid));
    const int k1 = tid >> 5, n3 = tid & 31;
    LAS f32x2* pb = buf + fpad(k1 * 1024 + n3);
    float re[32], im[32];
#pragma unroll
    for (int p = 0; p < 32; ++p) { const f32x2 v = pb[33 * brev(p, 5)]; re[p] = v.x; im[p] = v.y; }
    dit_inv<32>(re, im);
#pragma unroll
    for (int n2 = 0; n2 < 32; ++n2) { tw_inv(re[n2], im[n2], (float)((n2 * 32 + n3) * k1) * (1.f / 16384.f)); pb[33 * n2] = (f32x2){re[n2], im[n2]}; }
}
__device__ __forceinline__ void fft_s3_conv(LAS f32x2* buf, int tid, const f32x2* H) {
    asm volatile("" : "+v"(tid));
    const int k2 = tid & 31;
    LAS f32x2* pb = buf + fpad((tid >> 5) * 1024 + k2 * 32);
    const f32x2* hp = H + tid;
    float re[32], im[32];
#pragma unroll
    for (int n3 = 0; n3 < 32; ++n3) { const f32x2 v = pb[n3]; re[n3] = v.x; im[n3] = v.y; }
    dif_fwd<32>(re, im);
#pragma unroll
    for (int p = 0; p < 32; ++p) { const f32x2 h = hp[p * 512]; const float a = re[p] * h.x - im[p] * h.y, b = re[p] * h.y + im[p] * h.x; re[p] = a; im[p] = b; }
    dit_inv<32>(re, im);
#pragma unroll
    for (int n3 = 0; n3 < 32; ++n3) { tw_inv(re[n3], im[n3], (float)(n3 * k2) * (1.f / 1024.f)); pb[n3] = (f32x2){re[n3], im[n3]}; }
}

__device__ __forceinline__ void hyena_task(Frame& F, int c) {
    LAS f32x2* buf = (LAS f32x2*)F.lds;
    LAS float* scr = (LAS float*)(F.lds + SCR_OFF);
    int tid = threadIdx.x; asm volatile("" : "+v"(tid));
    const int lane = tid & 63, wave = __builtin_amdgcn_readfirstlane(tid >> 6);
    u16* PT = (u16*)(F.ws + WS_PT);
    const u16* FILT = (const u16*)(F.ws + WS_FILT);
    f32x2* HS = (f32x2*)(F.ws + WS_HS) + (size_t)blockIdx.x * 32768;
    unsigned* XS = (unsigned*)(F.ws + WS_XS) + (size_t)blockIdx.x * (32 * 512);
    const float* cw = F.in[13]; const float* cb = F.in[14]; const float* skip = F.in[21];
    {
        const u16* f1 = FILT + (size_t)(c) * FILT_T; const u16* f2 = FILT + (size_t)(512 + c) * FILT_T;
        const u16* b1 = FILT + (size_t)(1024 + c) * FILT_T; const u16* b2 = FILT + (size_t)(1536 + c) * FILT_T;
        float a1 = 0.f, a2 = 0.f;
        if (tid == 0) { a1 = fabsf(h2f(b1[0])); a2 = fabsf(h2f(b2[0])); }
#pragma unroll
        for (int jj = 0; jj < 2; ++jj) {
            __builtin_amdgcn_sched_barrier(0); int j = tid + 512 * jj; asm volatile("" : "+v"(j));
            float re[16], im[16];
#pragma unroll
            for (int n1 = 0; n1 < 16; ++n1) { const int n = n1 * 1024 + j;
                if (n1 < 8) { re[n1] = h2f(f1[n]); im[n1] = h2f(f2[n]); }
                else if (n == 8192) { re[n1] = 0.f; im[n1] = 0.f; }
                else { re[n1] = h2f(b1[16384 - n]); im[n1] = h2f(b2[16384 - n]); }
                a1 += fabsf(re[n1]); a2 += fabsf(im[n1]); }
            dif_fwd<16>(re, im);
#pragma unroll
            for (int p = 0; p < 16; ++p) { const int k1 = brev(p, 4); tw_fwd(re[p], im[p], (float)(j * k1) * (1.f / 16384.f)); (buf + fpad(j))[1056 * k1] = (f32x2){re[p], im[p]}; }
        }
        a1 = wave_sum(a1); a2 = wave_sum(a2);
        if (lane == 0) { scr[wave * 2] = a1; scr[wave * 2 + 1] = a2; }
        __syncthreads();
        float n1s = 0.f, n2s = 0.f;
#pragma unroll
        for (int w = 0; w < 8; ++w) { n1s += scr[2 * w]; n2s += scr[2 * w + 1]; }
        const float inv1 = 0.5f / (n1s * 16384.f), inv2 = 0.5f / (n2s * 16384.f);
        const float ska = skip[c] * (1.f / 16384.f), skb = skip[512 + c] * (1.f / 16384.f);
        fft_s2_fwd(buf, tid);
        __syncthreads();
        {
            const int k1 = tid >> 5, k2 = tid & 31;
            LAS f32x2* pb = buf + fpad(k1 * 1024 + k2 * 32);
            float re[32], im[32];
#pragma unroll
            for (int n3 = 0; n3 < 32; ++n3) { const f32x2 v = pb[n3]; re[n3] = v.x; im[n3] = v.y; }
            dif_fwd<32>(re, im);
#pragma unroll
            for (int p = 0; p < 32; ++p) pb[brev(p, 5)] = (f32x2){re[p], im[p]};
            __syncthreads();
            f32x2* hp = HS + tid;
#pragma unroll
            for (int p = 0; p < 32; ++p) {
                const int k = k1 + 16 * k2 + 512 * brev(p, 5), km = (16384 - k) & 16383;
                const f32x2 zm = buf[fpad((km & 15) * 1024 + ((km >> 4) & 31) * 32 + (km >> 9))];
                const float sr = re[p] + zm.x, si = im[p] - zm.y;
                const float dr = re[p] - zm.x, di = im[p] + zm.y;
                hp[p * 512] = (f32x2){sr * inv1 + ska, si * inv1};
                hp[16384 + p * 512] = (f32x2){di * inv2 + skb, -dr * inv2};
                if ((p & 3) == 3) __builtin_amdgcn_sched_barrier(0);
            }
        }
        __syncthreads();
    }
    unsigned vpk[16];
    {
        LAS u16* raw = (LAS u16*)F.lds;
#pragma unroll
        for (int w = 0; w < 3; ++w) {
            const u16* row = PT + (size_t)(512 + 512 * w + c) * PT_LD;
#pragma unroll
            for (int i = 0; i < 4; ++i) { const int e = (i * 512 + tid) * 8;
                *(LAS u32x4*)(raw + w * 16384 + e) = *(const u32x4*)(row + e); }
        }
        __syncthreads();
#pragma unroll
        for (int w = 0; w < 3; ++w) {
            const int ch = 512 * w + c;
            const float w0 = cw[ch], w1 = cw[1536 + ch], w2 = cw[3072 + ch], bias = cb[ch];
#pragma unroll
            for (int idx = 0; idx < 16; ++idx) { const int n = (idx & 7) * 1024 + tid + 512 * (idx >> 3);
                const LAS u16* p0 = raw + w * 16384 + n; const LAS u16* p1 = p0 + SEQ;
                const float a0 = n > 0 ? h2f(p0[-1]) : 0.f, a1 = h2f(p0[0]), a2 = n < SEQ - 1 ? h2f(p0[1]) : 0.f;
                const float c0 = n > 0 ? h2f(p1[-1]) : 0.f, c1 = h2f(p1[0]), c2 = n < SEQ - 1 ? h2f(p1[1]) : 0.f;
                const unsigned pk = pkh(w0 * a0 + w1 * a1 + w2 * a2 + bias, w0 * c0 + w1 * c1 + w2 * c2 + bias);
                if (w < 2) XS[(w * 16 + idx) * 512 + tid] = pk; else vpk[idx] = pk;
                if ((idx & 3) == 3) __builtin_amdgcn_sched_barrier(0); }
        }
        __syncthreads();
    }
#define XS_LD(w, idx, lo, hi) do { const f16x2 _v = __builtin_bit_cast(f16x2, XS[((w) * 16 + (idx)) * 512 + tid]); lo = (float)_v[0]; hi = (float)_v[1]; } while (0)
#pragma unroll
    for (int jj = 0; jj < 2; ++jj) {
        __builtin_amdgcn_sched_barrier(0); int j = tid + 512 * jj; asm volatile("" : "+v"(j));
        float re[16], im[16];
#pragma unroll
        for (int n1 = 0; n1 < 8; ++n1) { const f16x2 v = __builtin_bit_cast(f16x2, vpk[jj * 8 + n1]); re[n1] = (float)v[0]; im[n1] = (float)v[1]; }
#pragma unroll
        for (int n1 = 8; n1 < 16; ++n1) { re[n1] = 0.f; im[n1] = 0.f; }
        dif_fwd<16>(re, im);
#pragma unroll
        for (int p = 0; p < 16; ++p) { const int k1 = brev(p, 4); tw_fwd(re[p], im[p], (float)(j * k1) * (1.f / 16384.f)); (buf + fpad(j))[1056 * k1] = (f32x2){re[p], im[p]}; }
    }
    __syncthreads();
    fft_s2_fwd(buf, tid); __syncthreads();
    fft_s3_conv(buf, tid, HS); __syncthreads();
    fft_s2_inv(buf, tid); __syncthreads();
#pragma unroll
    for (int jj = 0; jj < 2; ++jj) {
        __builtin_amdgcn_sched_barrier(0); int j = tid + 512 * jj; asm volatile("" : "+v"(j));
        float re[16], im[16];
#pragma unroll
        for (int p = 0; p < 16; ++p) { const f32x2 v = (buf + fpad(j))[1056 * brev(p, 4)]; re[p] = v.x; im[p] = v.y; }
        dit_inv<16>(re, im);
#pragma unroll
        for (int n1 = 0; n1 < 8; ++n1) { float x0, x1; XS_LD(0, jj * 8 + n1, x0, x1); re[n1] *= x0; im[n1] *= x1; }
#pragma unroll
        for (int n1 = 8; n1 < 16; ++n1) { re[n1] = 0.f; im[n1] = 0.f; }
        dif_fwd<16>(re, im);
#pragma unroll
        for (int p = 0; p < 16; ++p) { const int k1 = brev(p, 4); tw_fwd(re[p], im[p], (float)(j * k1) * (1.f / 16384.f)); (buf + fpad(j))[1056 * k1] = (f32x2){re[p], im[p]}; }
    }
    __syncthreads();
    fft_s2_fwd(buf, tid); __syncthreads();
    fft_s3_conv(buf, tid, HS + 16384); __syncthreads();
    fft_s2_inv(buf, tid); __syncthreads();
    u16* yrow = PT + (size_t)(512 + c) * PT_LD;
#pragma unroll
    for (int jj = 0; jj < 2; ++jj) {
        __builtin_amdgcn_sched_barrier(0); int j = tid + 512 * jj; asm volatile("" : "+v"(j));
        float re[16], im[16];
#pragma unroll
        for (int p = 0; p < 16; ++p) { const f32x2 v = (buf + fpad(j))[1056 * brev(p, 4)]; re[p] = v.x; im[p] = v.y; }
        dit_inv<16>(re, im);
#pragma unroll
        for (int n1 = 0; n1 < 8; ++n1) { float x0, x1; XS_LD(1, jj * 8 + n1, x0, x1);
            yrow[n1 * 1024 + j] = __builtin_bit_cast(u16, (f16)(x0 * re[n1])); yrow[SEQ + n1 * 1024 + j] = __builtin_bit_cast(u16, (f16)(x1 * im[n1])); }
    }
#undef XS_LD
    __syncthreads();
}

__device__ __forceinline__ void fourier_task(Frame& F, int task) {
    LAS f32x2* buf = (LAS f32x2*)F.lds;
    int tid = threadIdx.x; asm volatile("" : "+v"(tid));
    const int b = task >> 7, g = (task >> 5) & 3, q = task & 31;
    u16* PT = (u16*)(F.ws + WS_PT);
    const int mA[2] = {q, q == 0 ? 32 : 64 - q};
    const size_t tok0 = (size_t)b * SEQ;
#pragma unroll
    for (int f = 0; f < 2; ++f) {
        const u16* rA = PT + (size_t)(128 * g + mA[f]) * PT_LD + tok0; const u16* rB = PT + (size_t)(128 * g + 64 + mA[f]) * PT_LD + tok0;
        const float sg = (f == 0 && q == 0) ? 1.f : -1.f;
#pragma unroll
        for (int jj = 0; jj < 2; ++jj) {
            __builtin_amdgcn_sched_barrier(0); int j = tid + 512 * jj; asm volatile("" : "+v"(j));
            float re[8], im[8];
#pragma unroll
            for (int n1 = 0; n1 < 8; ++n1) { re[n1] = h2f(rA[n1 * 1024 + j]); im[n1] = sg * h2f(rB[n1 * 1024 + j]); }
            dif_fwd<8>(re, im);
#pragma unroll
            for (int p = 0; p < 8; ++p) { const int k1 = brev(p, 3); tw_fwd(re[p], im[p], (float)(j * k1) * (1.f / 8192.f)); (buf + fpad(j))[1056 * (f * 8 + k1)] = (f32x2){re[p], im[p]}; }
        }
    }
    __syncthreads();
    fft_s2_fwd(buf, tid);
    __syncthreads();
    {
        const int kk = tid >> 5, k2 = tid & 31, f = kk >> 3, k1 = kk & 7;
        LAS f32x2* pb = buf + fpad(kk * 1024 + k2 * 32);
        float re[32], im[32];
#pragma unroll
        for (int n3 = 0; n3 < 32; ++n3) { const f32x2 v = pb[n3]; re[n3] = v.x; im[n3] = v.y; }
        dif_fwd<32>(re, im);
        __syncthreads();
        { LAS f32x2* pn = buf + fpad(f * 8192 + k1 + 8 * k2);
#pragma unroll
        for (int p = 0; p < 32; ++p) pn[264 * brev(p, 5)] = (f32x2){re[p], im[p]}; }
    }
    __syncthreads();
#pragma unroll
    for (int f = 0; f < 2; ++f) {
        const bool packed = (f == 0 && q == 0);
        const int m = mA[f];
        u16* o1 = PT + (size_t)(128 * g + (packed ? 0 : m)) * PT_LD + tok0;
        u16* o2 = PT + (size_t)(128 * g + (packed ? 64 : 128 - m)) * PT_LD + tok0;
        for (int l = tid; l < SEQ; l += 512) {
            const f32x2 a = buf[fpad(f * 8192 + l)], c = buf[fpad(f * 8192 + ((SEQ - l) & (SEQ - 1)))];
            const float y1 = packed ? 0.5f * (a.x + c.x) : a.x, y2 = packed ? 0.5f * (a.y + c.y) : c.x;
            o1[l] = __builtin_bit_cast(u16, (f16)y1); o2[l] = __builtin_bit_cast(u16, (f16)y2);
        }
    }
    __syncthreads();
}

__device__ __forceinline__ void fourier_ctx_task(Frame& F, int task) {
    LAS float* zr = (LAS float*)F.lds;
    LAS float* zi = zr + 512;
    LAS float* tc = zr + 1024;
    LAS float* ts = zr + 1280;
    LAS float* fr = zr + 1536;
    LAS float* fi = zr + 2048;
    int tid = threadIdx.x; asm volatile("" : "+v"(tid));
    const int f = tid >> 8, k = tid & 255;
    const int b = task >> 7, g = (task >> 5) & 3, q = task & 31;
    u16* PT = (u16*)(F.ws + WS_PT);
    const int m = f == 0 ? q : (q == 0 ? 32 : 64 - q);
    const bool packed = (f == 0 && q == 0);
    const size_t tok0 = (size_t)MLAT + (size_t)b * CTXL;
    const u16* rA = PT + (size_t)(128 * g + m) * PT_LD + tok0; const u16* rB = PT + (size_t)(128 * g + 64 + m) * PT_LD + tok0;
    zr[tid] = h2f(rA[k]); zi[tid] = (packed ? 1.f : -1.f) * h2f(rB[k]);
    if (tid < 256) { tc[tid] = cos_rev((float)tid * (1.f / 256.f)); ts[tid] = sin_rev((float)tid * (1.f / 256.f)); }
    __syncthreads();
    float ar = 0.f, ai = 0.f;
    for (int l = 0; l < 256; ++l) { const float x = zr[f * 256 + l], y = zi[f * 256 + l]; const int e = (k * l) & 255; const float c = tc[e], s = ts[e];
        ar += x * c + y * s; ai += y * c - x * s; }
    fr[tid] = ar; fi[tid] = ai;
    __syncthreads();
    const int km = f * 256 + ((256 - k) & 255);
    const float sc = 5.656854249492381f;
    const float y1 = packed ? 0.5f * (ar + fr[km]) : ar, y2 = packed ? 0.5f * (ai + fi[km]) : fr[km];
    u16* o1 = PT + (size_t)(128 * g + (packed ? 0 : m)) * PT_LD + tok0; u16* o2 = PT + (size_t)(128 * g + (packed ? 64 : 128 - m)) * PT_LD + tok0;
    o1[k] = __builtin_bit_cast(u16, (f16)(y1 * sc)); o2[k] = __builtin_bit_cast(u16, (f16)(y2 * sc));
    __syncthreads();
}
__device__ __forceinline__ void hyena_ctx_task(Frame& F, int c) {
    LAS float* fw = (LAS float*)F.lds;
    LAS float* bw = fw + 512;
    LAS float* vv = fw + 1024;
    LAS float* scr = fw + 1536;
    LOCAL_IDS();
    const int b = tid >> 8, t = tid & 255;
    u16* PT = (u16*)(F.ws + WS_PT);
    const u16* FILT = (const u16*)(F.ws + WS_FILT);
    const float* cw = F.in[13]; const float* cb = F.in[14]; const float* skip = F.in[21];
    const float fwv = h2f(FILT[(size_t)(b * 512 + c) * FILT_T + SEQ + t]), bwv = h2f(FILT[(size_t)(1024 + b * 512 + c) * FILT_T + SEQ + t]);
    float a = wave_sum(fabsf(fwv) + fabsf(bwv));
    if (lane == 0) scr[wave] = a;
    fw[tid] = fwv; bw[tid] = bwv;
    const size_t tok = (size_t)MLAT + (size_t)b * CTXL + t;
    auto sc3 = [&](int ch) { const u16* p = PT + (size_t)(512 + ch) * PT_LD + tok;
        const float a0 = t > 0 ? h2f(p[-1]) : 0.f, a1 = h2f(p[0]), a2 = t < CTXL - 1 ? h2f(p[1]) : 0.f;
        return cw[ch] * a0 + cw[1536 + ch] * a1 + cw[3072 + ch] * a2 + cb[ch]; };
    const float x1 = sc3(c), x2 = sc3(512 + c), v0 = sc3(1024 + c);
    vv[tid] = v0;
    __syncthreads();
    const float nr0 = scr[0] + scr[1] + scr[2] + scr[3], nr1 = scr[4] + scr[5] + scr[6] + scr[7];
    float y = 0.f;
    for (int s = 0; s < 256; ++s) { const float u = vv[b * 256 + s]; const float h = s <= t ? fw[t - s] : bw[s - t]; y += u * h; }
    const float v1 = x1 * (y / nr0 + skip[c] * v0);
    __syncthreads();
    vv[tid] = v1;
    __syncthreads();
    y = 0.f;
    for (int s = 0; s < 256; ++s) { const float u = vv[b * 256 + s]; const float h = s <= t ? fw[256 + t - s] : bw[256 + s - t]; y += u * h; }
    const float o = x2 * (y / nr1 + skip[512 + c] * v1);
    __syncthreads();
    PT[(size_t)(512 + c) * PT_LD + tok] = __builtin_bit_cast(u16, (f16)o);
    __syncthreads();
}
__device__ __forceinline__ void p3_fft(Frame& F) {
    for (int c = F.vcu; c < 512; c += F.G) hyena_task(F, c);
    for (int t = F.vcu; t < 256; t += F.G) fourier_task(F, t);
    for (int t = F.vcu; t < 256; t += F.G) fourier_ctx_task(F, t);
    for (int c = F.vcu; c < 512; c += F.G) hyena_ctx_task(F, c);
}

__device__ __forceinline__ void p4_transpose(Frame& F) {
    LOCAL_IDS();
    const int gw = F.vcu * NWAVES + wave, NGW = F.G * NWAVES;
    const u16* YT = (const u16*)(F.ws + WS_PT); u16* Y = (u16*)(F.ws + WS_Y);
    LAS u16* scr = (LAS u16*)(F.lds + wave * 16384);
    constexpr int NRB = MALL / 64;
    for (int it = gw; it < 16 * NRB; it += NGW) {
        const int cb = it / NRB, rb = it % NRB;
#pragma unroll
        for (int i = 0; i < 8; ++i) { const int ch = (lane >> 3) + 8 * i, seg = lane & 7;
            const u32x4 v = *(const u32x4*)(YT + (size_t)(cb * 64 + ch) * PT_LD + rb * 64 + 8 * seg);
            *(LAS u32x4*)(scr + ch * 72 + 8 * seg) = v; }
        LDS_WAIT(); asm volatile("" ::: "memory");
#pragma unroll
        for (int i = 0; i < 8; ++i) { const int tk = (lane >> 3) + 8 * i, seg = lane & 7;
            unsigned w[4];
#pragma unroll
            for (int e = 0; e < 4; ++e) { const unsigned lo = scr[(8 * seg + 2 * e) * 72 + tk], hi = scr[(8 * seg + 2 * e + 1) * 72 + tk]; w[e] = lo | (hi << 16); }
            *(u32x4*)(Y + (size_t)(rb * 64 + tk) * DM + cb * 64 + 8 * seg) = (u32x4){w[0], w[1], w[2], w[3]}; }
        LDS_WAIT(); asm volatile("" ::: "memory");
    }
}

constexpr int NA_KOFF = 0, NA_VOFF = 73728, NA_BIAS = 147456;
typedef short v4i16_t __attribute__((ext_vector_type(4)));
__device__ __forceinline__ f16x4 lds_tr(unsigned addr) { return __builtin_bit_cast(f16x4, __builtin_amdgcn_ds_read_tr16_b64_v4i16((LAS v4i16_t*)addr)); }
template <bool VSWZ> __device__ __forceinline__ void na_stage(const f16* src, unsigned ldsbase, int nchunk, int tid) {
    for (int cidx = tid; cidx < nchunk; cidx += 512) {
        const int key = cidx >> 3, ch = cidx & 7;
        const u32x4 v = *(const u32x4*)(src + (size_t)cidx * 8);
        const int slot = VSWZ ? ((((ch >> 1) ^ ((key >> 1) & 3)) << 1) | (ch & 1)) : (ch ^ (key & 7));
        *(LAS u32x4*)(ldsbase + key * 128 + slot * 16) = v;
    }
}
__device__ __forceinline__ void p11_na(Frame& F) {
    LOCAL_IDS();
    const f16* Q = (const f16*)(F.ws + WS_Q); const f16* K = (const f16*)(F.ws + WS_K); const f16* V = (const f16*)(F.ws + WS_V);
    const f16* KC = (const f16*)(F.ws + WS_KC); const f16* VC = (const f16*)(F.ws + WS_VC); f16* O = (f16*)(F.ws + WS_O);
    const unsigned lds0 = (unsigned)(uintptr_t)F.lds;
    for (int it = F.vcu * 8; it < 2048; it += F.G * 8) {
        { const int h = (it >> 6) & 15; const float* src = F.in[24] + (size_t)h * 465; LAS float* tb = (LAS float*)(F.lds + NA_BIAS);
          __syncthreads();
          if (tid < 465) tb[tid] = src[tid] * LOG2E;
        }
#pragma unroll 1
        for (int ii = 0; ii < 8; ++ii) {
            const int item = it + ii; if (item >= 2048) break;
            int tid = threadIdx.x; asm volatile("" : "+v"(tid));
            const int lane = tid & 63, wave = __builtin_amdgcn_readfirstlane(tid >> 6);
            const int bh = item >> 6, rp = item & 63, b = bh >> 4, h = bh & 15;
            const int r0 = 2 * rp, r = r0 + (wave >> 2), chunk = wave & 3;
            const int rsA = r0 - 4 < 0 ? 0 : (r0 - 4 > 120 ? 120 : r0 - 4);
            const int rs = r - 4 < 0 ? 0 : (r - 4 > 120 ? 120 : r - 4);
            const int rsB = r0 + 1 - 4 < 0 ? 0 : (r0 + 1 - 4 > 120 ? 120 : r0 + 1 - 4);
            const int nrows = 8 + (rsB - rsA);
            __syncthreads();
            na_stage<false>(K + ((size_t)bh * SEQ + rsA * 64) * HD, lds0 + NA_KOFF, nrows * 512, tid);
            na_stage<true>(V + ((size_t)bh * SEQ + rsA * 64) * HD, lds0 + NA_VOFF, nrows * 512, tid);
            const int q = lane & 15, g = lane >> 4;
            const int kstart = chunk == 0 ? 0 : (chunk == 1 ? 8 : (chunk == 2 ? 24 : 32));
            const int off = chunk == 0 ? 15 : (chunk == 3 ? -1 : 7);
            const int ws = chunk == 0 ? (q > 8 ? q - 8 : 0) : (chunk == 3 ? (q + 8 < 16 ? q + 8 : 16) : q);
            const f16* Qp = Q + ((size_t)bh * SEQ + r * 64 + 16 * chunk + q) * HD + 8 * g;
            const f16x8 q0 = *(const f16x8*)Qp, q1 = *(const f16x8*)(Qp + 32);
            const int lr = rs - rsA;
            unsigned ka[2][2];
#pragma unroll
            for (int kb = 0; kb < 2; ++kb)
#pragma unroll
                for (int ks = 0; ks < 2; ++ks) { const int key = 64 * lr + kstart + 16 * kb + q; ka[kb][ks] = lds0 + NA_KOFF + key * 128 + (((4 * ks + g) ^ (key & 7)) << 4); }
            unsigned va[4];
            { const int qq = (lane & 15) >> 2, p = lane & 3; const int key = 64 * lr + kstart + 4 * g + qq;
#pragma unroll
              for (int db = 0; db < 4; ++db) va[db] = lds0 + NA_VOFF + key * 128 + ((db ^ ((key >> 1) & 3)) << 5) + 8 * p; }
            int bidx[2][4];
#pragma unroll
            for (int kb = 0; kb < 2; ++kb)
#pragma unroll
                for (int e = 0; e < 4; ++e) { const int kc = 16 * kb + 4 * g + e; const bool ok = kc >= ws && kc < ws + 16; const int dc = kc - q + off; bidx[kb][e] = ok ? ((rs - r + 7) * 31 + dc) : -1; }
            f32x4 o[4];
#pragma unroll
            for (int db = 0; db < 4; ++db) o[db] = (f32x4){0.f, 0.f, 0.f, 0.f};
            float m = -INFINITY, l = 0.f;
            const LAS float* rpb = (const LAS float*)(F.lds + NA_BIAS);
            __syncthreads();
#define NA_STEP(S0, S1, KA00, KA01, KA10, KA11, VOFF) do { \
                S0 = __builtin_amdgcn_mfma_f32_16x16x32_f16(*(const LAS f16x8*)(KA00), q0, S0, 0, 0, 0); \
                S0 = __builtin_amdgcn_mfma_f32_16x16x32_f16(*(const LAS f16x8*)(KA01), q1, S0, 0, 0, 0); \
                S1 = __builtin_amdgcn_mfma_f32_16x16x32_f16(*(const LAS f16x8*)(KA10), q0, S1, 0, 0, 0); \
                S1 = __builtin_amdgcn_mfma_f32_16x16x32_f16(*(const LAS f16x8*)(KA11), q1, S1, 0, 0, 0); \
                float mx_ = fmaxf(fmaxf(fmaxf(S0[0], S0[1]), fmaxf(S0[2], S0[3])), fmaxf(fmaxf(S1[0], S1[1]), fmaxf(S1[2], S1[3]))); \
                mx_ = fmaxf(mx_, __shfl_xor(mx_, 16)); mx_ = fmaxf(mx_, __shfl_xor(mx_, 32)); \
                const float mn_ = fmaxf(m, mx_); const float alpha_ = __builtin_amdgcn_exp2f(m - mn_); m = mn_; \
                f16x8 pf_; float ps_ = 0.f; \
                _Pragma("unroll") for (int e = 0; e < 4; ++e) { const float p0_ = __builtin_amdgcn_exp2f(S0[e] - mn_), p1_ = __builtin_amdgcn_exp2f(S1[e] - mn_); ps_ += p0_ + p1_; pf_[e] = (f16)p0_; pf_[4 + e] = (f16)p1_; } \
                l = l * alpha_ + ps_; \
                _Pragma("unroll") for (int db = 0; db < 4; ++db) { const f16x4 v0_ = lds_tr(va[db] + (VOFF)), v1_ = lds_tr(va[db] + (VOFF) + 2048); \
                    const f16x8 vv_ = {v0_[0], v0_[1], v0_[2], v0_[3], v1_[0], v1_[1], v1_[2], v1_[3]}; \
                    o[db] = __builtin_amdgcn_mfma_f32_16x16x32_f16(vv_, pf_, o[db] * alpha_, 0, 0, 0); } } while (0)
#pragma unroll
            for (int i = 0; i < 8; ++i) {
                f32x4 s0, s1;
#pragma unroll
                for (int e = 0; e < 4; ++e) { s0[e] = bidx[0][e] >= 0 ? rpb[bidx[0][e] + 31 * i] : -INFINITY; s1[e] = bidx[1][e] >= 0 ? rpb[bidx[1][e] + 31 * i] : -INFINITY; }
                NA_STEP(s0, s1, ka[0][0] + 8192 * i, ka[0][1] + 8192 * i, ka[1][0] + 8192 * i, ka[1][1] + 8192 * i, 8192 * i);
            }
            __syncthreads();
            na_stage<false>(KC + (size_t)bh * CTXL * HD, lds0 + NA_KOFF, 2048, tid);
            na_stage<true>(VC + (size_t)bh * CTXL * HD, lds0 + NA_VOFF, 2048, tid);
            unsigned kc2[2][2];
#pragma unroll
            for (int kb = 0; kb < 2; ++kb)
#pragma unroll
                for (int ks = 0; ks < 2; ++ks) { const int key = 16 * kb + q; kc2[kb][ks] = lds0 + NA_KOFF + key * 128 + (((4 * ks + g) ^ (key & 7)) << 4); }
            { const int qq = (lane & 15) >> 2, p = lane & 3; const int key = 4 * g + qq;
#pragma unroll
              for (int db = 0; db < 4; ++db) va[db] = lds0 + NA_VOFF + key * 128 + ((db ^ ((key >> 1) & 3)) << 5) + 8 * p; }
            __syncthreads();
#pragma unroll
            for (int i = 0; i < 8; ++i) {
                f32x4 s0 = {0.f, 0.f, 0.f, 0.f}, s1 = s0;
                NA_STEP(s0, s1, kc2[0][0] + 4096 * i, kc2[0][1] + 4096 * i, kc2[1][0] + 4096 * i, kc2[1][1] + 4096 * i, 4096 * i);
            }
#undef NA_STEP
            l += __shfl_xor(l, 16); l += __shfl_xor(l, 32);
            const float rinv = 1.f / l;
            f16* op = O + ((size_t)b * SEQ + r * 64 + 16 * chunk + q) * DM + h * 64 + 4 * g;
#pragma unroll
            for (int db = 0; db < 4; ++db) { const f32x4 v = o[db] * rinv; u32x2 w; w.x = pkh(v[0], v[1]); w.y = pkh(v[2], v[3]); *(u32x2*)(op + 16 * db) = w; }
        }
    }
    __syncthreads();
}

struct Args { const float* in[26]; float* out; unsigned char* ws; int ph_lo, ph_hi; };
constexpr int NPHASE = 17;

__global__ void __launch_bounds__(NWAVES * 64, 2) fwd_kernel(Args args) {
    extern __shared__ __attribute__((aligned(16))) unsigned char lds[];
    Frame F;
    F.lds = (LAS unsigned char*)lds;
    F.G = gridDim.x; { const int bx = blockIdx.x; F.vcu = (F.G % 8 == 0) ? (bx % 8) * (F.G / 8) + bx / 8 : bx; }
    F.in = args.in;
    F.out = args.out; F.ws = args.ws;
    volatile LAS unsigned* MISC = (volatile LAS unsigned*)(F.lds + MISC_OFF);
    if (threadIdx.x < 64) MISC[threadIdx.x] = 0u;
    __syncthreads();
    unsigned* ctl = (unsigned*)(F.ws + WS_CTL);
    XcdBarrier bar; bar.bar = ctl + CW_BAR; bar.x = 0; bar.st = nullptr;
    const int lo = args.ph_lo, hi = args.ph_hi;
    if (hi - lo > 1) bar = xcd_barrier_post(ctl + CW_BAR, MISC + 8);
#define REFRESH() do { \
        { int z_ = 0; asm volatile("" : "+s"(z_)); F.in = args.in + z_; F.ws = args.ws + z_; F.out = args.out + z_; } \
        ws = F.ws; MOD = (const float*)(ws + WS_MOD); HC = (float*)(ws + WS_HC); } while (0)
#ifndef PH_MASK
#define PH_MASK 0x1FFFF
#endif
#define IN(k) (((PH_MASK >> (k)) & 1) && lo <= (k) && (k) < hi)
#define SEAM(k) do { if (lo <= (k) && (k) + 1 < hi) xcd_barrier(bar); } while (0)
    unsigned char* ws; const float* MOD; float* HC;
    LAS unsigned char* ring = F.lds;

#ifdef PROBE_MASK
    unsigned long long probe_acc = 0;
#endif
    for (int ph = lo; ph < hi; ++ph) {
#ifdef PROBE_MASK
        const unsigned long long probe_t0 = __builtin_amdgcn_s_memrealtime();
#endif
        REFRESH();
        switch (ph) {
    case 0: if (!((PH_MASK >> 0) & 1)) break; { p0_prep(F); } break;
    case 1: if (!((PH_MASK >> 1) & 1)) break; { norm_phase(F, F.in[0], F.in[2], F.in[6], 0, 0, 1024, (f16*)(ws + WS_U), MALL); filt_gemm(F); } break;
    case 2: if (!((PH_MASK >> 2) & 1)) break; {
        pg8::Gemm g{(const f16*)(ws + WS_U), (const f16*)(ws + WS_WIN), MALL, 2048, 1024}; pg8::StaticOrder S; S.init(MALL, 2048, F.G, (int)blockIdx.x);
        EpiCM E{(f16*)(ws + WS_PT), PT_LD};
        pg8::gemm_phase<EpiCM, pg8::StaticOrder, true>(ring, g, S, E);
    } break;
    case 3: if (!((PH_MASK >> 3) & 1)) break; { p3_fft(F); } break;
    case 4: if (!((PH_MASK >> 4) & 1)) break; { p4_transpose(F); } break;
    case 5: if (!((PH_MASK >> 5) & 1)) break; {
        pg8::Gemm g{(const f16*)(ws + WS_Y), (const f16*)(ws + WS_WOUT0), MALL, 1024, 1024}; pg8::StaticOrder S; S.init(MALL, 1024, F.G, (int)blockIdx.x);
        EpiResid E{F.in[0], F.in[2], F.out, HC, MOD + 2048};
        pg8::gemm_phase<EpiResid, pg8::StaticOrder, false>(ring, g, S, E);
    } break;
    case 6: if (!((PH_MASK >> 6) & 1)) break; { norm_phase(F, F.out, HC, F.in[7], 0, 3072, 4096, (f16*)(ws + WS_U2), MALL); } break;
    case 7: if (!((PH_MASK >> 7) & 1)) break; {
        pg8::Gemm g{(const f16*)(ws + WS_U2), (const f16*)(ws + WS_WGU0), MALL, 2 * DFF, 1024}; pg8::StaticOrder S; S.init(MALL, 2 * DFF, F.G, (int)blockIdx.x);
        EpiGU E{(f16*)(ws + WS_ACT)};
        pg8::gemm_phase<EpiGU, pg8::StaticOrder, false>(ring, g, S, E);
    } break;
    case 8: if (!((PH_MASK >> 8) & 1)) break; {
        pg8::Gemm g{(const f16*)(ws + WS_ACT), (const f16*)(ws + WS_WD0), MALL, 1024, DFF}; pg8::StaticOrder S; S.init(MALL, 1024, F.G, (int)blockIdx.x);
        EpiResid E{F.out, HC, F.out, HC, MOD + 5120};
        pg8::gemm_phase<EpiResid, pg8::StaticOrder, false>(ring, g, S, E);
    } break;
    case 9: if (!((PH_MASK >> 9) & 1)) break; { norm_phase(F, F.out, HC, F.in[6] + 1024, 1, 0, 1024, (f16*)(ws + WS_U1), MALL); } break;
    case 10: if (!((PH_MASK >> 10) & 1)) break; {
        pg8::Gemm g{(const f16*)(ws + WS_U1), (const f16*)(ws + WS_WQKV), MALL, 3072, 1024}; pg8::QkvOrder S{F.G, (int)blockIdx.x};
        EpiQKV E{(f16*)(ws + WS_Q), (f16*)(ws + WS_KC), 0.125f * LOG2E};
        static_assert(WS_K - WS_Q == 32 * MiB && WS_V - WS_K == 32 * MiB && WS_VC - WS_KC == 1 * MiB, "EpiQKV strides");
        pg8::gemm_phase<EpiQKV, pg8::QkvOrder, false>(ring, g, S, E);
    } break;
    case 11: if (!((PH_MASK >> 11) & 1)) break; { p11_na(F); } break;
    case 12: if (!((PH_MASK >> 12) & 1)) break; {
        pg8::Gemm g{(const f16*)(ws + WS_O), (const f16*)(ws + WS_WO1), MLAT, 1024, 1024}; pg8::StaticOrder S; S.init(MLAT, 1024, F.G, (int)blockIdx.x);
        EpiResid E{F.out, HC, F.out, HC, MOD + 3 * 6144 + 2048};
        pg8::gemm_phase<EpiResid, pg8::StaticOrder, false>(ring, g, S, E);
    } break;
    case 13: if (!((PH_MASK >> 13) & 1)) break; { norm_phase(F, F.out, HC, F.in[7] + 1024, 1, 3072, 4096, (f16*)(ws + WS_U3), MLAT); } break;
    case 14: if (!((PH_MASK >> 14) & 1)) break; {
        pg8::Gemm g{(const f16*)(ws + WS_U3), (const f16*)(ws + WS_WGU1), MLAT, 2 * DFF, 1024}; pg8::StaticOrder S; S.init(MLAT, 2 * DFF, F.G, (int)blockIdx.x);
        EpiGU E{(f16*)(ws + WS_ACT1)};
        pg8::gemm_phase<EpiGU, pg8::StaticOrder, false>(ring, g, S, E);
    } break;
    case 15: if (!((PH_MASK >> 15) & 1)) break; {
        pg8::Gemm g{(const f16*)(ws + WS_ACT1), (const f16*)(ws + WS_WD1), MLAT, 1024, DFF}; pg8::StaticOrder S; S.init(MLAT, 1024, F.G, (int)blockIdx.x);
        EpiResid E{F.out, HC, F.out, HC, MOD + 3 * 6144 + 5120};
        pg8::gemm_phase<EpiResid, pg8::StaticOrder, false>(ring, g, S, E);
    } break;
    case 16: if (!((PH_MASK >> 16) & 1)) break; { final_phase(F); } break;
        default: break;
        }
        if (ph + 1 < hi) xcd_barrier(bar);
#ifdef PROBE_MASK
        if ((PROBE_MASK >> ph) & 1) probe_acc += __builtin_amdgcn_s_memrealtime() - probe_t0;
#endif
    }
#ifdef PROBE_MASK
    if (blockIdx.x == 0) { const unsigned long long t0 = __builtin_amdgcn_s_memrealtime(); while (__builtin_amdgcn_s_memrealtime() - t0 < (unsigned long long)PROBE_AMP * probe_acc) __builtin_amdgcn_s_sleep(8); }
#endif
#undef IN
#undef SEAM
}

#ifdef DBG_STOP
__global__ void dbg_dump(const u16* src, float* out, size_t n, size_t nvalid) { for (size_t i = (size_t)blockIdx.x * blockDim.x + threadIdx.x; i < n; i += (size_t)gridDim.x * blockDim.x) out[i] = i < nvalid ? h2f(src[i]) : 0.f; }
__global__ void dbg_dump32(const float* src, float* out, size_t n, size_t nvalid) { for (size_t i = (size_t)blockIdx.x * blockDim.x + threadIdx.x; i < n; i += (size_t)gridDim.x * blockDim.x) out[i] = i < nvalid ? src[i] : 0.f; }
#endif
extern "C" void kernel_launch(void* const* d_in, const int* in_sizes, int n_in, void* d_out, int out_size, void* d_ws, size_t ws_size, hipStream_t stream) {
    static int grid = 0;
    if (grid == 0) {
        if (n_in != 26 || out_size != MLAT * DM || ws_size < WS_END) { fprintf(stderr, "kernel_launch: unexpected shapes (n_in %d out %d ws %zu)\n", n_in, out_size, ws_size); grid = -1; return; }
        int dev = 0, cus = 0;
        if (hipGetDevice(&dev) != hipSuccess || hipDeviceGetAttribute(&cus, hipDeviceAttributeMultiprocessorCount, dev) != hipSuccess) { grid = -1; return; }
        if (hipFuncSetAttribute((const void*)fwd_kernel, hipFuncAttributeMaxDynamicSharedMemorySize, LDS_BYTES) != hipSuccess) { fprintf(stderr, "kernel_launch: hipFuncSetAttribute failed\n"); grid = -1; return; }
        int per_cu = 0;
        if (hipOccupancyMaxActiveBlocksPerMultiprocessor(&per_cu, (const void*)fwd_kernel, NWAVES * 64, LDS_BYTES) != hipSuccess || per_cu < 1) fprintf(stderr, "kernel_launch: occupancy query reports %d\n", per_cu);
        (void)hipGetLastError();
        grid = cus;
    }
    if (grid < 0) return;
    (void)hipMemsetAsync((char*)d_ws + WS_CTL, 0, CTL_ZERO_BYTES, stream);
    Args a{};
    for (int i = 0; i < 26; ++i) a.in[i] = (const float*)d_in[i];
    a.out = (float*)d_out; a.ws = (unsigned char*)d_ws;
#ifdef DBG_STOP
    for (int p = 0; p <= DBG_STOP; ++p) { a.ph_lo = p; a.ph_hi = p + 1; hipLaunchKernelGGL(fwd_kernel, dim3(grid), dim3(NWAVES * 64), LDS_BYTES, stream, a); }
#if DBG_F32 == 2
#elif DBG_F32
    hipLaunchKernelGGL(dbg_dump32, dim3(2048), dim3(256), 0, stream, (const float*)((const char*)d_ws + DBG_OFF), (float*)d_out, (size_t)MLAT * DM, (size_t)DBG_N);
#else
    hipLaunchKernelGGL(dbg_dump, dim3(2048), dim3(256), 0, stream, (const u16*)((const char*)d_ws + DBG_OFF), (float*)d_out, (size_t)MLAT * DM, (size_t)DBG_N);
#endif
#elif MK_PER_PHASE
    for (int p = 0; p < NPHASE; ++p) { a.ph_lo = p; a.ph_hi = p + 1; hipLaunchKernelGGL(fwd_kernel, dim3(grid), dim3(NWAVES * 64), LDS_BYTES, stream, a); }
#else
    a.ph_lo = 0; a.ph_hi = NPHASE;
    hipLaunchKernelGGL(fwd_kernel, dim3(grid), dim3(NWAVES * 64), LDS_BYTES, stream, a);
#endif
}
```

```cpp
#include <hip/hip_runtime.h>
#include <cstdio>
#include <cstdint>

#ifndef MK_PER_PHASE
#define MK_PER_PHASE 0
#endif

#define LAS __attribute__((address_space(3)))
#define GAS __attribute__((address_space(1)))
typedef _Float16 f16;
typedef _Float16 f16x8 __attribute__((ext_vector_type(8)));
typedef _Float16 f16x4 __attribute__((ext_vector_type(4)));
typedef _Float16 f16x2 __attribute__((ext_vector_type(2)));
typedef float f32x4 __attribute__((ext_vector_type(4)));
typedef float f32x2 __attribute__((ext_vector_type(2)));
typedef unsigned u32x4 __attribute__((ext_vector_type(4)));
typedef unsigned u32x2 __attribute__((ext_vector_type(2)));
typedef unsigned short u16;

__device__ __forceinline__ unsigned pkh(float lo, float hi) { f16x2 v = {(f16)lo, (f16)hi}; return __builtin_bit_cast(unsigned, v); }
__device__ __forceinline__ float h2f(u16 b) { return (float)__builtin_bit_cast(f16, b); }

constexpr int DM = 1024, BATCH = 2, SEQ = 8192, CTXL = 256, DFF = 2816;
constexpr int MLAT = BATCH * SEQ;
constexpr int MCTX = BATCH * CTXL;
constexpr int MALL = MLAT + MCTX;
constexpr int NHEAD = 16, HD = 64;
constexpr int FILT_T = SEQ + CTXL;
constexpr float RMS_EPS = 1e-6f;
constexpr float LOG2E = 1.4426950408889634f;

namespace pg8 {
constexpr int BM = 256, BK = 64, HALF = 128, HTB = HALF * BK * 2, STAGE_BYTES = 8 * HTB, NXCD = 8, WGM = 8;
__host__ __device__ __forceinline__ int lds_byte(int r, int c) { const int st = (r >> 4) * 2 + (c >> 5), rr = r & 15, cc = c & 31, ob = rr * 64 + cc * 2; return st * 1024 + (ob ^ (((ob >> 9) & 1) << 5)); }
__host__ __device__ __forceinline__ void stage_rc(int b, int& R, int& C) { const int st = b / 1024, sb = b % 1024, swz = sb ^ (((sb >> 9) & 1) << 5); R = (st >> 1) * 16 + swz / 64; C = (st & 1) * 32 + (swz % 64) / 2; }

struct Unit { int pm, pn; };
struct Gemm { const f16* A; const f16* Bt; int M, N, K; };

struct StaticOrder {
    int nM, nN, nwg, G, c;
    __device__ void init(int M, int N, int G_, int c_) { nM = M / BM; nN = N / BM; nwg = nM * nN; G = G_; c = c_; }
    __device__ bool next(int i, Unit& u) const {
        const long L = (long)i * G + c; if (L >= nwg) return false;
        int wgid = (int)L; { const int q = nwg / NXCD, r = nwg % NXCD, xcd = wgid % NXCD, off = wgid / NXCD; wgid = (xcd < r ? xcd * (q + 1) : r * (q + 1) + (xcd - r) * q) + off; }
        const int nig = WGM * nN, gid = wgid / nig, fm = gid * WGM, gsz = (nM - fm) < WGM ? (nM - fm) : WGM;
        u.pm = fm + ((wgid % nig) % gsz); u.pn = (wgid % nig) / gsz; return true;
    }
};
struct QkvOrder {
    int G, c;
    __device__ bool next(int i, Unit& u) const {
        const long L = (long)i * G + c; if (L >= 784) return false;
        if (L >= 768) { const int r = (int)L - 768; u.pm = 64 + (r & 1); u.pn = 4 + (r >> 1); return true; }
        int wgid = (int)L; { const int q = 768 / NXCD, xcd = wgid % NXCD, off = wgid / NXCD; wgid = xcd * q + off; }
        const int nig = WGM * 12, gid = wgid / nig, fm = gid * WGM;
        u.pm = fm + ((wgid % nig) % WGM); u.pn = (wgid % nig) / WGM; return true;
    }
};

template <class Epi, class Sched, bool SWAP>
__device__ __forceinline__ void gemm_phase(LAS unsigned char* lds, const Gemm g, const Sched& S, const Epi& E) {
    int tid = threadIdx.x; asm volatile("" : "+v"(tid));
    const int wid = __builtin_amdgcn_readfirstlane(tid >> 6), lane = tid & 63, wr = wid >> 2, wc = wid & 3, fr = lane & 15, fq = lane >> 4;
    const int K = g.K, nt = K / BK;
    unsigned voffA[2];
#pragma unroll
    for (int i = 0; i < 2; ++i) { int R, C; stage_rc(tid * 16 + i * 8192, R, C); voffA[i] = (unsigned)(R * K + C) * 2u; }
    const size_t kstep = (size_t)(BK * 2);
    const size_t hstep = (size_t)HALF * K * 2;
    const size_t tstep = 2 * hstep;
    const unsigned ldsw = (unsigned)wid * 1024u;
    const int aoff = lds_byte(wr * 64 + fr, fq * 8), boff = lds_byte(wc * 32 + fr, fq * 8);
#define PG8_SA(b, h) (((b) * 2 + (h)) * HTB)
#define PG8_SB(b, h) ((4 + (b) * 2 + (h)) * HTB)
#define PG8_STAGE(bufoff, gbase) do { _Pragma("unroll") for (int _i = 0; _i < 2; ++_i) \
        __builtin_amdgcn_global_load_lds((const unsigned*)((const char*)(gbase) + voffA[_i]), (LAS unsigned*)(lds + (bufoff) + ldsw + _i * 8192), 16, 0, 0); } while (0)
#define PG8_LDA(dst, b, h) do { _Pragma("unroll") for (int m = 0; m < 4; ++m) _Pragma("unroll") for (int k = 0; k < 2; ++k) dst[m][k] = *(const LAS f16x8*)(lds + PG8_SA(b, h) + aoff + m * 2048 + k * 1024); } while (0)
#define PG8_LDB(dst, b, h) do { _Pragma("unroll") for (int n = 0; n < 2; ++n) _Pragma("unroll") for (int k = 0; k < 2; ++k) dst[n][k] = *(const LAS f16x8*)(lds + PG8_SB(b, h) + boff + n * 2048 + k * 1024); } while (0)
#define PG8_MMA(ai, bj, At, Bt) do { __builtin_amdgcn_s_setprio(1); _Pragma("unroll") for (int m = 0; m < 4; ++m) _Pragma("unroll") for (int n = 0; n < 2; ++n) _Pragma("unroll") for (int k = 0; k < 2; ++k) \
        acc[ai][bj][m][n] = SWAP ? __builtin_amdgcn_mfma_f32_16x16x32_f16(At[m][k], Bt[n][k], acc[ai][bj][m][n], 0, 0, 0) \
                                 : __builtin_amdgcn_mfma_f32_16x16x32_f16(Bt[n][k], At[m][k], acc[ai][bj][m][n], 0, 0, 0); __builtin_amdgcn_s_setprio(0); } while (0)
#define PG8_WAIT_V(n) asm volatile("s_waitcnt vmcnt(" #n ")" ::: "memory")
#define PG8_WAIT_L(n) asm volatile("s_waitcnt lgkmcnt(" #n ")" ::: "memory")
#define PG8_BAR __builtin_amdgcn_s_barrier()
#define PG8_SCHED __builtin_amdgcn_sched_barrier(0)
    Unit cur, nxt; int ui = 0;
    if (!S.next(0, cur)) return;
    f32x4 acc[2][2][4][2];
#pragma unroll
    for (int a = 0; a < 2; ++a)
#pragma unroll
        for (int b = 0; b < 2; ++b)
#pragma unroll
            for (int m = 0; m < 4; ++m)
#pragma unroll
                for (int n = 0; n < 2; ++n) acc[a][b][m][n] = (f32x4){0.f, 0.f, 0.f, 0.f};
    f16x8 At[4][2], B0[2][2], B1[2][2];
    const char* cA = (const char*)g.A + (size_t)cur.pm * tstep; const char* cB = (const char*)g.Bt + (size_t)cur.pn * tstep;
    PG8_STAGE(PG8_SB(0, 0), cB); PG8_STAGE(PG8_SB(0, 1), cB + hstep); PG8_STAGE(PG8_SA(0, 0), cA); PG8_STAGE(PG8_SA(0, 1), cA + hstep);
    if (wr == 1) PG8_BAR;
    PG8_WAIT_V(2); PG8_BAR;
    PG8_STAGE(PG8_SB(1, 0), cB + kstep); PG8_STAGE(PG8_SA(1, 0), cA + kstep); PG8_STAGE(PG8_SB(1, 1), cB + hstep + kstep);
    PG8_WAIT_V(6); PG8_BAR;
    for (;;) {
        const bool has_next = S.next(ui + 1, nxt);
        const char* nA = has_next ? (const char*)g.A + (size_t)nxt.pm * tstep : cA; const char* nB = has_next ? (const char*)g.Bt + (size_t)nxt.pn * tstep : cB;
        for (int t = 0; t < nt; t += 2) {
            const bool last = (t == nt - 2);
            const char* a1 = cA + (size_t)(t + 1) * kstep;
            const char* a2 = last ? nA : cA + (size_t)(t + 2) * kstep; const char* b2 = last ? nB : cB + (size_t)(t + 2) * kstep;
            const char* a3 = a2 + kstep; const char* b3 = b2 + kstep;
            PG8_LDB(B0, 0, 0); PG8_LDB(B1, 0, 1); PG8_SCHED; PG8_LDA(At, 0, 0); PG8_STAGE(PG8_SA(1, 1), a1 + hstep);
            PG8_WAIT_V(8); PG8_WAIT_L(0); PG8_BAR; PG8_MMA(0, 0, At, B0); PG8_MMA(0, 1, At, B1); PG8_BAR; PG8_SCHED;
            PG8_LDA(At, 0, 1); PG8_STAGE(PG8_SB(0, 0), b2); PG8_STAGE(PG8_SB(0, 1), b2 + hstep); PG8_STAGE(PG8_SA(0, 0), a2);
            PG8_WAIT_V(8); PG8_WAIT_L(0); PG8_BAR; PG8_MMA(1, 0, At, B0); PG8_MMA(1, 1, At, B1); PG8_BAR; PG8_SCHED;
            PG8_LDB(B0, 1, 0); PG8_LDB(B1, 1, 1); PG8_SCHED; PG8_LDA(At, 1, 0); PG8_STAGE(PG8_SA(0, 1), a2 + hstep);
            PG8_WAIT_V(8); PG8_WAIT_L(0); PG8_BAR; PG8_MMA(0, 0, At, B0); PG8_MMA(0, 1, At, B1); PG8_BAR; PG8_SCHED;
            PG8_LDA(At, 1, 1); PG8_STAGE(PG8_SB(1, 0), b3); PG8_STAGE(PG8_SB(1, 1), b3 + hstep); PG8_STAGE(PG8_SA(1, 0), a3);
            PG8_WAIT_V(8); PG8_WAIT_L(0); PG8_BAR; PG8_MMA(1, 0, At, B0); PG8_MMA(1, 1, At, B1); PG8_BAR; PG8_SCHED;
        }
        if (wr == 0) PG8_BAR;
        E(acc, cur, wr, wc, fr, fq);
        if (!has_next) break;
#pragma unroll
        for (int a = 0; a < 2; ++a)
#pragma unroll
            for (int b = 0; b < 2; ++b)
#pragma unroll
                for (int m = 0; m < 4; ++m)
#pragma unroll
                    for (int n = 0; n < 2; ++n) acc[a][b][m][n] = (f32x4){0.f, 0.f, 0.f, 0.f};
        cur = nxt; cA = nA; cB = nB; ++ui;
        if (wr == 1) PG8_BAR;
    }
    PG8_WAIT_V(0);
    PG8_BAR;
#undef PG8_SA
#undef PG8_SB
#undef PG8_STAGE
#undef PG8_LDA
#undef PG8_LDB
#undef PG8_MMA
#undef PG8_WAIT_V
#undef PG8_WAIT_L
#undef PG8_BAR
#undef PG8_SCHED
}
}

constexpr size_t MiB = 1u << 20;
constexpr size_t WS_CTL = 0, CTL_ZERO_BYTES = 512 * 1024;
constexpr size_t WS_SSQ = 65536;
constexpr size_t WS_SHW = 1 * MiB + 256 * 1024;
constexpr size_t WS_MOD  = 1 * MiB;
constexpr size_t WS_HID2 = 2 * MiB;
constexpr size_t WS_HC   = 5 * MiB;
constexpr size_t WS_WIN  = 8 * MiB;
constexpr size_t WS_WOUT0 = 12 * MiB;
constexpr size_t WS_WGU0 = 14 * MiB;
constexpr size_t WS_WD0  = 26 * MiB;
constexpr size_t WS_WGU1 = 32 * MiB;
constexpr size_t WS_WD1  = 44 * MiB;
constexpr size_t WS_WQKV = 50 * MiB;
constexpr size_t WS_WO1  = 56 * MiB;
constexpr size_t WS_PT   = 64 * MiB;
constexpr size_t WS_FILT = 130 * MiB;
constexpr size_t WS_U    = 163 * MiB;
constexpr size_t WS_HS   = 163 * MiB;
constexpr size_t WS_XS   = 228 * MiB;
constexpr size_t WS_Y    = 130 * MiB;
constexpr size_t WS_U2   = 64 * MiB;
constexpr size_t WS_ACT  = 100 * MiB;
constexpr size_t WS_U1   = 64 * MiB;
constexpr size_t WS_Q    = 100 * MiB;
constexpr size_t WS_K    = 132 * MiB;
constexpr size_t WS_V    = 164 * MiB;
constexpr size_t WS_KC   = 198 * MiB;
constexpr size_t WS_VC   = 199 * MiB;
constexpr size_t WS_O    = 64 * MiB;
constexpr size_t WS_U3   = 100 * MiB;
constexpr size_t WS_ACT1 = 132 * MiB;
constexpr size_t WS_END  = 256 * MiB;
constexpr int PT_LD = MALL;

constexpr int CW_BAR = 4096;

constexpr int LDS_BYTES = 163840;
constexpr int FFT_BYTES = 16384 * 33 / 32 * 8;
constexpr int SCR_OFF = FFT_BYTES;
constexpr int MISC_OFF = LDS_BYTES - 256;
constexpr int NWAVES = 8;

#define RLX_AGENT __ATOMIC_RELAXED, __HIP_MEMORY_SCOPE_AGENT
#define LDS_WAIT() asm volatile("s_waitcnt lgkmcnt(0)" ::: "memory")
#define VM_WAIT() asm volatile("s_waitcnt vmcnt(0)" ::: "memory")

#define XB_TMO      128
#define XB_XCNT(j)  (256  + 64 * (j))
#define XB_XSUB(j)  (1280 + 64 * (j))
#define XB_XGEN(j)  (2304 + 64 * (j))
#define XB_TOP      3328
#define XB_TOPGEN   3392
#define XCD_BAR_WORDS 3456
#define XB_SPIN_CAP (1u << 18)
__device__ __forceinline__ unsigned xb_ld(unsigned* p)              { return __hip_atomic_load(p, __ATOMIC_RELAXED, __HIP_MEMORY_SCOPE_AGENT); }
__device__ __forceinline__ unsigned xb_add(unsigned* p, unsigned v) { return __hip_atomic_fetch_add(p, v, __ATOMIC_RELAXED, __HIP_MEMORY_SCOPE_AGENT); }
__device__ __forceinline__ unsigned xb_xcc_id() { return (unsigned)__builtin_amdgcn_s_getreg((3 << 11) | 20) & 0xFu; }
#define XB_SPIN(cond, bar) do { unsigned _sp = 0; while (cond) { __builtin_amdgcn_s_sleep(1); \
    if ((++_sp & 255u) == 0u) { if (xb_ld(&(bar)[XB_TMO])) break; if (_sp > XB_SPIN_CAP) { atomicAdd(&(bar)[XB_TMO], 1u); break; } } } } while (0)
struct XcdBarrier { unsigned* bar; unsigned x; volatile LAS unsigned* st; };
__device__ __forceinline__ XcdBarrier xcd_barrier_post(unsigned* bar, volatile LAS unsigned* st) {
    XcdBarrier b; b.bar = bar; b.x = xb_xcc_id(); b.st = st;
    if (threadIdx.x == 0) (void)xb_add(&bar[XB_XCNT(b.x)], 1u);
    return b;
}
__device__ __forceinline__ void xcd_barrier_complete(unsigned* bar, unsigned x, unsigned& nloc, unsigned& nx) {
    const unsigned G = gridDim.x * gridDim.y * gridDim.z;
    unsigned sum, cnt, mine, sp = 0u;
    for (;;) {
        sum = 0u; cnt = 0u; mine = 0u;
#pragma unroll
        for (unsigned j = 0; j < 16; ++j) { const unsigned c = xb_ld(&bar[XB_XCNT(j)]); sum += c; cnt += (c > 0u) ? 1u : 0u; mine = (j == x) ? c : mine; }
        if (sum == G) break;
        __builtin_amdgcn_s_sleep(1);
        if ((++sp & 255u) == 0u) { if (xb_ld(&bar[XB_TMO])) break; if (sp > XB_SPIN_CAP) { atomicAdd(&bar[XB_TMO], 1u); break; } }
    }
    nloc = mine > 0u ? mine : 1u; nx = cnt > 0u ? cnt : 1u;
}
__device__ __forceinline__ void xcd_barrier(const XcdBarrier& b) {
    asm volatile("s_waitcnt vmcnt(0)" ::: "memory");
    __syncthreads();
    if (threadIdx.x == 0) {
        unsigned* bar = b.bar;
        __builtin_amdgcn_s_waitcnt(0);
        unsigned nloc = b.st[0], nx = b.st[1];
        if (nloc == 0u) { xcd_barrier_complete(bar, b.x, nloc, nx); b.st[0] = nloc; b.st[1] = nx; }
        const unsigned old = xb_add(&bar[XB_XSUB(b.x)], 1u);
        const unsigned gen = old / nloc;
        if (old + 1u == (gen + 1u) * nloc) {
            __builtin_amdgcn_fence(__ATOMIC_RELEASE, "agent");
            asm volatile("s_waitcnt vmcnt(0)" ::: "memory");
            const unsigned og = xb_add(&bar[XB_TOP], 1u);
            const unsigned tg = og / nx;
            if (og + 1u == (tg + 1u) * nx) xb_add(&bar[XB_TOPGEN], 1u);
            else XB_SPIN(xb_ld(&bar[XB_TOPGEN]) == tg, bar);
            __builtin_amdgcn_fence(__ATOMIC_ACQUIRE, "agent");
            xb_add(&bar[XB_XGEN(b.x)], 1u);
            asm volatile("s_waitcnt vmcnt(0)" ::: "memory");
        } else {
            XB_SPIN(xb_ld(&bar[XB_XGEN(b.x)]) == gen, bar);
            __builtin_amdgcn_fence(__ATOMIC_ACQUIRE, "agent");
            asm volatile("s_waitcnt vmcnt(0)" ::: "memory");
        }
    }
    __syncthreads();
}

struct Frame {
    LAS unsigned char* lds;
    int vcu, G;
    unsigned long long pacc;
    const float* const* in;
    float* out; unsigned char* ws;
};
#define LOCAL_IDS() int tid = threadIdx.x; asm volatile("" : "+v"(tid)); const int lane = tid & 63; const int wave = __builtin_amdgcn_readfirstlane(tid >> 6); (void)lane; (void)wave
__device__ __forceinline__ float wave_sum(float v) {
#pragma unroll
    for (int o = 1; o < 64; o <<= 1) v += __shfl_xor(v, o);
    return v;
}
__device__ __forceinline__ float silu_f(float x) { return x / (1.f + __expf(-x)); }
__device__ __forceinline__ float sin_rev(float r) { return __builtin_amdgcn_sinf(__builtin_amdgcn_fractf(r)); }
__device__ __forceinline__ float cos_rev(float r) { return __builtin_amdgcn_cosf(__builtin_amdgcn_fractf(r)); }
__device__ __forceinline__ float sin_rad(float x) { return sin_rev(x * 0.15915494309189535f); }

__device__ __forceinline__ void transpose_item(const float* W, int N, f16* WT, int ldt, int k0, int n0, int drow0, LAS float* scr, int lane) {
#pragma unroll 8
    for (int i = 0; i < 32; ++i) { const int kk = 2 * i + (lane >> 5); scr[kk * 33 + (lane & 31)] = W[(size_t)(k0 + kk) * N + n0 + (lane & 31)]; }
    LDS_WAIT(); asm volatile("" ::: "memory");
    const int c = lane & 7;
#pragma unroll
    for (int j = 0; j < 4; ++j) { const int n = (lane >> 3) + 8 * j; const LAS float* s = scr + (8 * c) * 33 + n;
        u32x4 o; o.x = pkh(s[0 * 33], s[1 * 33]); o.y = pkh(s[2 * 33], s[3 * 33]); o.z = pkh(s[4 * 33], s[5 * 33]); o.w = pkh(s[6 * 33], s[7 * 33]);
        *(u32x4*)(WT + (size_t)(drow0 + n0 + n) * ldt + k0 + 8 * c) = o; }
    LDS_WAIT(); asm volatile("" ::: "memory");
}
__device__ __forceinline__ void fold_item(const float* Win, f16* WT, int g, int k0, LAS float* scr, int lane) {
    LAS float* wrow = scr;
    LAS float* tcs = scr + 1024;
#pragma unroll
    for (int i = 0; i < 16; ++i) { const int e = i * 64 + lane; wrow[e] = Win[(size_t)(k0 + (e >> 7)) * 2048 + 128 * g + (e & 127)]; }
    { const float r0 = (float)lane * (1.f / 128.f), r1 = (float)(lane + 64) * (1.f / 128.f);
      tcs[lane] = cos_rev(r0); tcs[lane + 64] = cos_rev(r1); tcs[128 + lane] = sin_rev(r0); tcs[128 + lane + 64] = sin_rev(r1); }
    LDS_WAIT(); asm volatile("" ::: "memory");
#pragma unroll
    for (int half = 0; half < 2; ++half) {
        const int mp = lane + 64 * half;
        const int m = (mp <= 64) ? mp : mp - 64; const int tb = (mp <= 64) ? 0 : 128;
        float acc[8];
#pragma unroll
        for (int kk = 0; kk < 8; ++kk) acc[kk] = 0.f;
        for (int c = 0; c < 128; ++c) { const float f = tcs[tb + ((m * c) & 127)];
#pragma unroll
            for (int kk = 0; kk < 8; ++kk) acc[kk] += wrow[kk * 128 + c] * f; }
        const float s = 1.f / 1024.f;
        u32x4 o; o.x = pkh(acc[0] * s, acc[1] * s); o.y = pkh(acc[2] * s, acc[3] * s); o.z = pkh(acc[4] * s, acc[5] * s); o.w = pkh(acc[6] * s, acc[7] * s);
        *(u32x4*)(WT + (size_t)(128 * g + mp) * 1024 + k0) = o;
    }
    LDS_WAIT(); asm volatile("" ::: "memory");
}
__device__ __forceinline__ void hid_rows(Frame& F, int gw, int NGW) {
    LOCAL_IDS();
    const float* w1 = F.in[15]; const float* b1 = F.in[16]; const float* fr = F.in[17]; const float* w2 = F.in[18]; const float* b2 = F.in[19];
    float* HID2 = (float*)(F.ws + WS_HID2);
    LAS float* wl = (LAS float*)F.lds;
    __syncthreads();
    for (int e = tid; e < 33 * 64; e += 512) wl[e] = w1[e];
    for (int e = tid; e < 64 * 64; e += 512) wl[33 * 64 + e] = w2[e];
    __syncthreads();
    const int j = lane;
    const float bb1 = b1[j], bb2 = b2[j], fq = fr[j];
    for (int t = gw; t < FILT_T; t += NGW) {
        const int L = t < SEQ ? SEQ : CTXL, tt = t < SEQ ? t : t - SEQ;
        float z = 0.f;
        if (j == 0) z = (float)tt / (float)(L - 1);
        else if (j < 33) { const int bnd = (j - 1) & 15; const float band = 1e-4f + (float)bnd * ((15.f - 1e-4f) / 15.f);
            const float rev = (float)tt * band / (float)L;
            z = (j <= 16) ? cos_rev(rev) : -sin_rev(rev); }
        float a1 = bb1;
#pragma unroll
        for (int i = 0; i < 33; ++i) a1 += __shfl(z, i) * wl[i * 64 + j];
        const float h1 = sin_rad(fq * a1);
        float a2 = bb2;
#pragma unroll
        for (int i = 0; i < 64; ++i) a2 += __shfl(h1, i) * wl[(33 + i) * 64 + j];
        HID2[(size_t)t * 64 + j] = sin_rad(fq * a2);
    }
    __syncthreads();
}
__device__ __forceinline__ void ada_items(Frame& F) {
    LOCAL_IDS();
    const float* c = F.in[1]; const float* cctx = F.in[3]; const float* aw = F.in[4]; const float* ab = F.in[5];
    float* MOD = (float*)(F.ws + WS_MOD);
    LAS float* sl = (LAS float*)F.lds;
    LAS float* red = (LAS float*)(F.lds + 16384);
    bool have = false;
    for (int it = F.vcu; it < 192; it += F.G) {
        if (!have) { for (int e = tid; e < 3072; e += 512) { const int r = e >> 10, k = e & 1023; const float v = r < 2 ? c[r * 1024 + k] : cctx[k]; sl[e] = silu_f(v); } have = true; __syncthreads(); }
        const int layer = it / 96, n0 = (it % 96) * 64;
        const int kq = tid >> 4, cq = tid & 15;
        f32x4 a0 = {0.f, 0.f, 0.f, 0.f}, a1 = a0, a2 = a0;
        const float* wp = aw + ((size_t)layer * 1024) * 6144 + n0 + 4 * cq;
#pragma unroll 4
        for (int kk = kq; kk < 1024; kk += 32) { const f32x4 w = *(const f32x4*)(wp + (size_t)kk * 6144);
            a0 += w * sl[kk]; a1 += w * sl[1024 + kk]; a2 += w * sl[2048 + kk]; }
#pragma unroll
        for (int e = 0; e < 4; ++e) { red[(kq * 3 + 0) * 64 + 4 * cq + e] = a0[e]; red[(kq * 3 + 1) * 64 + 4 * cq + e] = a1[e]; red[(kq * 3 + 2) * 64 + 4 * cq + e] = a2[e]; }
        __syncthreads();
        if (tid < 192) { const int r = tid >> 6, col = tid & 63; float s = ab[layer * 6144 + n0 + col];
            for (int q = 0; q < 32; ++q) s += red[(q * 3 + r) * 64 + col];
            MOD[(size_t)(layer * 3 + r) * 6144 + n0 + col] = s; }
        __syncthreads();
    }
}
__device__ __forceinline__ void p0_prep(Frame& F) {
    LOCAL_IDS();
    const int gw = F.vcu * NWAVES + wave, NGW = F.G * NWAVES;
    ada_items(F);
    __syncthreads();
    LAS float* scr = (LAS float*)(F.lds + wave * 16384);
    f16* Win_t = (f16*)(F.ws + WS_WIN);
    constexpr int I_WIN = 16 * 48, I_WOUT = 16 * 32, I_G = 16 * 88, I_D = 44 * 32, I_QKV = 16 * 96, I_O1 = 16 * 32;
    constexpr int NIT = I_WIN + I_WOUT + 4 * I_G + 2 * I_D + I_QKV + I_O1;
    for (int it = gw; it < NIT; it += NGW) {
        int r = it;
        if (r < I_WIN) { const int kb = r / 48, nb = r % 48; transpose_item(F.in[11], 2048, Win_t, 1024, 64 * kb, 512 + 32 * nb, 0, scr, lane); continue; } r -= I_WIN;
        if (r < I_WOUT) { const int kb = r / 32, nb = r % 32; transpose_item(F.in[12], 1024, (f16*)(F.ws + WS_WOUT0), 1024, 64 * kb, 32 * nb, 0, scr, lane); continue; } r -= I_WOUT;
        if (r < 4 * I_G) { const int which = r / I_G, rr = r % I_G, layer = which >> 1, up = which & 1; const int kb = rr / 88, nb = rr % 88, n0 = 32 * nb;
            const float* src = (up ? F.in[9] : F.in[8]) + (size_t)layer * 1024 * DFF;
            f16* dst = (f16*)(F.ws + (layer ? WS_WGU1 : WS_WGU0));
            const int drow0 = (n0 >> 7) * 256 + (up ? 128 : 0) + (n0 & 127) - n0;
            transpose_item(src, DFF, dst, 1024, 64 * kb, n0, drow0, scr, lane); continue; } r -= 4 * I_G;
        if (r < 2 * I_D) { const int layer = r / I_D, rr = r % I_D; const int kb = rr / 32, nb = rr % 32;
            transpose_item(F.in[10] + (size_t)layer * DFF * 1024, 1024, (f16*)(F.ws + (layer ? WS_WD1 : WS_WD0)), DFF, 64 * kb, 32 * nb, 0, scr, lane); continue; } r -= 2 * I_D;
        if (r < I_QKV) { const int kb = r / 96, nb = r % 96; transpose_item(F.in[22], 3072, (f16*)(F.ws + WS_WQKV), 1024, 64 * kb, 32 * nb, 0, scr, lane); continue; } r -= I_QKV;
        { const int kb = r / 32, nb = r % 32; transpose_item(F.in[23], 1024, (f16*)(F.ws + WS_WO1), 1024, 64 * kb, 32 * nb, 0, scr, lane); }
    }
    for (int it = gw; it < 512; it += NGW) fold_item(F.in[11], Win_t, it >> 7, (it & 127) * 8, scr, lane);
    hid_rows(F, gw, NGW);
}

__device__ __forceinline__ void norm_mod_row(const float* xrow, const float* g, const float* sh, const float* sc, f16* orow, int lane) {
    const f32x4* xr = (const f32x4*)xrow + lane;
    f32x4 v[4]; float s = 0.f;
#pragma unroll
    for (int j = 0; j < 4; ++j) { v[j] = xr[64 * j]; s += (v[j].x * v[j].x + v[j].y * v[j].y) + (v[j].z * v[j].z + v[j].w * v[j].w); }
    const float rstd = 1.f / sqrtf(wave_sum(s) * (1.f / DM) + RMS_EPS);
    u32x2* o8 = (u32x2*)orow + lane;
#pragma unroll
    for (int j = 0; j < 4; ++j) { const f32x4 gg = ((const f32x4*)g)[lane + 64 * j], s1 = ((const f32x4*)sc)[lane + 64 * j], s0 = ((const f32x4*)sh)[lane + 64 * j];
        const f32x4 y = (v[j] * rstd) * gg * (s1 + 1.f) + s0;
        u32x2 w; w.x = pkh(y.x, y.y); w.y = pkh(y.z, y.w); o8[64 * j] = w; }
}
__device__ __forceinline__ void norm_phase(Frame& F, const float* hl, const float* hc, const float* g, int layer, int sh_off, int sc_off, f16* U, int nrows) {
    LOCAL_IDS();
    const int gw = F.vcu * NWAVES + wave, NGW = F.G * NWAVES;
    const float* MOD = (const float*)(F.ws + WS_MOD) + (size_t)layer * 3 * 6144;
    for (int m = gw; m < nrows; m += NGW) {
        const int r = m < MLAT ? (m >> 13) : 2;
        const float* src = m < MLAT ? hl + (size_t)m * DM : hc + (size_t)(m - MLAT) * DM;
        norm_mod_row(src, g, MOD + r * 6144 + sh_off, MOD + r * 6144 + sc_off, U + (size_t)m * DM, lane);
    }
}
__device__ __forceinline__ void final_phase(Frame& F) {
    LOCAL_IDS();
    const int gw = F.vcu * NWAVES + wave, NGW = F.G * NWAVES;
    const float* g = F.in[25];
    for (int m = gw; m < MLAT; m += NGW) {
        f32x4* xr = (f32x4*)(F.out + (size_t)m * DM) + lane;
        f32x4 v[4]; float s = 0.f;
#pragma unroll
        for (int j = 0; j < 4; ++j) { v[j] = xr[64 * j]; s += (v[j].x * v[j].x + v[j].y * v[j].y) + (v[j].z * v[j].z + v[j].w * v[j].w); }
        const float rstd = 1.f / sqrtf(wave_sum(s) * (1.f / DM) + RMS_EPS);
#pragma unroll
        for (int j = 0; j < 4; ++j) xr[64 * j] = (v[j] * rstd) * ((const f32x4*)g)[lane + 64 * j];
    }
}

__device__ __forceinline__ void filt_gemm(Frame& F) {
    LOCAL_IDS();
    const int gw = F.vcu * NWAVES + wave, NGW = F.G * NWAVES;
    const float* HID2 = (const float*)(F.ws + WS_HID2); const float* w3 = F.in[20];
    f16* FILT = (f16*)(F.ws + WS_FILT);
    const int li = lane & 15, lg = lane >> 4;
    constexpr int NTB = FILT_T / 64;
    const int cb = gw & 127, ch0 = cb * 16;
    float bf[16];
#pragma unroll
    for (int kk = 0; kk < 16; ++kk) bf[kk] = w3[(size_t)(16 * lg + kk) * 2048 + ch0 + li];
    const int ch = ch0 + li, c = ch & 511;
    const float mind = -3.0701134573253945f, maxd = -15.350567286626973f;
    const float delta = fabsf(mind + (float)c * ((maxd - mind) / 511.f));
    for (int tb = gw >> 7; tb < NTB; tb += NGW >> 7) {
        const int t0 = tb * 64;
#pragma unroll
        for (int s = 0; s < 4; ++s) {
            f32x4 acc = {0.f, 0.f, 0.f, 0.f};
            const f32x4* hp = (const f32x4*)(HID2 + (size_t)(t0 + 16 * s + li) * 64 + 16 * lg);
            const f32x4 h0 = hp[0], h1 = hp[1], h2 = hp[2], h3 = hp[3];
#pragma unroll
            for (int kk = 0; kk < 4; ++kk) acc = __builtin_amdgcn_mfma_f32_16x16x4f32(h0[kk], bf[kk], acc, 0, 0, 0);
#pragma unroll
            for (int kk = 0; kk < 4; ++kk) acc = __builtin_amdgcn_mfma_f32_16x16x4f32(h1[kk], bf[4 + kk], acc, 0, 0, 0);
#pragma unroll
            for (int kk = 0; kk < 4; ++kk) acc = __builtin_amdgcn_mfma_f32_16x16x4f32(h2[kk], bf[8 + kk], acc, 0, 0, 0);
#pragma unroll
            for (int kk = 0; kk < 4; ++kk) acc = __builtin_amdgcn_mfma_f32_16x16x4f32(h3[kk], bf[12 + kk], acc, 0, 0, 0);
            const int tq = t0 + 16 * s + 4 * lg;
            float o[4];
#pragma unroll
            for (int e = 0; e < 4; ++e) { const int t = tq + e; const float t01 = t < SEQ ? (float)t * (1.f / (SEQ - 1)) : (float)(t - SEQ) * (1.f / (CTXL - 1)); o[e] = acc[e] * __expf(-t01 * delta); }
            u32x2 w; w.x = pkh(o[0], o[1]); w.y = pkh(o[2], o[3]);
            *(u32x2*)(FILT + (size_t)ch * FILT_T + tq) = w;
        }
    }
}

__device__ __forceinline__ void shw_tasks(Frame& F) {
    LOCAL_IDS();
    const int gw = F.vcu * NWAVES + wave, NGW = F.G * NWAVES;
    const float* MOD = (const float*)(F.ws + WS_MOD); float* SHW = (float*)(F.ws + WS_SHW);
    for (int n = gw; n < 5632 + 3072 + 5632; n += NGW) {
        const f16* wrow; const float* sh; float* dst; int N;
        if (n < 5632) { wrow = (const f16*)(F.ws + WS_WGU0) + (size_t)n * 1024; sh = MOD + 3072; dst = SHW + n; N = 5632; }
        else if (n < 5632 + 3072) { const int j = n - 5632; wrow = (const f16*)(F.ws + WS_WQKV) + (size_t)j * 1024; sh = MOD + 3 * 6144; dst = SHW + 3 * 5632 + j; N = 3072; }
        else { const int j = n - 5632 - 3072; wrow = (const f16*)(F.ws + WS_WGU1) + (size_t)j * 1024; sh = MOD + 3 * 6144 + 3072; dst = SHW + 3 * 5632 + 3 * 3072 + j; N = 5632; }
        const f16x8 w0 = *(const f16x8*)(wrow + 16 * lane), w1 = *(const f16x8*)(wrow + 16 * lane + 8);
        float a[3];
#pragma unroll
        for (int r = 0; r < 3; ++r) { const float* sp = sh + r * 6144 + 16 * lane; float acc = 0.f;
#pragma unroll
            for (int e = 0; e < 8; ++e) acc += sp[e] * (float)w0[e] + sp[8 + e] * (float)w1[e];
            a[r] = wave_sum(acc); }
        if (lane == 0) { dst[0] = a[0]; dst[N] = a[1]; dst[2 * N] = a[2]; }
    }
}

__device__ __forceinline__ void cm_frag(f16* T, int ld, int col, int row, const f32x4 v) { u32x2 w; w.x = pkh(v[0], v[1]); w.y = pkh(v[2], v[3]); *(u32x2*)(T + (size_t)col * ld + row) = w; }
struct ResidP { const float* baseL; const float* baseC; float* dstL; float* dstC; const float* gate; f16* An; const float* gamma; const float* scale; float* ssq; };
template <bool NEXT> __device__ __forceinline__ float resid_frag(const ResidP& P, int row, int col, const f32x4 acc) {
    const bool lat = row < MLAT; const int rmod = lat ? (row >> 13) : 2;
    const size_t ro = (lat ? (size_t)row : (size_t)(row - MLAT)) * DM + col;
    const f32x4 b = *(const f32x4*)((lat ? P.baseL : P.baseC) + ro), gg = *(const f32x4*)(P.gate + rmod * 6144 + col);
    const f32x4 hn = b + gg * acc;
    *(f32x4*)((lat ? P.dstL : P.dstC) + ro) = hn;
    if (!NEXT) return 0.f;
    const f32x4 ga = *(const f32x4*)(P.gamma + col), sc = *(const f32x4*)(P.scale + rmod * 6144 + col);
    const f32x4 a = hn * ga * (sc + 1.f);
    u32x2 w; w.x = pkh(a[0], a[1]); w.y = pkh(a[2], a[3]); *(u32x2*)(P.An + (size_t)row * DM + col) = w;
    return (hn[0] * hn[0] + hn[1] * hn[1]) + (hn[2] * hn[2] + hn[3] * hn[3]);
}
template <bool NEXT> struct EpiResid {
    ResidP P;
    __device__ __forceinline__ void operator()(const f32x4 (&acc)[2][2][4][2], const pg8::Unit& u, int wr, int wc, int fr, int fq) const {
#pragma unroll
        for (int ai = 0; ai < 2; ++ai)
#pragma unroll
            for (int m = 0; m < 4; ++m) { const int row = u.pm * 256 + ai * 128 + wr * 64 + m * 16 + fr;
                float sq = 0.f;
#pragma unroll
                for (int bj = 0; bj < 2; ++bj)
#pragma unroll
                    for (int n = 0; n < 2; ++n) sq += resid_frag<NEXT>(P, row, u.pn * 256 + bj * 128 + wc * 32 + n * 16 + 4 * fq, acc[ai][bj][m][n]);
                if (NEXT) { sq += __shfl_xor(sq, 16); sq += __shfl_xor(sq, 32); if (fq == 0) atomicAdd(P.ssq + row, sq); } }
    }
};
struct EpiCM {
    f16* T; int ld;
    __device__ __forceinline__ void operator()(const f32x4 (&acc)[2][2][4][2], const pg8::Unit& u, int wr, int wc, int fr, int fq) const {
#pragma unroll
        for (int ai = 0; ai < 2; ++ai)
#pragma unroll
            for (int m = 0; m < 4; ++m) { const int row = u.pm * 256 + ai * 128 + wr * 64 + m * 16 + 4 * fq;
#pragma unroll
                for (int bj = 0; bj < 2; ++bj)
#pragma unroll
                    for (int n = 0; n < 2; ++n) cm_frag(T, ld, u.pn * 256 + bj * 128 + wc * 32 + n * 16 + fr, row, acc[ai][bj][m][n]); }
    }
};
struct GuP { f16* ACT; const float* ssq; const float* shw; };
__device__ __forceinline__ void gu_frag(const GuP& P, int row, int hcol, int gcol, const f32x4 ga, const f32x4 ua, float rstd, int rmod) {
    const f32x4 g = ga * rstd + *(const f32x4*)(P.shw + rmod * 5632 + gcol), up = ua * rstd + *(const f32x4*)(P.shw + rmod * 5632 + gcol + 128);
    float o[4];
#pragma unroll
    for (int e = 0; e < 4; ++e) o[e] = g[e] / (1.f + __expf(-g[e])) * up[e];
    u32x2 w; w.x = pkh(o[0], o[1]); w.y = pkh(o[2], o[3]); *(u32x2*)(P.ACT + (size_t)row * DFF + hcol) = w;
}
struct EpiGU {
    GuP P;
    __device__ __forceinline__ void operator()(const f32x4 (&acc)[2][2][4][2], const pg8::Unit& u, int wr, int wc, int fr, int fq) const {
#pragma unroll
        for (int ai = 0; ai < 2; ++ai)
#pragma unroll
            for (int m = 0; m < 4; ++m) { const int row = u.pm * 256 + ai * 128 + wr * 64 + m * 16 + fr;
                const int rmod = row < MLAT ? (row >> 13) : 2; const float rstd = 1.f / sqrtf(P.ssq[row] * (1.f / DM) + RMS_EPS);
#pragma unroll
                for (int n = 0; n < 2; ++n) gu_frag(P, row, u.pn * 128 + wc * 32 + n * 16 + 4 * fq, u.pn * 256 + wc * 32 + n * 16 + 4 * fq, acc[ai][0][m][n], acc[ai][1][m][n], rstd, rmod); }
    }
};
struct QkvP { f16* Q; f16* KC; float qscale; const float* ssq; const float* shw; };
__device__ __forceinline__ void qkv_frag(const QkvP& P, int row, int c, const f32x4 acc, float rstd) {
    const bool lat = row < MLAT; const int which = c >> 10, col = c & 1023, h = col >> 6, d = col & 63;
    const int b = lat ? (row >> 13) : ((row - MLAT) >> 8), t = lat ? (row & 8191) : ((row - MLAT) & 255), rmod = lat ? b : 2;
    f16* dst = lat ? P.Q + (size_t)which * (16u << 20) + (((size_t)(b * NHEAD + h) * SEQ + t) * HD + d)
                   : P.KC + (size_t)(which > 0 ? which - 1 : 0) * (512u << 10) + (((size_t)(b * NHEAD + h) * CTXL + t) * HD + d);
    const float sc = which == 0 ? P.qscale : 1.f;
    const f32x4 v = (acc * rstd + *(const f32x4*)(P.shw + rmod * 3072 + c)) * sc; u32x2 w; w.x = pkh(v[0], v[1]); w.y = pkh(v[2], v[3]); *(u32x2*)dst = w;
}
struct EpiQKV {
    QkvP P;
    __device__ __forceinline__ void operator()(const f32x4 (&acc)[2][2][4][2], const pg8::Unit& u, int wr, int wc, int fr, int fq) const {
#pragma unroll
        for (int ai = 0; ai < 2; ++ai)
#pragma unroll
            for (int m = 0; m < 4; ++m) { const int row = u.pm * 256 + ai * 128 + wr * 64 + m * 16 + fr;
                const float rstd = 1.f / sqrtf(P.ssq[row] * (1.f / DM) + RMS_EPS);
#pragma unroll
                for (int bj = 0; bj < 2; ++bj)
#pragma unroll
                    for (int n = 0; n < 2; ++n) qkv_frag(P, row, u.pn * 256 + bj * 128 + wc * 32 + n * 16 + 4 * fq, acc[ai][bj][m][n], rstd); }
    }
};

__device__ __forceinline__ unsigned ctx_slot(int r, int c) { return (unsigned)(r * 512 + (((c & 16) | ((c & 15) ^ (r & 15))) << 4)); }
template <bool SWAPT> __device__ __forceinline__ void ctx_tile_mm(LAS unsigned char* lds, const f16* a0, const f16* blo, const f16* bhi, int K, int tid, int wr, int rb0, int rb1, int fr, int fq, f32x4& c0, f32x4& c1) {
    c0 = (f32x4){0.f, 0.f, 0.f, 0.f}; c1 = c0;
    const int sr = tid >> 5, sc = tid & 31;
    u32x4 ra[4], rb[4];
    const int nch = K >> 8;
#define CTX_LD(kc) do { _Pragma("unroll") for (int i = 0; i < 4; ++i) { const int r = sr + 16 * i; ra[i] = *(const u32x4*)(a0 + (size_t)r * K + (kc) * 256 + 8 * sc); \
        rb[i] = *(const u32x4*)((r < 32 ? blo + (size_t)r * K : bhi + (size_t)(r - 32) * K) + (kc) * 256 + 8 * sc); } } while (0)
#define CTX_ST(buf) do { _Pragma("unroll") for (int i = 0; i < 4; ++i) { const int r = sr + 16 * i; *(LAS u32x4*)(lds + (buf) * 65536 + ctx_slot(r, sc)) = ra[i]; *(LAS u32x4*)(lds + (buf) * 65536 + 32768 + ctx_slot(r, sc)) = rb[i]; } } while (0)
    __syncthreads();
    CTX_LD(0); CTX_ST(0);
    __syncthreads();
    for (int kc = 0; kc < nch; ++kc) {
        const int buf = kc & 1;
        if (kc + 1 < nch) CTX_LD(kc + 1);
#pragma unroll
        for (int j = 0; j < 8; ++j) {
            const f16x8 a = *(const LAS f16x8*)(lds + buf * 65536 + ctx_slot(16 * wr + fr, 4 * j + fq));
            const f16x8 b0 = *(const LAS f16x8*)(lds + buf * 65536 + 32768 + ctx_slot(rb0 + fr, 4 * j + fq));
            const f16x8 b1 = *(const LAS f16x8*)(lds + buf * 65536 + 32768 + ctx_slot(rb1 + fr, 4 * j + fq));
            if (SWAPT) { c0 = __builtin_amdgcn_mfma_f32_16x16x32_f16(a, b0, c0, 0, 0, 0); c1 = __builtin_amdgcn_mfma_f32_16x16x32_f16(a, b1, c1, 0, 0, 0); }
            else { c0 = __builtin_amdgcn_mfma_f32_16x16x32_f16(b0, a, c0, 0, 0, 0); c1 = __builtin_amdgcn_mfma_f32_16x16x32_f16(b1, a, c1, 0, 0, 0); }
        }
        if (kc + 1 < nch) { CTX_ST(buf ^ 1); }
        __syncthreads();
    }
#undef CTX_LD
#undef CTX_ST
}
#define CTX_TILE_SETUP(NT) LOCAL_IDS(); const int fr = lane & 15, fq = lane >> 4, wr = wave >> 1, wc = wave & 1; (void)fq; \
    for (int t = F.vcu; t < 8 * (NT); t += F.G) { const int tm = t / (NT), tn = t % (NT); const int row0 = MLAT + tm * 64, row = row0 + wr * 16;
__device__ __forceinline__ void ctx_inproj(Frame& F) {
    const f16* U = (const f16*)(F.ws + WS_U); const f16* W = (const f16*)(F.ws + WS_WIN); f16* PT = (f16*)(F.ws + WS_PT);
    CTX_TILE_SETUP(32)
        const int col = tn * 64 + wc * 32; f32x4 c0, c1;
        ctx_tile_mm<true>(F.lds, U + (size_t)row0 * DM, W + (size_t)(tn * 64) * DM, W + (size_t)(tn * 64 + 32) * DM, DM, tid, wr, wc * 32, wc * 32 + 16, fr, fq, c0, c1);
        cm_frag(PT, PT_LD, col + fr, row + 4 * fq, c0); cm_frag(PT, PT_LD, col + 16 + fr, row + 4 * fq, c1);
    }
}
template <bool NEXT> __device__ __forceinline__ void ctx_resid(Frame& F, const f16* A, int K, const f16* W, const ResidP& P) {
    CTX_TILE_SETUP(16)
        const int col = tn * 64 + wc * 32; f32x4 c0, c1;
        ctx_tile_mm<false>(F.lds, A + (size_t)row0 * K, W + (size_t)(tn * 64) * K, W + (size_t)(tn * 64 + 32) * K, K, tid, wr, wc * 32, wc * 32 + 16, fr, fq, c0, c1);
        float sq = resid_frag<NEXT>(P, row + fr, col + 4 * fq, c0) + resid_frag<NEXT>(P, row + fr, col + 16 + 4 * fq, c1);
        if (NEXT) { sq += __shfl_xor(sq, 16); sq += __shfl_xor(sq, 32); if (fq == 0) atomicAdd(P.ssq + row + fr, sq); }
    }
}
__device__ __forceinline__ void ctx_gu(Frame& F, const f16* A, const f16* W, const GuP& P) {
    CTX_TILE_SETUP(88)
        const int ht = tn * 32, gt = (ht >> 7) * 256 + (ht & 127); f32x4 c0, c1;
        ctx_tile_mm<false>(F.lds, A + (size_t)row0 * DM, W + (size_t)gt * DM, W + (size_t)(gt + 128) * DM, DM, tid, wr, wc * 16, 32 + wc * 16, fr, fq, c0, c1);
        const float rstd = 1.f / sqrtf(P.ssq[row + fr] * (1.f / DM) + RMS_EPS);
        gu_frag(P, row + fr, ht + wc * 16 + 4 * fq, gt + wc * 16 + 4 * fq, c0, c1, rstd, 2);
    }
}
__device__ __forceinline__ void ctx_kv(Frame& F, const f16* A, const f16* W, const QkvP& P) {
    CTX_TILE_SETUP(32)
        const int col = 1024 + tn * 64 + wc * 32; f32x4 c0, c1;
        ctx_tile_mm<false>(F.lds, A + (size_t)row0 * DM, W + (size_t)(1024 + tn * 64) * DM, W + (size_t)(1024 + tn * 64 + 32) * DM, DM, tid, wr, wc * 32, wc * 32 + 16, fr, fq, c0, c1);
        const float rstd = 1.f / sqrtf(P.ssq[row + fr] * (1.f / DM) + RMS_EPS);
        qkv_frag(P, row + fr, col + 4 * fq, c0, rstd); qkv_frag(P, row + fr, col + 16 + 4 * fq, c1, rstd);
    }
}

__device__ constexpr float C32T[16] = {1.f, 0.98078528040323f, 0.92387953251129f, 0.83146961230255f, 0.70710678118655f, 0.55557023301960f, 0.38268343236509f, 0.19509032201613f,
                                       0.f, -0.19509032201613f, -0.38268343236509f, -0.55557023301960f, -0.70710678118655f, -0.83146961230255f, -0.92387953251129f, -0.98078528040323f};
__device__ constexpr float S32T[16] = {0.f, 0.19509032201613f, 0.38268343236509f, 0.55557023301960f, 0.70710678118655f, 0.83146961230255f, 0.92387953251129f, 0.98078528040323f,
                                       1.f, 0.98078528040323f, 0.92387953251129f, 0.83146961230255f, 0.70710678118655f, 0.55557023301960f, 0.38268343236509f, 0.19509032201613f};
__device__ constexpr int BR5[32] = {0,16,8,24,4,20,12,28,2,18,10,26,6,22,14,30,1,17,9,25,5,21,13,29,3,19,11,27,7,23,15,31};
__device__ constexpr int BR4[16] = {0,8,4,12,2,10,6,14,1,9,5,13,3,11,7,15};
__device__ constexpr int BR3[8] = {0,4,2,6,1,5,3,7};
__device__ __forceinline__ constexpr int brev(int i, int bits) { return bits == 5 ? BR5[i] : (bits == 4 ? BR4[i] : BR3[i]); }
template <int R> __device__ __forceinline__ void dif_fwd(float (&re)[R], float (&im)[R]) {
    constexpr int LG = R == 32 ? 5 : (R == 16 ? 4 : (R == 8 ? 3 : (R == 4 ? 2 : 1)));
#pragma unroll
    for (int st = 0; st < LG; ++st) {
        const int m = R >> st, hm = m >> 1, ts = 32 / m;
#pragma unroll
        for (int b = 0; b < R; b += m)
#pragma unroll
            for (int j = 0; j < hm; ++j) {
                const int i0 = b + j, i1 = b + j + hm, tw = j * ts;
                const float ar = re[i0], ai = im[i0], cr = re[i1], ci = im[i1];
                re[i0] = ar + cr; im[i0] = ai + ci;
                const float dr = ar - cr, di = ai - ci;
                if (tw == 0) { re[i1] = dr; im[i1] = di; }
                else if (tw == 8) { re[i1] = di; im[i1] = -dr; }
                else { const float c = C32T[tw], s = S32T[tw]; re[i1] = dr * c + di * s; im[i1] = di * c - dr * s; }
            }
    }
}
template <int R> __device__ __forceinline__ void dit_inv(float (&re)[R], float (&im)[R]) {
    constexpr int LG = R == 32 ? 5 : (R == 16 ? 4 : (R == 8 ? 3 : (R == 4 ? 2 : 1)));
#pragma unroll
    for (int st = LG - 1; st >= 0; --st) {
        const int m = R >> st, hm = m >> 1, ts = 32 / m;
#pragma unroll
        for (int b = 0; b < R; b += m)
#pragma unroll
            for (int j = 0; j < hm; ++j) {
                const int i0 = b + j, i1 = b + j + hm, tw = j * ts;
                const float ar = re[i0], ai = im[i0], cr = re[i1], ci = im[i1];
                float tr, ti;
                if (tw == 0) { tr = cr; ti = ci; }
                else if (tw == 8) { tr = -ci; ti = cr; }
                else { const float c = C32T[tw], s = S32T[tw]; tr = cr * c - ci * s; ti = ci * c + cr * s; }
                re[i0] = ar + tr; im[i0] = ai + ti; re[i1] = ar - tr; im[i1] = ai - ti;
            }
    }
}
__device__ __forceinline__ int fpad(int i) { return i + (i >> 5); }
__device__ __forceinline__ void tw_fwd(float& x, float& y, float rev) { const float c = __builtin_amdgcn_cosf(rev), s = __builtin_amdgcn_sinf(rev); const float a = x * c + y * s, b = y * c - x * s; x = a; y = b; }
__device__ __forceinline__ void tw_inv(float& x, float& y, float rev) { const float c = __builtin_amdgcn_cosf(rev), s = __builtin_amdgcn_sinf(rev); const float a = x * c - y * s, b = y * c + x * s; x = a; y = b; }

__device__ __forceinline__ void fft_s2_fwd(LAS f32x2* buf, int tid) {
    asm volatile("" : "+v"(tid));
    const int kk = tid >> 5, n3 = tid & 31;
    LAS f32x2* pb = buf + fpad(kk * 1024 + n3);
    float re[32], im[32];
#pragma unroll
    for (int n2 = 0; n2 < 32; ++n2) { const f32x2 v = pb[33 * n2]; re[n2] = v.x; im[n2] = v.y; }
    dif_fwd<32>(re, im);
#pragma unroll
    for (int p = 0; p < 32; ++p) { const int k2 = brev(p, 5); tw_fwd(re[p], im[p], (float)(n3 * k2) * (1.f / 1024.f)); pb[33 * k2] = (f32x2){re[p], im[p]}; }
}
__device__ __forceinline__ void fft_s2_inv(LAS f32x2* buf, int tid) {
    asm volatile("" : "+v"(tid));
    const int k1 = tid >> 5, n3 = tid & 31;
    LAS f32x2* pb = buf + fpad(k1 * 1024 + n3);
    float re[32], im[32];
#pragma unroll
    for (int p = 0; p < 32; ++p) { const f32x2 v = pb[33 * brev(p, 5)]; re[p] = v.x; im[p] = v.y; }
    dit_inv<32>(re, im);
#pragma unroll
    for (int n2 = 0; n2 < 32; ++n2) { tw_inv(re[n2], im[n2], (float)((n2 * 32 + n3) * k1) * (1.f / 16384.f)); pb[33 * n2] = (f32x2){re[n2], im[n2]}; }
}
__device__ __forceinline__ void fft_s3_conv(LAS f32x2* buf, int tid, const unsigned* H) {
    asm volatile("" : "+v"(tid));
    const int k2 = tid & 31;
    LAS f32x2* pb = buf + fpad((tid >> 5) * 1024 + k2 * 32);
    const unsigned* hp = H + tid;
    float re[32], im[32];
#pragma unroll
    for (int n3 = 0; n3 < 32; ++n3) { const f32x2 v = pb[n3]; re[n3] = v.x; im[n3] = v.y; }
    dif_fwd<32>(re, im);
#pragma unroll
    for (int p = 0; p < 32; ++p) { const f16x2 hh = __builtin_bit_cast(f16x2, hp[p * 512]); const float hx = (float)hh[0] * (1.f / 16384.f), hy = (float)hh[1] * (1.f / 16384.f);
        const float a = re[p] * hx - im[p] * hy, b = re[p] * hy + im[p] * hx; re[p] = a; im[p] = b; }
    dit_inv<32>(re, im);
#pragma unroll
    for (int n3 = 0; n3 < 32; ++n3) { tw_inv(re[n3], im[n3], (float)(n3 * k2) * (1.f / 1024.f)); pb[n3] = (f32x2){re[n3], im[n3]}; }
}

__device__ __forceinline__ void hyena_task(Frame& F, int c) {
    LAS f32x2* buf = (LAS f32x2*)F.lds;
    LAS float* scr = (LAS float*)(F.lds + SCR_OFF);
    int tid = threadIdx.x; asm volatile("" : "+v"(tid));
    const int lane = tid & 63, wave = __builtin_amdgcn_readfirstlane(tid >> 6);
    u16* PT = (u16*)(F.ws + WS_PT);
    const u16* FILT = (const u16*)(F.ws + WS_FILT);
    unsigned* HS = (unsigned*)(F.ws + WS_HS) + (size_t)blockIdx.x * 32768;
    unsigned* XS = (unsigned*)(F.ws + WS_XS) + (size_t)blockIdx.x * (32 * 512);
    const float* cw = F.in[13]; const float* cb = F.in[14]; const float* skip = F.in[21];
    {
        const u16* f1 = FILT + (size_t)(c) * FILT_T; const u16* f2 = FILT + (size_t)(512 + c) * FILT_T;
        const u16* b1 = FILT + (size_t)(1024 + c) * FILT_T; const u16* b2 = FILT + (size_t)(1536 + c) * FILT_T;
        float a1 = 0.f, a2 = 0.f;
        if (tid == 0) { a1 = fabsf(h2f(b1[0])); a2 = fabsf(h2f(b2[0])); }
#pragma unroll
        for (int jj = 0; jj < 2; ++jj) {
            __builtin_amdgcn_sched_barrier(0); int j = tid + 512 * jj; asm volatile("" : "+v"(j));
            float re[16], im[16];
#pragma unroll
            for (int n1 = 0; n1 < 16; ++n1) { const int n = n1 * 1024 + j;
                if (n1 < 8) { re[n1] = h2f(f1[n]); im[n1] = h2f(f2[n]); }
                else if (n == 8192) { re[n1] = 0.f; im[n1] = 0.f; }
                else { re[n1] = h2f(b1[16384 - n]); im[n1] = h2f(b2[16384 - n]); }
                a1 += fabsf(re[n1]); a2 += fabsf(im[n1]); }
            dif_fwd<16>(re, im);
#pragma unroll
            for (int p = 0; p < 16; ++p) { const int k1 = brev(p, 4); tw_fwd(re[p], im[p], (float)(j * k1) * (1.f / 16384.f)); (buf + fpad(j))[1056 * k1] = (f32x2){re[p], im[p]}; }
        }
        a1 = wave_sum(a1); a2 = wave_sum(a2);
        if (lane == 0) { scr[wave * 2] = a1; scr[wave * 2 + 1] = a2; }
        __syncthreads();
        float n1s = 0.f, n2s = 0.f;
#pragma unroll
        for (int w = 0; w < 8; ++w) { n1s += scr[2 * w]; n2s += scr[2 * w + 1]; }
        const float inv1 = 0.5f / n1s, inv2 = 0.5f / n2s;
        const float ska = skip[c], skb = skip[512 + c];
        fft_s2_fwd(buf, tid);
        __syncthreads();
        {
            const int k1 = tid >> 5, k2 = tid & 31;
            LAS f32x2* pb = buf + fpad(k1 * 1024 + k2 * 32);
            float re[32], im[32];
#pragma unroll
            for (int n3 = 0; n3 < 32; ++n3) { const f32x2 v = pb[n3]; re[n3] = v.x; im[n3] = v.y; }
            dif_fwd<32>(re, im);
#pragma unroll
            for (int p = 0; p < 32; ++p) pb[brev(p, 5)] = (f32x2){re[p], im[p]};
            __syncthreads();
            unsigned* hp = HS + tid;
#pragma unroll
            for (int p = 0; p < 32; ++p) {
                const int k = k1 + 16 * k2 + 512 * brev(p, 5), km = (16384 - k) & 16383;
                const f32x2 zm = buf[fpad((km & 15) * 1024 + ((km >> 4) & 31) * 32 + (km >> 9))];
                const float sr = re[p] + zm.x, si = im[p] - zm.y;
                const float dr = re[p] - zm.x, di = im[p] + zm.y;
                hp[p * 512] = pkh(sr * inv1 + ska, si * inv1);
                hp[16384 + p * 512] = pkh(di * inv2 + skb, -dr * inv2);
                if ((p & 3) == 3) __builtin_amdgcn_sched_barrier(0);
            }
        }
        __syncthreads();
    }
    unsigned vpk[16];
    {
        LAS u16* raw = (LAS u16*)F.lds;
#pragma unroll
        for (int w = 0; w < 3; ++w) {
            const u16* row = PT + (size_t)(512 + 512 * w + c) * PT_LD;
#pragma unroll
            for (int i = 0; i < 4; ++i) { const int e = (i * 512 + tid) * 8;
                *(LAS u32x4*)(raw + w * 16384 + e) = *(const u32x4*)(row + e); }
        }
        __syncthreads();
#pragma unroll
        for (int w = 0; w < 3; ++w) {
            const int ch = 512 * w + c;
            const float w0 = cw[ch], w1 = cw[1536 + ch], w2 = cw[3072 + ch], bias = cb[ch];
#pragma unroll
            for (int idx = 0; idx < 16; ++idx) { const int n = (idx & 7) * 1024 + tid + 512 * (idx >> 3);
                const LAS u16* p0 = raw + w * 16384 + n; const LAS u16* p1 = p0 + SEQ;
                const float a0 = n > 0 ? h2f(p0[-1]) : 0.f, a1 = h2f(p0[0]), a2 = n < SEQ - 1 ? h2f(p0[1]) : 0.f;
                const float c0 = n > 0 ? h2f(p1[-1]) : 0.f, c1 = h2f(p1[0]), c2 = n < SEQ - 1 ? h2f(p1[1]) : 0.f;
                const unsigned pk = pkh(w0 * a0 + w1 * a1 + w2 * a2 + bias, w0 * c0 + w1 * c1 + w2 * c2 + bias);
                if (w < 2) XS[(w * 16 + idx) * 512 + tid] = pk; else vpk[idx] = pk;
                if ((idx & 3) == 3) __builtin_amdgcn_sched_barrier(0); }
        }
        __syncthreads();
    }
#define XS_LD(w, idx, lo, hi) do { const f16x2 _v = __builtin_bit_cast(f16x2, XS[((w) * 16 + (idx)) * 512 + tid]); lo = (float)_v[0]; hi = (float)_v[1]; } while (0)
#pragma unroll
    for (int jj = 0; jj < 2; ++jj) {
        __builtin_amdgcn_sched_barrier(0); int j = tid + 512 * jj; asm volatile("" : "+v"(j));
        float re[16], im[16];
#pragma unroll
        for (int n1 = 0; n1 < 8; ++n1) { const f16x2 v = __builtin_bit_cast(f16x2, vpk[jj * 8 + n1]); re[n1] = (float)v[0]; im[n1] = (float)v[1]; }
#pragma unroll
        for (int n1 = 8; n1 < 16; ++n1) { re[n1] = 0.f; im[n1] = 0.f; }
        dif_fwd<16>(re, im);
#pragma unroll
        for (int p = 0; p < 16; ++p) { const int k1 = brev(p, 4); tw_fwd(re[p], im[p], (float)(j * k1) * (1.f / 16384.f)); (buf + fpad(j))[1056 * k1] = (f32x2){re[p], im[p]}; }
    }
    __syncthreads();
    fft_s2_fwd(buf, tid); __syncthreads();
    fft_s3_conv(buf, tid, HS); __syncthreads();
    fft_s2_inv(buf, tid); __syncthreads();
#pragma unroll
    for (int jj = 0; jj < 2; ++jj) {
        __builtin_amdgcn_sched_barrier(0); int j = tid + 512 * jj; asm volatile("" : "+v"(j));
        float re[16], im[16];
#pragma unroll
        for (int p = 0; p < 16; ++p) { const f32x2 v = (buf + fpad(j))[1056 * brev(p, 4)]; re[p] = v.x; im[p] = v.y; }
        dit_inv<16>(re, im);
#pragma unroll
        for (int n1 = 0; n1 < 8; ++n1) { float x0, x1; XS_LD(0, jj * 8 + n1, x0, x1); re[n1] *= x0; im[n1] *= x1; }
#pragma unroll
        for (int n1 = 8; n1 < 16; ++n1) { re[n1] = 0.f; im[n1] = 0.f; }
        dif_fwd<16>(re, im);
#pragma unroll
        for (int p = 0; p < 16; ++p) { const int k1 = brev(p, 4); tw_fwd(re[p], im[p], (float)(j * k1) * (1.f / 16384.f)); (buf + fpad(j))[1056 * k1] = (f32x2){re[p], im[p]}; }
    }
    __syncthreads();
    fft_s2_fwd(buf, tid); __syncthreads();
    fft_s3_conv(buf, tid, HS + 16384); __syncthreads();
    fft_s2_inv(buf, tid); __syncthreads();
    u16* yrow = PT + (size_t)(512 + c) * PT_LD;
#pragma unroll
    for (int jj = 0; jj < 2; ++jj) {
        __builtin_amdgcn_sched_barrier(0); int j = tid + 512 * jj; asm volatile("" : "+v"(j));
        float re[16], im[16];
#pragma unroll
        for (int p = 0; p < 16; ++p) { const f32x2 v = (buf + fpad(j))[1056 * brev(p, 4)]; re[p] = v.x; im[p] = v.y; }
        dit_inv<16>(re, im);
#pragma unroll
        for (int n1 = 0; n1 < 8; ++n1) { float x0, x1; XS_LD(1, jj * 8 + n1, x0, x1);
            yrow[n1 * 1024 + j] = __builtin_bit_cast(u16, (f16)(x0 * re[n1])); yrow[SEQ + n1 * 1024 + j] = __builtin_bit_cast(u16, (f16)(x1 * im[n1])); }
    }
#undef XS_LD
    __syncthreads();
}

__device__ __forceinline__ void fourier_task(Frame& F, int task) {
    LAS f32x2* buf = (LAS f32x2*)F.lds;
    int tid = threadIdx.x; asm volatile("" : "+v"(tid));
    const int b = task >> 7, g = (task >> 5) & 3, q = task & 31;
    u16* PT = (u16*)(F.ws + WS_PT);
    const int mA[2] = {q, q == 0 ? 32 : 64 - q};
    const size_t tok0 = (size_t)b * SEQ;
#pragma unroll
    for (int f = 0; f < 2; ++f) {
        const u16* rA = PT + (size_t)(128 * g + mA[f]) * PT_LD + tok0; const u16* rB = PT + (size_t)(128 * g + 64 + mA[f]) * PT_LD + tok0;
        const float sg = (f == 0 && q == 0) ? 1.f : -1.f;
#pragma unroll
        for (int jj = 0; jj < 2; ++jj) {
            __builtin_amdgcn_sched_barrier(0); int j = tid + 512 * jj; asm volatile("" : "+v"(j));
            float re[8], im[8];
#pragma unroll
            for (int n1 = 0; n1 < 8; ++n1) { re[n1] = h2f(rA[n1 * 1024 + j]); im[n1] = sg * h2f(rB[n1 * 1024 + j]); }
            dif_fwd<8>(re, im);
#pragma unroll
            for (int p = 0; p < 8; ++p) { const int k1 = brev(p, 3); tw_fwd(re[p], im[p], (float)(j * k1) * (1.f / 8192.f)); (buf + fpad(j))[1056 * (f * 8 + k1)] = (f32x2){re[p], im[p]}; }
        }
    }
    __syncthreads();
    fft_s2_fwd(buf, tid);
    __syncthreads();
    {
        const int kk = tid >> 5, k2 = tid & 31, f = kk >> 3, k1 = kk & 7;
        LAS f32x2* pb = buf + fpad(kk * 1024 + k2 * 32);
        float re[32], im[32];
#pragma unroll
        for (int n3 = 0; n3 < 32; ++n3) { const f32x2 v = pb[n3]; re[n3] = v.x; im[n3] = v.y; }
        dif_fwd<32>(re, im);
        __syncthreads();
        { LAS f32x2* pn = buf + fpad(f * 8192 + k1 + 8 * k2);
#pragma unroll
        for (int p = 0; p < 32; ++p) pn[264 * brev(p, 5)] = (f32x2){re[p], im[p]}; }
    }
    __syncthreads();
#pragma unroll
    for (int f = 0; f < 2; ++f) {
        const bool packed = (f == 0 && q == 0);
        const int m = mA[f];
        u16* o1 = PT + (size_t)(128 * g + (packed ? 0 : m)) * PT_LD + tok0;
        u16* o2 = PT + (size_t)(128 * g + (packed ? 64 : 128 - m)) * PT_LD + tok0;
        for (int l = tid; l < SEQ; l += 512) {
            const f32x2 a = buf[fpad(f * 8192 + l)], c = buf[fpad(f * 8192 + ((SEQ - l) & (SEQ - 1)))];
            const float y1 = packed ? 0.5f * (a.x + c.x) : a.x, y2 = packed ? 0.5f * (a.y + c.y) : c.x;
            o1[l] = __builtin_bit_cast(u16, (f16)y1); o2[l] = __builtin_bit_cast(u16, (f16)y2);
        }
    }
    __syncthreads();
}

__device__ __forceinline__ void fourier_ctx_task(Frame& F, int task) {
    LAS float* zr = (LAS float*)F.lds;
    LAS float* zi = zr + 512;
    LAS float* tc = zr + 1024;
    LAS float* ts = zr + 1280;
    LAS float* fr = zr + 1536;
    LAS float* fi = zr + 2048;
    int tid = threadIdx.x; asm volatile("" : "+v"(tid));
    const int f = tid >> 8, k = tid & 255;
    const int b = task >> 7, g = (task >> 5) & 3, q = task & 31;
    u16* PT = (u16*)(F.ws + WS_PT);
    const int m = f == 0 ? q : (q == 0 ? 32 : 64 - q);
    const bool packed = (f == 0 && q == 0);
    const size_t tok0 = (size_t)MLAT + (size_t)b * CTXL;
    const u16* rA = PT + (size_t)(128 * g + m) * PT_LD + tok0; const u16* rB = PT + (size_t)(128 * g + 64 + m) * PT_LD + tok0;
    zr[tid] = h2f(rA[k]); zi[tid] = (packed ? 1.f : -1.f) * h2f(rB[k]);
    if (tid < 256) { tc[tid] = cos_rev((float)tid * (1.f / 256.f)); ts[tid] = sin_rev((float)tid * (1.f / 256.f)); }
    __syncthreads();
    float ar = 0.f, ai = 0.f;
    for (int l = 0; l < 256; ++l) { const float x = zr[f * 256 + l], y = zi[f * 256 + l]; const int e = (k * l) & 255; const float c = tc[e], s = ts[e];
        ar += x * c + y * s; ai += y * c - x * s; }
    fr[tid] = ar; fi[tid] = ai;
    __syncthreads();
    const int km = f * 256 + ((256 - k) & 255);
    const float sc = 5.656854249492381f;
    const float y1 = packed ? 0.5f * (ar + fr[km]) : ar, y2 = packed ? 0.5f * (ai + fi[km]) : fr[km];
    u16* o1 = PT + (size_t)(128 * g + (packed ? 0 : m)) * PT_LD + tok0; u16* o2 = PT + (size_t)(128 * g + (packed ? 64 : 128 - m)) * PT_LD + tok0;
    o1[k] = __builtin_bit_cast(u16, (f16)(y1 * sc)); o2[k] = __builtin_bit_cast(u16, (f16)(y2 * sc));
    __syncthreads();
}
__device__ __forceinline__ void hyena_ctx_task(Frame& F, int c) {
    LAS float* fw = (LAS float*)F.lds;
    LAS float* bw = fw + 512;
    LAS float* vv = fw + 1024;
    LAS float* scr = fw + 1536;
    LOCAL_IDS();
    const int b = tid >> 8, t = tid & 255;
    u16* PT = (u16*)(F.ws + WS_PT);
    const u16* FILT = (const u16*)(F.ws + WS_FILT);
    const float* cw = F.in[13]; const float* cb = F.in[14]; const float* skip = F.in[21];
    const float fwv = h2f(FILT[(size_t)(b * 512 + c) * FILT_T + SEQ + t]), bwv = h2f(FILT[(size_t)(1024 + b * 512 + c) * FILT_T + SEQ + t]);
    float a = wave_sum(fabsf(fwv) + fabsf(bwv));
    if (lane == 0) scr[wave] = a;
    fw[tid] = fwv; bw[tid] = bwv;
    const size_t tok = (size_t)MLAT + (size_t)b * CTXL + t;
    auto sc3 = [&](int ch) { const u16* p = PT + (size_t)(512 + ch) * PT_LD + tok;
        const float a0 = t > 0 ? h2f(p[-1]) : 0.f, a1 = h2f(p[0]), a2 = t < CTXL - 1 ? h2f(p[1]) : 0.f;
        return cw[ch] * a0 + cw[1536 + ch] * a1 + cw[3072 + ch] * a2 + cb[ch]; };
    const float x1 = sc3(c), x2 = sc3(512 + c), v0 = sc3(1024 + c);
    vv[tid] = v0;
    __syncthreads();
    const float nr0 = scr[0] + scr[1] + scr[2] + scr[3], nr1 = scr[4] + scr[5] + scr[6] + scr[7];
    float y = 0.f;
    for (int s = 0; s < 256; ++s) { const float u = vv[b * 256 + s]; const float h = s <= t ? fw[t - s] : bw[s - t]; y += u * h; }
    const float v1 = x1 * (y / nr0 + skip[c] * v0);
    __syncthreads();
    vv[tid] = v1;
    __syncthreads();
    y = 0.f;
    for (int s = 0; s < 256; ++s) { const float u = vv[b * 256 + s]; const float h = s <= t ? fw[256 + t - s] : bw[256 + s - t]; y += u * h; }
    const float o = x2 * (y / nr1 + skip[512 + c] * v1);
    __syncthreads();
    PT[(size_t)(512 + c) * PT_LD + tok] = __builtin_bit_cast(u16, (f16)o);
    __syncthreads();
}
#ifdef PROBE_P3
#define P3T(k, stmt) do { const unsigned long long t0_ = __builtin_amdgcn_s_memrealtime(); stmt; if (PROBE_P3 == (k)) F.pacc += __builtin_amdgcn_s_memrealtime() - t0_; } while (0)
#else
#define P3T(k, stmt) do { stmt; } while (0)
#endif
__device__ __forceinline__ void p3_fft(Frame& F) {
    P3T(1, for (int c = F.vcu; c < 512; c += F.G) hyena_task(F, c));
    P3T(2, for (int t = F.vcu; t < 256; t += F.G) fourier_task(F, t));
    P3T(3, for (int t = F.vcu; t < 256; t += F.G) fourier_ctx_task(F, t));
    P3T(4, for (int c = F.vcu; c < 512; c += F.G) hyena_ctx_task(F, c));
}

__device__ __forceinline__ void p4_transpose(Frame& F) {
    LOCAL_IDS();
    const int gw = F.vcu * NWAVES + wave, NGW = F.G * NWAVES;
    const u16* YT = (const u16*)(F.ws + WS_PT); u16* Y = (u16*)(F.ws + WS_Y);
    LAS u16* scr = (LAS u16*)(F.lds + wave * 16384);
    constexpr int NRB = MALL / 64;
    for (int it = gw; it < 16 * NRB; it += NGW) {
        const int cb = it / NRB, rb = it % NRB;
#pragma unroll
        for (int i = 0; i < 8; ++i) { const int ch = (lane >> 3) + 8 * i, seg = lane & 7;
            const u32x4 v = *(const u32x4*)(YT + (size_t)(cb * 64 + ch) * PT_LD + rb * 64 + 8 * seg);
            *(LAS u32x4*)(scr + ch * 72 + 8 * seg) = v; }
        LDS_WAIT(); asm volatile("" ::: "memory");
#pragma unroll
        for (int i = 0; i < 8; ++i) { const int tk = (lane >> 3) + 8 * i, seg = lane & 7;
            unsigned w[4];
#pragma unroll
            for (int e = 0; e < 4; ++e) { const unsigned lo = scr[(8 * seg + 2 * e) * 72 + tk], hi = scr[(8 * seg + 2 * e + 1) * 72 + tk]; w[e] = lo | (hi << 16); }
            *(u32x4*)(Y + (size_t)(rb * 64 + tk) * DM + cb * 64 + 8 * seg) = (u32x4){w[0], w[1], w[2], w[3]}; }
        LDS_WAIT(); asm volatile("" ::: "memory");
    }
}

constexpr int NA_KOFF = 0, NA_VOFF = 73728, NA_BIAS = 147456;
typedef short v4i16_t __attribute__((ext_vector_type(4)));
__device__ __forceinline__ f16x4 lds_tr(unsigned addr) { return __builtin_bit_cast(f16x4, __builtin_amdgcn_ds_read_tr16_b64_v4i16((LAS v4i16_t*)addr)); }
template <bool VSWZ> __device__ __forceinline__ void na_stage(const f16* src, unsigned ldsbase, int nchunk, int tid) {
    for (int cidx = tid; cidx < nchunk; cidx += 512) {
        const int key = cidx >> 3, ch = cidx & 7;
        const u32x4 v = *(const u32x4*)(src + (size_t)cidx * 8);
        const int slot = VSWZ ? ((((ch >> 1) ^ ((key >> 1) & 3)) << 1) | (ch & 1)) : (ch ^ (key & 7));
        *(LAS u32x4*)(ldsbase + key * 128 + slot * 16) = v;
    }
}
__device__ __forceinline__ void p11_na(Frame& F) {
    LOCAL_IDS();
    const f16* Q = (const f16*)(F.ws + WS_Q); const f16* K = (const f16*)(F.ws + WS_K); const f16* V = (const f16*)(F.ws + WS_V);
    const f16* KC = (const f16*)(F.ws + WS_KC); const f16* VC = (const f16*)(F.ws + WS_VC); f16* O = (f16*)(F.ws + WS_O);
    const unsigned lds0 = (unsigned)(uintptr_t)F.lds;
    for (int it = F.vcu * 8; it < 2048; it += F.G * 8) {
        { const int h = (it >> 6) & 15; const float* src = F.in[24] + (size_t)h * 465; LAS float* tb = (LAS float*)(F.lds + NA_BIAS);
          __syncthreads();
          if (tid < 465) tb[tid] = src[tid] * LOG2E;
        }
#pragma unroll 1
        for (int ii = 0; ii < 8; ++ii) {
            const int item = it + ii; if (item >= 2048) break;
            int tid = threadIdx.x; asm volatile("" : "+v"(tid));
            const int lane = tid & 63, wave = __builtin_amdgcn_readfirstlane(tid >> 6);
            const int bh = item >> 6, rp = item & 63, b = bh >> 4, h = bh & 15;
            const int r0 = 2 * rp, r = r0 + (wave >> 2), chunk = wave & 3;
            const int rsA = r0 - 4 < 0 ? 0 : (r0 - 4 > 120 ? 120 : r0 - 4);
            const int rs = r - 4 < 0 ? 0 : (r - 4 > 120 ? 120 : r - 4);
            const int rsB = r0 + 1 - 4 < 0 ? 0 : (r0 + 1 - 4 > 120 ? 120 : r0 + 1 - 4);
            const int nrows = 8 + (rsB - rsA);
            __syncthreads();
            na_stage<false>(K + ((size_t)bh * SEQ + rsA * 64) * HD, lds0 + NA_KOFF, nrows * 512, tid);
            na_stage<true>(V + ((size_t)bh * SEQ + rsA * 64) * HD, lds0 + NA_VOFF, nrows * 512, tid);
            const int q = lane & 15, g = lane >> 4;
            const int kstart = chunk == 0 ? 0 : (chunk == 1 ? 8 : (chunk == 2 ? 24 : 32));
            const int off = chunk == 0 ? 15 : (chunk == 3 ? -1 : 7);
            const int ws = chunk == 0 ? (q > 8 ? q - 8 : 0) : (chunk == 3 ? (q + 8 < 16 ? q + 8 : 16) : q);
            const f16* Qp = Q + ((size_t)bh * SEQ + r * 64 + 16 * chunk + q) * HD + 8 * g;
            const f16x8 q0 = *(const f16x8*)Qp, q1 = *(const f16x8*)(Qp + 32);
            const int lr = rs - rsA;
            unsigned ka[2][2];
#pragma unroll
            for (int kb = 0; kb < 2; ++kb)
#pragma unroll
                for (int ks = 0; ks < 2; ++ks) { const int key = 64 * lr + kstart + 16 * kb + q; ka[kb][ks] = lds0 + NA_KOFF + key * 128 + (((4 * ks + g) ^ (key & 7)) << 4); }
            unsigned va[4];
            { const int qq = (lane & 15) >> 2, p = lane & 3; const int key = 64 * lr + kstart + 4 * g + qq;
#pragma unroll
              for (int db = 0; db < 4; ++db) va[db] = lds0 + NA_VOFF + key * 128 + ((db ^ ((key >> 1) & 3)) << 5) + 8 * p; }
            int bidx[2][4];
#pragma unroll
            for (int kb = 0; kb < 2; ++kb)
#pragma unroll
                for (int e = 0; e < 4; ++e) { const int kc = 16 * kb + 4 * g + e; const bool ok = kc >= ws && kc < ws + 16; const int dc = kc - q + off; bidx[kb][e] = ok ? ((rs - r + 7) * 31 + dc) : -1; }
            f32x4 o[4];
#pragma unroll
            for (int db = 0; db < 4; ++db) o[db] = (f32x4){0.f, 0.f, 0.f, 0.f};
            float m = -INFINITY, l = 0.f;
            const LAS float* rpb = (const LAS float*)(F.lds + NA_BIAS);
            __syncthreads();
#define NA_STEP(S0, S1, KA00, KA01, KA10, KA11, VOFF) do { \
                S0 = __builtin_amdgcn_mfma_f32_16x16x32_f16(*(const LAS f16x8*)(KA00), q0, S0, 0, 0, 0); \
                S0 = __builtin_amdgcn_mfma_f32_16x16x32_f16(*(const LAS f16x8*)(KA01), q1, S0, 0, 0, 0); \
                S1 = __builtin_amdgcn_mfma_f32_16x16x32_f16(*(const LAS f16x8*)(KA10), q0, S1, 0, 0, 0); \
                S1 = __builtin_amdgcn_mfma_f32_16x16x32_f16(*(const LAS f16x8*)(KA11), q1, S1, 0, 0, 0); \
                float mx_ = fmaxf(fmaxf(fmaxf(S0[0], S0[1]), fmaxf(S0[2], S0[3])), fmaxf(fmaxf(S1[0], S1[1]), fmaxf(S1[2], S1[3]))); \
                mx_ = fmaxf(mx_, __shfl_xor(mx_, 16)); mx_ = fmaxf(mx_, __shfl_xor(mx_, 32)); \
                const float mn_ = fmaxf(m, mx_); const float alpha_ = __builtin_amdgcn_exp2f(m - mn_); m = mn_; \
                f16x8 pf_; float ps_ = 0.f; \
                _Pragma("unroll") for (int e = 0; e < 4; ++e) { const float p0_ = __builtin_amdgcn_exp2f(S0[e] - mn_), p1_ = __builtin_amdgcn_exp2f(S1[e] - mn_); ps_ += p0_ + p1_; pf_[e] = (f16)p0_; pf_[4 + e] = (f16)p1_; } \
                l = l * alpha_ + ps_; \
                _Pragma("unroll") for (int db = 0; db < 4; ++db) { const f16x4 v0_ = lds_tr(va[db] + (VOFF)), v1_ = lds_tr(va[db] + (VOFF) + 2048); \
                    const f16x8 vv_ = {v0_[0], v0_[1], v0_[2], v0_[3], v1_[0], v1_[1], v1_[2], v1_[3]}; \
                    o[db] = __builtin_amdgcn_mfma_f32_16x16x32_f16(vv_, pf_, o[db] * alpha_, 0, 0, 0); } } while (0)
#pragma unroll
            for (int i = 0; i < 8; ++i) {
                f32x4 s0, s1;
#pragma unroll
                for (int e = 0; e < 4; ++e) { s0[e] = bidx[0][e] >= 0 ? rpb[bidx[0][e] + 31 * i] : -INFINITY; s1[e] = bidx[1][e] >= 0 ? rpb[bidx[1][e] + 31 * i] : -INFINITY; }
                NA_STEP(s0, s1, ka[0][0] + 8192 * i, ka[0][1] + 8192 * i, ka[1][0] + 8192 * i, ka[1][1] + 8192 * i, 8192 * i);
            }
            __syncthreads();
            na_stage<false>(KC + (size_t)bh * CTXL * HD, lds0 + NA_KOFF, 2048, tid);
            na_stage<true>(VC + (size_t)bh * CTXL * HD, lds0 + NA_VOFF, 2048, tid);
            unsigned kc2[2][2];
#pragma unroll
            for (int kb = 0; kb < 2; ++kb)
#pragma unroll
                for (int ks = 0; ks < 2; ++ks) { const int key = 16 * kb + q; kc2[kb][ks] = lds0 + NA_KOFF + key * 128 + (((4 * ks + g) ^ (key & 7)) << 4); }
            { const int qq = (lane & 15) >> 2, p = lane & 3; const int key = 4 * g + qq;
#pragma unroll
              for (int db = 0; db < 4; ++db) va[db] = lds0 + NA_VOFF + key * 128 + ((db ^ ((key >> 1) & 3)) << 5) + 8 * p; }
            __syncthreads();
#pragma unroll
            for (int i = 0; i < 8; ++i) {
                f32x4 s0 = {0.f, 0.f, 0.f, 0.f}, s1 = s0;
                NA_STEP(s0, s1, kc2[0][0] + 4096 * i, kc2[0][1] + 4096 * i, kc2[1][0] + 4096 * i, kc2[1][1] + 4096 * i, 4096 * i);
            }
#undef NA_STEP
            l += __shfl_xor(l, 16); l += __shfl_xor(l, 32);
            const float rinv = 1.f / l;
            f16* op = O + ((size_t)b * SEQ + r * 64 + 16 * chunk + q) * DM + h * 64 + 4 * g;
#pragma unroll
            for (int db = 0; db < 4; ++db) { const f32x4 v = o[db] * rinv; u32x2 w; w.x = pkh(v[0], v[1]); w.y = pkh(v[2], v[3]); *(u32x2*)(op + 16 * db) = w; }
        }
    }
    __syncthreads();
}

struct Args { const float* in[26]; float* out; unsigned char* ws; int ph_lo, ph_hi; };
constexpr int NPHASE = 14;

__global__ void __launch_bounds__(NWAVES * 64, 2) fwd_kernel(Args args) {
    extern __shared__ __attribute__((aligned(16))) unsigned char lds[];
    Frame F;
    F.lds = (LAS unsigned char*)lds;
    F.G = gridDim.x; { const int bx = blockIdx.x; F.vcu = (F.G % 8 == 0) ? (bx % 8) * (F.G / 8) + bx / 8 : bx; }
    F.in = args.in;
    F.out = args.out; F.ws = args.ws;
    volatile LAS unsigned* MISC = (volatile LAS unsigned*)(F.lds + MISC_OFF);
    if (threadIdx.x < 64) MISC[threadIdx.x] = 0u;
    __syncthreads();
    unsigned* ctl = (unsigned*)(F.ws + WS_CTL);
    XcdBarrier bar; bar.bar = ctl + CW_BAR; bar.x = 0; bar.st = nullptr;
    const int lo = args.ph_lo, hi = args.ph_hi;
    if (hi - lo > 1) bar = xcd_barrier_post(ctl + CW_BAR, MISC + 8);
#define REFRESH() do { \
        { int z_ = 0; asm volatile("" : "+s"(z_)); F.in = args.in + z_; F.ws = args.ws + z_; F.out = args.out + z_; } \
        ws = F.ws; MOD = (const float*)(ws + WS_MOD); HC = (float*)(ws + WS_HC); SSQ = (float*)(ws + WS_SSQ); SHW = (const float*)(ws + WS_SHW); } while (0)
#ifndef PH_MASK
#define PH_MASK 0x3FFF
#endif
#define IN(k) (((PH_MASK >> (k)) & 1) && lo <= (k) && (k) < hi)
#define SEAM(k) do { if (lo <= (k) && (k) + 1 < hi) xcd_barrier(bar); } while (0)
    unsigned char* ws; const float* MOD; float* HC; float* SSQ; const float* SHW;
    LAS unsigned char* ring = F.lds;

    F.pacc = 0;
#ifdef PROBE_MASK
    unsigned long long probe_acc = 0;
#endif
    for (int ph = lo; ph < hi; ++ph) {
#ifdef PROBE_MASK
        const unsigned long long probe_t0 = __builtin_amdgcn_s_memrealtime();
#endif
        REFRESH();
        switch (ph) {
    case 0: if (!((PH_MASK >> 0) & 1)) break; { p0_prep(F); } break;
    case 1: if (!((PH_MASK >> 1) & 1)) break; { norm_phase(F, F.in[0], F.in[2], F.in[6], 0, 0, 1024, (f16*)(ws + WS_U), MALL); filt_gemm(F); shw_tasks(F); } break;
    case 2: if (!((PH_MASK >> 2) & 1)) break; {
        pg8::Gemm g{(const f16*)(ws + WS_U), (const f16*)(ws + WS_WIN), MLAT, 2048, 1024}; pg8::StaticOrder S; S.init(MLAT, 2048, F.G, (int)blockIdx.x);
        EpiCM E{(f16*)(ws + WS_PT), PT_LD};
        pg8::gemm_phase<EpiCM, pg8::StaticOrder, true>(ring, g, S, E);
        ctx_inproj(F);
    } break;
    case 3: if (!((PH_MASK >> 3) & 1)) break; { p3_fft(F); } break;
    case 4: if (!((PH_MASK >> 4) & 1)) break; { p4_transpose(F); } break;
    case 5: if (!((PH_MASK >> 5) & 1)) break; {
        pg8::Gemm g{(const f16*)(ws + WS_Y), (const f16*)(ws + WS_WOUT0), MLAT, 1024, 1024}; pg8::StaticOrder S; S.init(MLAT, 1024, F.G, (int)blockIdx.x);
        EpiResid<true> E{{F.in[0], F.in[2], F.out, HC, MOD + 2048, (f16*)(ws + WS_U2), F.in[7], MOD + 4096, SSQ}};
        pg8::gemm_phase<EpiResid<true>, pg8::StaticOrder, false>(ring, g, S, E);
        ctx_resid<true>(F, (const f16*)(ws + WS_Y), 1024, (const f16*)(ws + WS_WOUT0), E.P);
    } break;
    case 6: if (!((PH_MASK >> 6) & 1)) break; {
        pg8::Gemm g{(const f16*)(ws + WS_U2), (const f16*)(ws + WS_WGU0), MLAT, 2 * DFF, 1024}; pg8::StaticOrder S; S.init(MLAT, 2 * DFF, F.G, (int)blockIdx.x);
        EpiGU E{{(f16*)(ws + WS_ACT), SSQ, SHW}};
        pg8::gemm_phase<EpiGU, pg8::StaticOrder, false>(ring, g, S, E);
        ctx_gu(F, (const f16*)(ws + WS_U2), (const f16*)(ws + WS_WGU0), E.P);
    } break;
    case 7: if (!((PH_MASK >> 7) & 1)) break; {
        pg8::Gemm g{(const f16*)(ws + WS_ACT), (const f16*)(ws + WS_WD0), MLAT, 1024, DFF}; pg8::StaticOrder S; S.init(MLAT, 1024, F.G, (int)blockIdx.x);
        EpiResid<true> E{{F.out, HC, F.out, HC, MOD + 5120, (f16*)(ws + WS_U1), F.in[6] + 1024, MOD + 3 * 6144 + 1024, SSQ + MALL}};
        pg8::gemm_phase<EpiResid<true>, pg8::StaticOrder, false>(ring, g, S, E);
        ctx_resid<true>(F, (const f16*)(ws + WS_ACT), DFF, (const f16*)(ws + WS_WD0), E.P);
    } break;
    case 8: if (!((PH_MASK >> 8) & 1)) break; {
        pg8::Gemm g{(const f16*)(ws + WS_U1), (const f16*)(ws + WS_WQKV), MLAT, 3072, 1024}; pg8::StaticOrder S; S.init(MLAT, 3072, F.G, (int)blockIdx.x);
        EpiQKV E{{(f16*)(ws + WS_Q), (f16*)(ws + WS_KC), 0.125f * LOG2E, SSQ + MALL, SHW + 3 * 5632}};
        static_assert(WS_K - WS_Q == 32 * MiB && WS_V - WS_K == 32 * MiB && WS_VC - WS_KC == 1 * MiB, "EpiQKV strides");
        pg8::gemm_phase<EpiQKV, pg8::StaticOrder, false>(ring, g, S, E);
        ctx_kv(F, (const f16*)(ws + WS_U1), (const f16*)(ws + WS_WQKV), E.P);
    } break;
    case 9: if (!((PH_MASK >> 9) & 1)) break; { p11_na(F); } break;
    case 10: if (!((PH_MASK >> 10) & 1)) break; {
        pg8::Gemm g{(const f16*)(ws + WS_O), (const f16*)(ws + WS_WO1), MLAT, 1024, 1024}; pg8::StaticOrder S; S.init(MLAT, 1024, F.G, (int)blockIdx.x);
        EpiResid<true> E{{F.out, HC, F.out, HC, MOD + 3 * 6144 + 2048, (f16*)(ws + WS_U3), F.in[7] + 1024, MOD + 3 * 6144 + 4096, SSQ + 2 * MALL}};
        pg8::gemm_phase<EpiResid<true>, pg8::StaticOrder, false>(ring, g, S, E);
    } break;
    case 11: if (!((PH_MASK >> 11) & 1)) break; {
        pg8::Gemm g{(const f16*)(ws + WS_U3), (const f16*)(ws + WS_WGU1), MLAT, 2 * DFF, 1024}; pg8::StaticOrder S; S.init(MLAT, 2 * DFF, F.G, (int)blockIdx.x);
        EpiGU E{{(f16*)(ws + WS_ACT1), SSQ + 2 * MALL, SHW + 3 * 5632 + 3 * 3072}};
        pg8::gemm_phase<EpiGU, pg8::StaticOrder, false>(ring, g, S, E);
    } break;
    case 12: if (!((PH_MASK >> 12) & 1)) break; {
        pg8::Gemm g{(const f16*)(ws + WS_ACT1), (const f16*)(ws + WS_WD1), MLAT, 1024, DFF}; pg8::StaticOrder S; S.init(MLAT, 1024, F.G, (int)blockIdx.x);
        EpiResid<false> E{{F.out, HC, F.out, HC, MOD + 3 * 6144 + 5120, nullptr, nullptr, nullptr, nullptr}};
        pg8::gemm_phase<EpiResid<false>, pg8::StaticOrder, false>(ring, g, S, E);
    } break;
    case 13: if (!((PH_MASK >> 13) & 1)) break; { final_phase(F); } break;
        default: break;
        }
        if (ph + 1 < hi) xcd_barrier(bar);
#ifdef PROBE_MASK
        if ((PROBE_MASK >> ph) & 1) probe_acc += __builtin_amdgcn_s_memrealtime() - probe_t0;
#endif
    }
#ifdef PROBE_MASK
    if (blockIdx.x == 0) { const unsigned long long t0 = __builtin_amdgcn_s_memrealtime(); while (__builtin_amdgcn_s_memrealtime() - t0 < (unsigned long long)PROBE_AMP * (probe_acc + F.pacc)) __builtin_amdgcn_s_sleep(8); }
#endif
#undef IN
#undef SEAM
}

#ifdef DBG_STOP
__global__ void dbg_dump(const u16* src, float* out, size_t n, size_t nvalid) { for (size_t i = (size_t)blockIdx.x * blockDim.x + threadIdx.x; i < n; i += (size_t)gridDim.x * blockDim.x) out[i] = i < nvalid ? h2f(src[i]) : 0.f; }
__global__ void dbg_dump32(const float* src, float* out, size_t n, size_t nvalid) { for (size_t i = (size_t)blockIdx.x * blockDim.x + threadIdx.x; i < n; i += (size_t)gridDim.x * blockDim.x) out[i] = i < nvalid ? src[i] : 0.f; }
#endif
extern "C" void kernel_launch(void* const* d_in, const int* in_sizes, int n_in, void* d_out, int out_size, void* d_ws, size_t ws_size, hipStream_t stream) {
    static int grid = 0;
    if (grid == 0) {
        if (n_in != 26 || out_size != MLAT * DM || ws_size < WS_END) { fprintf(stderr, "kernel_launch: unexpected shapes (n_in %d out %d ws %zu)\n", n_in, out_size, ws_size); grid = -1; return; }
        int dev = 0, cus = 0;
        if (hipGetDevice(&dev) != hipSuccess || hipDeviceGetAttribute(&cus, hipDeviceAttributeMultiprocessorCount, dev) != hipSuccess) { grid = -1; return; }
        if (hipFuncSetAttribute((const void*)fwd_kernel, hipFuncAttributeMaxDynamicSharedMemorySize, LDS_BYTES) != hipSuccess) { fprintf(stderr, "kernel_launch: hipFuncSetAttribute failed\n"); grid = -1; return; }
        int per_cu = 0;
        if (hipOccupancyMaxActiveBlocksPerMultiprocessor(&per_cu, (const void*)fwd_kernel, NWAVES * 64, LDS_BYTES) != hipSuccess || per_cu < 1) fprintf(stderr, "kernel_launch: occupancy query reports %d\n", per_cu);
        (void)hipGetLastError();
        grid = cus;
    }
    if (grid < 0) return;
    (void)hipMemsetAsync((char*)d_ws + WS_CTL, 0, CTL_ZERO_BYTES, stream);
    Args a{};
    for (int i = 0; i < 26; ++i) a.in[i] = (const float*)d_in[i];
    a.out = (float*)d_out; a.ws = (unsigned char*)d_ws;
#ifdef DBG_STOP
    for (int p = 0; p <= DBG_STOP; ++p) { a.ph_lo = p; a.ph_hi = p + 1; hipLaunchKernelGGL(fwd_kernel, dim3(grid), dim3(NWAVES * 64), LDS_BYTES, stream, a); }
#if DBG_F32 == 2
#elif DBG_F32
    hipLaunchKernelGGL(dbg_dump32, dim3(2048), dim3(256), 0, stream, (const float*)((const char*)d_ws + DBG_OFF), (float*)d_out, (size_t)MLAT * DM, (size_t)DBG_N);
#else
    hipLaunchKernelGGL(dbg_dump, dim3(2048), dim3(256), 0, stream, (const u16*)((const char*)d_ws + DBG_OFF), (float*)d_out, (size_t)MLAT * DM, (size_t)DBG_N);
#endif
#elif MK_PER_PHASE
    for (int p = 0; p < NPHASE; ++p) { a.ph_lo = p; a.ph_hi = p + 1; hipLaunchKernelGGL(fwd_kernel, dim3(grid), dim3(NWAVES * 64), LDS_BYTES, stream, a); }
#else
    a.ph_lo = 0; a.ph_hi = NPHASE;
    hipLaunchKernelGGL(fwd_kernel, dim3(grid), dim3(NWAVES * 64), LDS_BYTES, stream, a);
#endif
}
```

```cpp
#include <hip/hip_runtime.h>
#include <cstdio>
#include <cstdint>

#ifndef MK_PER_PHASE
#define MK_PER_PHASE 0
#endif

#define LAS __attribute__((address_space(3)))
#define GAS __attribute__((address_space(1)))
typedef _Float16 f16;
typedef _Float16 f16x8 __attribute__((ext_vector_type(8)));
typedef _Float16 f16x4 __attribute__((ext_vector_type(4)));
typedef _Float16 f16x2 __attribute__((ext_vector_type(2)));
typedef float f32x4 __attribute__((ext_vector_type(4)));
typedef float f32x2 __attribute__((ext_vector_type(2)));
typedef unsigned u32x4 __attribute__((ext_vector_type(4)));
typedef unsigned u32x2 __attribute__((ext_vector_type(2)));
typedef unsigned short u16;

__device__ __forceinline__ unsigned pkh(float lo, float hi) { f16x2 v = {(f16)lo, (f16)hi}; return __builtin_bit_cast(unsigned, v); }
__device__ __forceinline__ float h2f(u16 b) { return (float)__builtin_bit_cast(f16, b); }

constexpr int DM = 1024, BATCH = 2, SEQ = 8192, CTXL = 256, DFF = 2816;
constexpr int MLAT = BATCH * SEQ;
constexpr int MCTX = BATCH * CTXL;
constexpr int MALL = MLAT + MCTX;
constexpr int NHEAD = 16, HD = 64;
constexpr int FILT_T = SEQ + CTXL;
constexpr float RMS_EPS = 1e-6f;
constexpr float LOG2E = 1.4426950408889634f;

namespace pg8 {
constexpr int BM = 256, BK = 64, HALF = 128, HTB = HALF * BK * 2, STAGE_BYTES = 8 * HTB, NXCD = 8, WGM = 8;
__host__ __device__ __forceinline__ int lds_byte(int r, int c) { const int st = (r >> 4) * 2 + (c >> 5), rr = r & 15, cc = c & 31, ob = rr * 64 + cc * 2; return st * 1024 + (ob ^ (((ob >> 9) & 1) << 5)); }
__host__ __device__ __forceinline__ void stage_rc(int b, int& R, int& C) { const int st = b / 1024, sb = b % 1024, swz = sb ^ (((sb >> 9) & 1) << 5); R = (st >> 1) * 16 + swz / 64; C = (st & 1) * 32 + (swz % 64) / 2; }

struct Unit { int pm, pn; };
struct Gemm { const f16* A; const f16* Bt; int M, N, K; };

struct StaticOrder {
    int nM, nN, nwg, G, c;
    __device__ void init(int M, int N, int G_, int c_) { nM = M / BM; nN = N / BM; nwg = nM * nN; G = G_; c = c_; }
    __device__ bool next(int i, Unit& u) const {
        const long L = (long)i * G + c; if (L >= nwg) return false;
        int wgid = (int)L; { const int q = nwg / NXCD, r = nwg % NXCD, xcd = wgid % NXCD, off = wgid / NXCD; wgid = (xcd < r ? xcd * (q + 1) : r * (q + 1) + (xcd - r) * q) + off; }
        const int nig = WGM * nN, gid = wgid / nig, fm = gid * WGM, gsz = (nM - fm) < WGM ? (nM - fm) : WGM;
        u.pm = fm + ((wgid % nig) % gsz); u.pn = (wgid % nig) / gsz; return true;
    }
};
struct QkvOrder {
    int G, c;
    __device__ bool next(int i, Unit& u) const {
        const long L = (long)i * G + c; if (L >= 784) return false;
        if (L >= 768) { const int r = (int)L - 768; u.pm = 64 + (r & 1); u.pn = 4 + (r >> 1); return true; }
        int wgid = (int)L; { const int q = 768 / NXCD, xcd = wgid % NXCD, off = wgid / NXCD; wgid = xcd * q + off; }
        const int nig = WGM * 12, gid = wgid / nig, fm = gid * WGM;
        u.pm = fm + ((wgid % nig) % WGM); u.pn = (wgid % nig) / WGM; return true;
    }
};

template <class Epi, class Sched, bool SWAP>
__device__ __forceinline__ void gemm_phase(LAS unsigned char* lds, const Gemm g, const Sched& S, const Epi& E) {
    int tid = threadIdx.x; asm volatile("" : "+v"(tid));
    const int wid = __builtin_amdgcn_readfirstlane(tid >> 6), lane = tid & 63, wr = wid >> 2, wc = wid & 3, fr = lane & 15, fq = lane >> 4;
    const int K = g.K, nt = K / BK;
    unsigned voffA[2];
#pragma unroll
    for (int i = 0; i < 2; ++i) { int R, C; stage_rc(tid * 16 + i * 8192, R, C); voffA[i] = (unsigned)(R * K + C) * 2u; }
    const size_t kstep = (size_t)(BK * 2);
    const size_t hstep = (size_t)HALF * K * 2;
    const size_t tstep = 2 * hstep;
    const unsigned ldsw = (unsigned)wid * 1024u;
    const int aoff = lds_byte(wr * 64 + fr, fq * 8), boff = lds_byte(wc * 32 + fr, fq * 8);
#define PG8_SA(b, h) (((b) * 2 + (h)) * HTB)
#define PG8_SB(b, h) ((4 + (b) * 2 + (h)) * HTB)
#define PG8_STAGE(bufoff, gbase) do { _Pragma("unroll") for (int _i = 0; _i < 2; ++_i) \
        __builtin_amdgcn_global_load_lds((const unsigned*)((const char*)(gbase) + voffA[_i]), (LAS unsigned*)(lds + (bufoff) + ldsw + _i * 8192), 16, 0, 0); } while (0)
#define PG8_LDA(dst, b, h) do { _Pragma("unroll") for (int m = 0; m < 4; ++m) _Pragma("unroll") for (int k = 0; k < 2; ++k) dst[m][k] = *(const LAS f16x8*)(lds + PG8_SA(b, h) + aoff + m * 2048 + k * 1024); } while (0)
#define PG8_LDB(dst, b, h) do { _Pragma("unroll") for (int n = 0; n < 2; ++n) _Pragma("unroll") for (int k = 0; k < 2; ++k) dst[n][k] = *(const LAS f16x8*)(lds + PG8_SB(b, h) + boff + n * 2048 + k * 1024); } while (0)
#define PG8_MMA(ai, bj, At, Bt) do { __builtin_amdgcn_s_setprio(1); _Pragma("unroll") for (int m = 0; m < 4; ++m) _Pragma("unroll") for (int n = 0; n < 2; ++n) _Pragma("unroll") for (int k = 0; k < 2; ++k) \
        acc[ai][bj][m][n] = SWAP ? __builtin_amdgcn_mfma_f32_16x16x32_f16(At[m][k], Bt[n][k], acc[ai][bj][m][n], 0, 0, 0) \
                                 : __builtin_amdgcn_mfma_f32_16x16x32_f16(Bt[n][k], At[m][k], acc[ai][bj][m][n], 0, 0, 0); __builtin_amdgcn_s_setprio(0); } while (0)
#define PG8_WAIT_V(n) asm volatile("s_waitcnt vmcnt(" #n ")" ::: "memory")
#define PG8_WAIT_L(n) asm volatile("s_waitcnt lgkmcnt(" #n ")" ::: "memory")
#define PG8_BAR __builtin_amdgcn_s_barrier()
#define PG8_SCHED __builtin_amdgcn_sched_barrier(0)
    Unit cur, nxt; int ui = 0;
    if (!S.next(0, cur)) return;
    f32x4 acc[2][2][4][2];
#pragma unroll
    for (int a = 0; a < 2; ++a)
#pragma unroll
        for (int b = 0; b < 2; ++b)
#pragma unroll
            for (int m = 0; m < 4; ++m)
#pragma unroll
                for (int n = 0; n < 2; ++n) acc[a][b][m][n] = (f32x4){0.f, 0.f, 0.f, 0.f};
    f16x8 At[4][2], B0[2][2], B1[2][2];
    const char* cA = (const char*)g.A + (size_t)cur.pm * tstep; const char* cB = (const char*)g.Bt + (size_t)cur.pn * tstep;
    PG8_STAGE(PG8_SB(0, 0), cB); PG8_STAGE(PG8_SB(0, 1), cB + hstep); PG8_STAGE(PG8_SA(0, 0), cA); PG8_STAGE(PG8_SA(0, 1), cA + hstep);
    if (wr == 1) PG8_BAR;
    PG8_WAIT_V(2); PG8_BAR;
    PG8_STAGE(PG8_SB(1, 0), cB + kstep); PG8_STAGE(PG8_SA(1, 0), cA + kstep); PG8_STAGE(PG8_SB(1, 1), cB + hstep + kstep);
    PG8_WAIT_V(6); PG8_BAR;
    for (;;) {
        const bool has_next = S.next(ui + 1, nxt);
        const char* nA = has_next ? (const char*)g.A + (size_t)nxt.pm * tstep : cA; const char* nB = has_next ? (const char*)g.Bt + (size_t)nxt.pn * tstep : cB;
        for (int t = 0; t < nt; t += 2) {
            const bool last = (t == nt - 2);
            const char* a1 = cA + (size_t)(t + 1) * kstep;
            const char* a2 = last ? nA : cA + (size_t)(t + 2) * kstep; const char* b2 = last ? nB : cB + (size_t)(t + 2) * kstep;
            const char* a3 = a2 + kstep; const char* b3 = b2 + kstep;
            PG8_LDB(B0, 0, 0); PG8_LDB(B1, 0, 1); PG8_SCHED; PG8_LDA(At, 0, 0); PG8_STAGE(PG8_SA(1, 1), a1 + hstep);
            PG8_WAIT_V(8); PG8_WAIT_L(0); PG8_BAR; PG8_MMA(0, 0, At, B0); PG8_MMA(0, 1, At, B1); PG8_BAR; PG8_SCHED;
            PG8_LDA(At, 0, 1); PG8_STAGE(PG8_SB(0, 0), b2); PG8_STAGE(PG8_SB(0, 1), b2 + hstep); PG8_STAGE(PG8_SA(0, 0), a2);
            PG8_WAIT_V(8); PG8_WAIT_L(0); PG8_BAR; PG8_MMA(1, 0, At, B0); PG8_MMA(1, 1, At, B1); PG8_BAR; PG8_SCHED;
            PG8_LDB(B0, 1, 0); PG8_LDB(B1, 1, 1); PG8_SCHED; PG8_LDA(At, 1, 0); PG8_STAGE(PG8_SA(0, 1), a2 + hstep);
            PG8_WAIT_V(8); PG8_WAIT_L(0); PG8_BAR; PG8_MMA(0, 0, At, B0); PG8_MMA(0, 1, At, B1); PG8_BAR; PG8_SCHED;
            PG8_LDA(At, 1, 1); PG8_STAGE(PG8_SB(1, 0), b3); PG8_STAGE(PG8_SB(1, 1), b3 + hstep); PG8_STAGE(PG8_SA(1, 0), a3);
            PG8_WAIT_V(8); PG8_WAIT_L(0); PG8_BAR; PG8_MMA(1, 0, At, B0); PG8_MMA(1, 1, At, B1); PG8_BAR; PG8_SCHED;
        }
        if (wr == 0) PG8_BAR;
        E(acc, cur, wr, wc, fr, fq);
        if (!has_next) break;
#pragma unroll
        for (int a = 0; a < 2; ++a)
#pragma unroll
            for (int b = 0; b < 2; ++b)
#pragma unroll
                for (int m = 0; m < 4; ++m)
#pragma unroll
                    for (int n = 0; n < 2; ++n) acc[a][b][m][n] = (f32x4){0.f, 0.f, 0.f, 0.f};
        cur = nxt; cA = nA; cB = nB; ++ui;
        if (wr == 1) PG8_BAR;
    }
    PG8_WAIT_V(0);
    PG8_BAR;
#undef PG8_SA
#undef PG8_SB
#undef PG8_STAGE
#undef PG8_LDA
#undef PG8_LDB
#undef PG8_MMA
#undef PG8_WAIT_V
#undef PG8_WAIT_L
#undef PG8_BAR
#undef PG8_SCHED
}
}

constexpr size_t MiB = 1u << 20;
constexpr size_t WS_CTL = 0, CTL_ZERO_BYTES = 512 * 1024;
constexpr size_t WS_SSQ = 65536;
constexpr size_t WS_SHW = 1 * MiB + 256 * 1024;
constexpr size_t WS_MOD  = 1 * MiB;
constexpr size_t WS_HID2 = 2 * MiB;
constexpr size_t WS_HC   = 5 * MiB;
constexpr size_t WS_WIN  = 8 * MiB;
constexpr size_t WS_WOUT0 = 12 * MiB;
constexpr size_t WS_WGU0 = 14 * MiB;
constexpr size_t WS_WD0  = 26 * MiB;
constexpr size_t WS_WGU1 = 32 * MiB;
constexpr size_t WS_WD1  = 44 * MiB;
constexpr size_t WS_WQKV = 50 * MiB;
constexpr size_t WS_WO1  = 56 * MiB;
constexpr size_t WS_PT   = 64 * MiB;
constexpr size_t WS_FILT = 130 * MiB;
constexpr size_t WS_U    = 163 * MiB;
constexpr size_t WS_HS   = 163 * MiB;
constexpr size_t WS_XS   = 228 * MiB;
constexpr size_t WS_Y    = 130 * MiB;
constexpr size_t WS_U2   = 64 * MiB;
constexpr size_t WS_ACT  = 100 * MiB;
constexpr size_t WS_U1   = 64 * MiB;
constexpr size_t WS_Q    = 100 * MiB;
constexpr size_t WS_K    = 132 * MiB;
constexpr size_t WS_V    = 164 * MiB;
constexpr size_t WS_KC   = 198 * MiB;
constexpr size_t WS_VC   = 199 * MiB;
constexpr size_t WS_O    = 64 * MiB;
constexpr size_t WS_U3   = 100 * MiB;
constexpr size_t WS_ACT1 = 132 * MiB;
constexpr size_t WS_END  = 256 * MiB;
constexpr int PT_LD = MALL;

constexpr int CW_BAR = 4096;

constexpr int LDS_BYTES = 163840;
constexpr int FFT_BYTES = 16384 * 33 / 32 * 8;
constexpr int SCR_OFF = FFT_BYTES;
constexpr int MISC_OFF = LDS_BYTES - 256;
constexpr int NWAVES = 8;

#define RLX_AGENT __ATOMIC_RELAXED, __HIP_MEMORY_SCOPE_AGENT
#define LDS_WAIT() asm volatile("s_waitcnt lgkmcnt(0)" ::: "memory")
#define VM_WAIT() asm volatile("s_waitcnt vmcnt(0)" ::: "memory")

#define XB_TMO      128
#define XB_XCNT(j)  (256  + 64 * (j))
#define XB_XSUB(j)  (1280 + 64 * (j))
#define XB_XGEN(j)  (2304 + 64 * (j))
#define XB_TOP      3328
#define XB_TOPGEN   3392
#define XCD_BAR_WORDS 3456
#define XB_SPIN_CAP (1u << 18)
__device__ __forceinline__ unsigned xb_ld(unsigned* p)              { return __hip_atomic_load(p, __ATOMIC_RELAXED, __HIP_MEMORY_SCOPE_AGENT); }
__device__ __forceinline__ unsigned xb_add(unsigned* p, unsigned v) { return __hip_atomic_fetch_add(p, v, __ATOMIC_RELAXED, __HIP_MEMORY_SCOPE_AGENT); }
__device__ __forceinline__ unsigned xb_xcc_id() { return (unsigned)__builtin_amdgcn_s_getreg((3 << 11) | 20) & 0xFu; }
#define XB_SPIN(cond, bar) do { unsigned _sp = 0; while (cond) { __builtin_amdgcn_s_sleep(1); \
    if ((++_sp & 255u) == 0u) { if (xb_ld(&(bar)[XB_TMO])) break; if (_sp > XB_SPIN_CAP) { atomicAdd(&(bar)[XB_TMO], 1u); break; } } } } while (0)
struct XcdBarrier { unsigned* bar; unsigned x; volatile LAS unsigned* st; };
__device__ __forceinline__ XcdBarrier xcd_barrier_post(unsigned* bar, volatile LAS unsigned* st) {
    XcdBarrier b; b.bar = bar; b.x = xb_xcc_id(); b.st = st;
    if (threadIdx.x == 0) (void)xb_add(&bar[XB_XCNT(b.x)], 1u);
    return b;
}
__device__ __forceinline__ void xcd_barrier_complete(unsigned* bar, unsigned x, unsigned& nloc, unsigned& nx) {
    const unsigned G = gridDim.x * gridDim.y * gridDim.z;
    unsigned sum, cnt, mine, sp = 0u;
    for (;;) {
        sum = 0u; cnt = 0u; mine = 0u;
#pragma unroll
        for (unsigned j = 0; j < 16; ++j) { const unsigned c = xb_ld(&bar[XB_XCNT(j)]); sum += c; cnt += (c > 0u) ? 1u : 0u; mine = (j == x) ? c : mine; }
        if (sum == G) break;
        __builtin_amdgcn_s_sleep(1);
        if ((++sp & 255u) == 0u) { if (xb_ld(&bar[XB_TMO])) break; if (sp > XB_SPIN_CAP) { atomicAdd(&bar[XB_TMO], 1u); break; } }
    }
    nloc = mine > 0u ? mine : 1u; nx = cnt > 0u ? cnt : 1u;
}
__device__ __forceinline__ void xcd_barrier(const XcdBarrier& b) {
    asm volatile("s_waitcnt vmcnt(0)" ::: "memory");
    __syncthreads();
    if (threadIdx.x == 0) {
        unsigned* bar = b.bar;
        __builtin_amdgcn_s_waitcnt(0);
        unsigned nloc = b.st[0], nx = b.st[1];
        if (nloc == 0u) { xcd_barrier_complete(bar, b.x, nloc, nx); b.st[0] = nloc; b.st[1] = nx; }
        const unsigned old = xb_add(&bar[XB_XSUB(b.x)], 1u);
        const unsigned gen = old / nloc;
        if (old + 1u == (gen + 1u) * nloc) {
            __builtin_amdgcn_fence(__ATOMIC_RELEASE, "agent");
            asm volatile("s_waitcnt vmcnt(0)" ::: "memory");
            const unsigned og = xb_add(&bar[XB_TOP], 1u);
            const unsigned tg = og / nx;
            if (og + 1u == (tg + 1u) * nx) xb_add(&bar[XB_TOPGEN], 1u);
            else XB_SPIN(xb_ld(&bar[XB_TOPGEN]) == tg, bar);
            __builtin_amdgcn_fence(__ATOMIC_ACQUIRE, "agent");
            xb_add(&bar[XB_XGEN(b.x)], 1u);
            asm volatile("s_waitcnt vmcnt(0)" ::: "memory");
        } else {
            XB_SPIN(xb_ld(&bar[XB_XGEN(b.x)]) == gen, bar);
            __builtin_amdgcn_fence(__ATOMIC_ACQUIRE, "agent");
            asm volatile("s_waitcnt vmcnt(0)" ::: "memory");
        }
    }
    __syncthreads();
}

struct Frame {
    LAS unsigned char* lds;
    int vcu, G;
    unsigned long long pacc;
    const float* const* in;
    float* out; unsigned char* ws;
};
#define LOCAL_IDS() int tid = threadIdx.x; asm volatile("" : "+v"(tid)); const int lane = tid & 63; const int wave = __builtin_amdgcn_readfirstlane(tid >> 6); (void)lane; (void)wave
__device__ __forceinline__ float wave_sum(float v) {
#pragma unroll
    for (int o = 1; o < 64; o <<= 1) v += __shfl_xor(v, o);
    return v;
}
__device__ __forceinline__ float silu_f(float x) { return x / (1.f + __expf(-x)); }
__device__ __forceinline__ float sin_rev(float r) { return __builtin_amdgcn_sinf(__builtin_amdgcn_fractf(r)); }
__device__ __forceinline__ float cos_rev(float r) { return __builtin_amdgcn_cosf(__builtin_amdgcn_fractf(r)); }
__device__ __forceinline__ float sin_rad(float x) { return sin_rev(x * 0.15915494309189535f); }

__device__ __forceinline__ void transpose_item(const float* W, int N, f16* WT, int ldt, int k0, int n0, int drow0, LAS float* scr, int lane) {
#pragma unroll 8
    for (int i = 0; i < 32; ++i) { const int kk = 2 * i + (lane >> 5); scr[kk * 33 + (lane & 31)] = W[(size_t)(k0 + kk) * N + n0 + (lane & 31)]; }
    LDS_WAIT(); asm volatile("" ::: "memory");
    const int c = lane & 7;
#pragma unroll
    for (int j = 0; j < 4; ++j) { const int n = (lane >> 3) + 8 * j; const LAS float* s = scr + (8 * c) * 33 + n;
        u32x4 o; o.x = pkh(s[0 * 33], s[1 * 33]); o.y = pkh(s[2 * 33], s[3 * 33]); o.z = pkh(s[4 * 33], s[5 * 33]); o.w = pkh(s[6 * 33], s[7 * 33]);
        *(u32x4*)(WT + (size_t)(drow0 + n0 + n) * ldt + k0 + 8 * c) = o; }
    LDS_WAIT(); asm volatile("" ::: "memory");
}
__device__ __forceinline__ void fold_item(const float* Win, f16* WT, int g, int k0, LAS float* scr, int lane) {
    LAS float* wrow = scr;
    LAS float* tcs = scr + 256;
#pragma unroll
    for (int i = 0; i < 4; ++i) { const int e = i * 64 + lane; wrow[e] = Win[(size_t)(k0 + (e >> 7)) * 2048 + 128 * g + (e & 127)]; }
    { const float r0 = (float)lane * (1.f / 128.f), r1 = (float)(lane + 64) * (1.f / 128.f);
      tcs[lane] = cos_rev(r0); tcs[lane + 64] = cos_rev(r1); tcs[128 + lane] = sin_rev(r0); tcs[128 + lane + 64] = sin_rev(r1); }
    LDS_WAIT(); asm volatile("" ::: "memory");
#pragma unroll
    for (int half = 0; half < 2; ++half) {
        const int mp = lane + 64 * half;
        const int m = (mp <= 64) ? mp : mp - 64; const int tb = (mp <= 64) ? 0 : 128;
        float a0 = 0.f, a1 = 0.f, b0 = 0.f, b1 = 0.f;
#pragma unroll 8
        for (int c = 0; c < 128; c += 2) { const float f0 = tcs[tb + ((m * c) & 127)], f1 = tcs[tb + ((m * (c + 1)) & 127)];
            a0 += wrow[c] * f0; a1 += wrow[128 + c] * f0; b0 += wrow[c + 1] * f1; b1 += wrow[128 + c + 1] * f1; }
        const float s = 1.f / 1024.f;
        *(unsigned*)(WT + (size_t)(128 * g + mp) * 1024 + k0) = pkh((a0 + b0) * s, (a1 + b1) * s);
    }
    LDS_WAIT(); asm volatile("" ::: "memory");
}
__device__ __forceinline__ void hid_rows(Frame& F, int gw, int NGW) {
    LOCAL_IDS();
    const float* w1 = F.in[15]; const float* b1 = F.in[16]; const float* fr = F.in[17]; const float* w2 = F.in[18]; const float* b2 = F.in[19];
    float* HID2 = (float*)(F.ws + WS_HID2);
    LAS float* wl = (LAS float*)F.lds;
    __syncthreads();
    for (int e = tid; e < 33 * 64; e += 512) wl[e] = w1[e];
    for (int e = tid; e < 64 * 64; e += 512) wl[33 * 64 + e] = w2[e];
    __syncthreads();
    const int j = lane;
    const float bb1 = b1[j], bb2 = b2[j], fq = fr[j];
    for (int t = gw; t < FILT_T; t += NGW) {
        const int L = t < SEQ ? SEQ : CTXL, tt = t < SEQ ? t : t - SEQ;
        float z = 0.f;
        if (j == 0) z = (float)tt / (float)(L - 1);
        else if (j < 33) { const int bnd = (j - 1) & 15; const float band = 1e-4f + (float)bnd * ((15.f - 1e-4f) / 15.f);
            const float rev = (float)tt * band / (float)L;
            z = (j <= 16) ? cos_rev(rev) : -sin_rev(rev); }
        float a1 = bb1;
#pragma unroll
        for (int i = 0; i < 33; ++i) a1 += __builtin_bit_cast(float, __builtin_amdgcn_readlane(__builtin_bit_cast(int, z), i)) * wl[i * 64 + j];
        const float h1 = sin_rad(fq * a1);
        float a2 = bb2;
#pragma unroll
        for (int i = 0; i < 64; ++i) a2 += __builtin_bit_cast(float, __builtin_amdgcn_readlane(__builtin_bit_cast(int, h1), i)) * wl[(33 + i) * 64 + j];
        HID2[(size_t)t * 64 + j] = sin_rad(fq * a2);
    }
    __syncthreads();
}
__device__ __forceinline__ void ada_items(Frame& F) {
    LOCAL_IDS();
    const float* c = F.in[1]; const float* cctx = F.in[3]; const float* aw = F.in[4]; const float* ab = F.in[5];
    float* MOD = (float*)(F.ws + WS_MOD);
    LAS float* sl = (LAS float*)F.lds;
    LAS float* red = (LAS float*)(F.lds + 16384);
    bool have = false;
    for (int it = F.vcu; it < 192; it += F.G) {
        if (!have) { for (int e = tid; e < 3072; e += 512) { const int r = e >> 10, k = e & 1023; const float v = r < 2 ? c[r * 1024 + k] : cctx[k]; sl[e] = silu_f(v); } have = true; __syncthreads(); }
        const int layer = it / 96, n0 = (it % 96) * 64;
        const int kq = tid >> 4, cq = tid & 15;
        f32x4 a0 = {0.f, 0.f, 0.f, 0.f}, a1 = a0, a2 = a0;
        const float* wp = aw + ((size_t)layer * 1024) * 6144 + n0 + 4 * cq;
#pragma unroll 4
        for (int kk = kq; kk < 1024; kk += 32) { const f32x4 w = *(const f32x4*)(wp + (size_t)kk * 6144);
            a0 += w * sl[kk]; a1 += w * sl[1024 + kk]; a2 += w * sl[2048 + kk]; }
#pragma unroll
        for (int e = 0; e < 4; ++e) { red[(kq * 3 + 0) * 64 + 4 * cq + e] = a0[e]; red[(kq * 3 + 1) * 64 + 4 * cq + e] = a1[e]; red[(kq * 3 + 2) * 64 + 4 * cq + e] = a2[e]; }
        __syncthreads();
        if (tid < 192) { const int r = tid >> 6, col = tid & 63; float s = ab[layer * 6144 + n0 + col];
            for (int q = 0; q < 32; ++q) s += red[(q * 3 + r) * 64 + col];
            MOD[(size_t)(layer * 3 + r) * 6144 + n0 + col] = s; }
        __syncthreads();
    }
}
__device__ __forceinline__ void p0_prep(Frame& F) {
    LOCAL_IDS();
    const int gw = F.vcu * NWAVES + wave, NGW = F.G * NWAVES;
    ada_items(F);
    __syncthreads();
    LAS float* scr = (LAS float*)(F.lds + wave * 16384);
    f16* Win_t = (f16*)(F.ws + WS_WIN);
    constexpr int I_WIN = 16 * 48, I_WOUT = 16 * 32, I_G = 16 * 88, I_D = 44 * 32, I_QKV = 16 * 96, I_O1 = 16 * 32;
    constexpr int NIT = I_WIN + I_WOUT + 4 * I_G + 2 * I_D + I_QKV + I_O1;
    for (int it = gw; it < NIT; it += NGW) {
        int r = it;
        if (r < I_WIN) { const int kb = r / 48, nb = r % 48; transpose_item(F.in[11], 2048, Win_t, 1024, 64 * kb, 512 + 32 * nb, 0, scr, lane); continue; } r -= I_WIN;
        if (r < I_WOUT) { const int kb = r / 32, nb = r % 32; transpose_item(F.in[12], 1024, (f16*)(F.ws + WS_WOUT0), 1024, 64 * kb, 32 * nb, 0, scr, lane); continue; } r -= I_WOUT;
        if (r < 4 * I_G) { const int which = r / I_G, rr = r % I_G, layer = which >> 1, up = which & 1; const int kb = rr / 88, nb = rr % 88, n0 = 32 * nb;
            const float* src = (up ? F.in[9] : F.in[8]) + (size_t)layer * 1024 * DFF;
            f16* dst = (f16*)(F.ws + (layer ? WS_WGU1 : WS_WGU0));
            const int drow0 = (n0 >> 7) * 256 + (up ? 128 : 0) + (n0 & 127) - n0;
            transpose_item(src, DFF, dst, 1024, 64 * kb, n0, drow0, scr, lane); continue; } r -= 4 * I_G;
        if (r < 2 * I_D) { const int layer = r / I_D, rr = r % I_D; const int kb = rr / 32, nb = rr % 32;
            transpose_item(F.in[10] + (size_t)layer * DFF * 1024, 1024, (f16*)(F.ws + (layer ? WS_WD1 : WS_WD0)), DFF, 64 * kb, 32 * nb, 0, scr, lane); continue; } r -= 2 * I_D;
        if (r < I_QKV) { const int kb = r / 96, nb = r % 96; transpose_item(F.in[22], 3072, (f16*)(F.ws + WS_WQKV), 1024, 64 * kb, 32 * nb, 0, scr, lane); continue; } r -= I_QKV;
        { const int kb = r / 32, nb = r % 32; transpose_item(F.in[23], 1024, (f16*)(F.ws + WS_WO1), 1024, 64 * kb, 32 * nb, 0, scr, lane); }
    }
    for (int it = gw; it < 2048; it += NGW) fold_item(F.in[11], Win_t, it >> 9, (it & 511) * 2, scr, lane);
    hid_rows(F, gw, NGW);
}

__device__ __forceinline__ void norm_mod_row(const float* xrow, const float* g, const float* sh, const float* sc, f16* orow, int lane) {
    const f32x4* xr = (const f32x4*)xrow + lane;
    f32x4 v[4]; float s = 0.f;
#pragma unroll
    for (int j = 0; j < 4; ++j) { v[j] = xr[64 * j]; s += (v[j].x * v[j].x + v[j].y * v[j].y) + (v[j].z * v[j].z + v[j].w * v[j].w); }
    const float rstd = 1.f / sqrtf(wave_sum(s) * (1.f / DM) + RMS_EPS);
    u32x2* o8 = (u32x2*)orow + lane;
#pragma unroll
    for (int j = 0; j < 4; ++j) { const f32x4 gg = ((const f32x4*)g)[lane + 64 * j], s1 = ((const f32x4*)sc)[lane + 64 * j], s0 = ((const f32x4*)sh)[lane + 64 * j];
        const f32x4 y = (v[j] * rstd) * gg * (s1 + 1.f) + s0;
        u32x2 w; w.x = pkh(y.x, y.y); w.y = pkh(y.z, y.w); o8[64 * j] = w; }
}
__device__ __forceinline__ void norm_phase(Frame& F, const float* hl, const float* hc, const float* g, int layer, int sh_off, int sc_off, f16* U, int nrows) {
    LOCAL_IDS();
    const int gw = F.vcu * NWAVES + wave, NGW = F.G * NWAVES;
    const float* MOD = (const float*)(F.ws + WS_MOD) + (size_t)layer * 3 * 6144;
    for (int m0 = gw; m0 < nrows; m0 += 2 * NGW) {
        const int m1 = m0 + NGW; const bool two = m1 < nrows;
        const float* s0 = m0 < MLAT ? hl + (size_t)m0 * DM : hc + (size_t)(m0 - MLAT) * DM;
        const float* s1 = two ? (m1 < MLAT ? hl + (size_t)m1 * DM : hc + (size_t)(m1 - MLAT) * DM) : s0;
        const f32x4* x0 = (const f32x4*)s0 + lane; const f32x4* x1 = (const f32x4*)s1 + lane;
        f32x4 v0[4], v1[4]; float q0 = 0.f, q1 = 0.f;
#pragma unroll
        for (int j = 0; j < 4; ++j) { v0[j] = x0[64 * j]; v1[j] = x1[64 * j]; }
#pragma unroll
        for (int j = 0; j < 4; ++j) { q0 += (v0[j].x * v0[j].x + v0[j].y * v0[j].y) + (v0[j].z * v0[j].z + v0[j].w * v0[j].w); q1 += (v1[j].x * v1[j].x + v1[j].y * v1[j].y) + (v1[j].z * v1[j].z + v1[j].w * v1[j].w); }
        const float rs0 = 1.f / sqrtf(wave_sum(q0) * (1.f / DM) + RMS_EPS), rs1 = 1.f / sqrtf(wave_sum(q1) * (1.f / DM) + RMS_EPS);
        const int r0 = m0 < MLAT ? (m0 >> 13) : 2, r1 = m1 < MLAT ? (m1 >> 13) : 2;
#pragma unroll
        for (int j = 0; j < 4; ++j) { const f32x4 gg = ((const f32x4*)g)[lane + 64 * j];
            { const f32x4 sc = ((const f32x4*)(MOD + r0 * 6144 + sc_off))[lane + 64 * j], sh = ((const f32x4*)(MOD + r0 * 6144 + sh_off))[lane + 64 * j];
              const f32x4 y = (v0[j] * rs0) * gg * (sc + 1.f) + sh; u32x2 w; w.x = pkh(y.x, y.y); w.y = pkh(y.z, y.w); ((u32x2*)(U + (size_t)m0 * DM))[lane + 64 * j] = w; }
            if (two) { const f32x4 sc = ((const f32x4*)(MOD + r1 * 6144 + sc_off))[lane + 64 * j], sh = ((const f32x4*)(MOD + r1 * 6144 + sh_off))[lane + 64 * j];
              const f32x4 y = (v1[j] * rs1) * gg * (sc + 1.f) + sh; u32x2 w; w.x = pkh(y.x, y.y); w.y = pkh(y.z, y.w); ((u32x2*)(U + (size_t)m1 * DM))[lane + 64 * j] = w; } }
    }
}
__device__ __forceinline__ void final_phase(Frame& F) {
    LOCAL_IDS();
    const int gw = F.vcu * NWAVES + wave, NGW = F.G * NWAVES;
    const float* g = F.in[25];
    for (int m = gw; m < MLAT; m += NGW) {
        f32x4* xr = (f32x4*)(F.out + (size_t)m * DM) + lane;
        f32x4 v[4]; float s = 0.f;
#pragma unroll
        for (int j = 0; j < 4; ++j) { v[j] = xr[64 * j]; s += (v[j].x * v[j].x + v[j].y * v[j].y) + (v[j].z * v[j].z + v[j].w * v[j].w); }
        const float rstd = 1.f / sqrtf(wave_sum(s) * (1.f / DM) + RMS_EPS);
#pragma unroll
        for (int j = 0; j < 4; ++j) xr[64 * j] = (v[j] * rstd) * ((const f32x4*)g)[lane + 64 * j];
    }
}

__device__ __forceinline__ void filt_gemm(Frame& F) {
    LOCAL_IDS();
    const int gw = F.vcu * NWAVES + wave, NGW = F.G * NWAVES;
    const float* HID2 = (const float*)(F.ws + WS_HID2); const float* w3 = F.in[20];
    f16* FILT = (f16*)(F.ws + WS_FILT);
    const int li = lane & 15, lg = lane >> 4;
    constexpr int NTB = FILT_T / 64;
    LAS u16* stg = (LAS u16*)(F.lds + wave * 4096);
    const int cb = gw & 127, ch0 = cb * 16;
    f16x8 bw[2];
#pragma unroll
    for (int ks = 0; ks < 2; ++ks)
#pragma unroll
        for (int j = 0; j < 8; ++j) bw[ks][j] = (f16)w3[(size_t)(32 * ks + 8 * lg + j) * 2048 + ch0 + li];
    const int c = (ch0 + li) & 511;
    const float mind = -3.0701134573253945f, maxd = -15.350567286626973f;
    const float delta = fabsf(mind + (float)c * ((maxd - mind) / 511.f));
    for (int tb = gw >> 7; tb < NTB; tb += NGW >> 7) {
        const int t0 = tb * 64;
#pragma unroll
        for (int s = 0; s < 4; ++s) {
            f32x4 acc = {0.f, 0.f, 0.f, 0.f};
            const f32x4* hp = (const f32x4*)(HID2 + (size_t)(t0 + 16 * s + li) * 64 + 8 * lg);
#pragma unroll
            for (int ks = 0; ks < 2; ++ks) { const f32x4 h0 = hp[8 * ks], h1 = hp[8 * ks + 1];
                f16x8 hi, lo;
#pragma unroll
                for (int e = 0; e < 4; ++e) { hi[e] = (f16)h0[e]; lo[e] = (f16)(h0[e] - (float)hi[e]); hi[4 + e] = (f16)h1[e]; lo[4 + e] = (f16)(h1[e] - (float)hi[4 + e]); }
                acc = __builtin_amdgcn_mfma_f32_16x16x32_f16(hi, bw[ks], acc, 0, 0, 0);
                acc = __builtin_amdgcn_mfma_f32_16x16x32_f16(lo, bw[ks], acc, 0, 0, 0); }
            const int tq = t0 + 16 * s + 4 * lg;
            float o[4];
#pragma unroll
            for (int e = 0; e < 4; ++e) { const int t = tq + e; const float t01 = t < SEQ ? (float)t * (1.f / (SEQ - 1)) : (float)(t - SEQ) * (1.f / (CTXL - 1)); o[e] = acc[e] * __expf(-t01 * delta); }
            u32x2 w; w.x = pkh(o[0], o[1]); w.y = pkh(o[2], o[3]);
            *(LAS u32x2*)(stg + li * 72 + 16 * s + 4 * lg) = w;
        }
        LDS_WAIT(); asm volatile("" ::: "memory");
#pragma unroll
        for (int i = 0; i < 2; ++i) { const int chl = (lane >> 3) + 8 * i, seg = lane & 7;
            const u32x4 v = *(const LAS u32x4*)(stg + chl * 72 + 8 * seg);
            *(u32x4*)(FILT + (size_t)(ch0 + chl) * FILT_T + t0 + 8 * seg) = v; }
        LDS_WAIT(); asm volatile("" ::: "memory");
    }
}

__device__ __forceinline__ void shw_tasks(Frame& F) {
    LOCAL_IDS();
    const int gw = F.vcu * NWAVES + wave, NGW = F.G * NWAVES;
    const float* MOD = (const float*)(F.ws + WS_MOD); float* SHW = (float*)(F.ws + WS_SHW);
    for (int n = gw; n < 5632 + 3072 + 5632; n += NGW) {
        const f16* wrow; const float* sh; float* dst; int N;
        if (n < 5632) { wrow = (const f16*)(F.ws + WS_WGU0) + (size_t)n * 1024; sh = MOD + 3072; dst = SHW + n; N = 5632; }
        else if (n < 5632 + 3072) { const int j = n - 5632; wrow = (const f16*)(F.ws + WS_WQKV) + (size_t)j * 1024; sh = MOD + 3 * 6144; dst = SHW + 3 * 5632 + j; N = 3072; }
        else { const int j = n - 5632 - 3072; wrow = (const f16*)(F.ws + WS_WGU1) + (size_t)j * 1024; sh = MOD + 3 * 6144 + 3072; dst = SHW + 3 * 5632 + 3 * 3072 + j; N = 5632; }
        const f16x8 w0 = *(const f16x8*)(wrow + 16 * lane), w1 = *(const f16x8*)(wrow + 16 * lane + 8);
        float a[3];
#pragma unroll
        for (int r = 0; r < 3; ++r) { const float* sp = sh + r * 6144 + 16 * lane; float acc = 0.f;
#pragma unroll
            for (int e = 0; e < 8; ++e) acc += sp[e] * (float)w0[e] + sp[8 + e] * (float)w1[e];
            a[r] = wave_sum(acc); }
        if (lane == 0) { dst[0] = a[0]; dst[N] = a[1]; dst[2 * N] = a[2]; }
    }
}

__device__ __forceinline__ void cm_frag(f16* T, int ld, int col, int row, const f32x4 v) { u32x2 w; w.x = pkh(v[0], v[1]); w.y = pkh(v[2], v[3]); *(u32x2*)(T + (size_t)col * ld + row) = w; }
struct ResidP { const float* baseL; const float* baseC; float* dstL; float* dstC; const float* gate; f16* An; const float* gamma; const float* scale; float* ssq; };
template <bool NEXT> __device__ __forceinline__ float resid_frag(const ResidP& P, int row, int col, const f32x4 acc) {
    const bool lat = row < MLAT; const int rmod = lat ? (row >> 13) : 2;
    const size_t ro = (lat ? (size_t)row : (size_t)(row - MLAT)) * DM + col;
    const f32x4 b = *(const f32x4*)((lat ? P.baseL : P.baseC) + ro), gg = *(const f32x4*)(P.gate + rmod * 6144 + col);
    const f32x4 hn = b + gg * acc;
    *(f32x4*)((lat ? P.dstL : P.dstC) + ro) = hn;
    if (!NEXT) return 0.f;
    const f32x4 ga = *(const f32x4*)(P.gamma + col), sc = *(const f32x4*)(P.scale + rmod * 6144 + col);
    const f32x4 a = hn * ga * (sc + 1.f);
    u32x2 w; w.x = pkh(a[0], a[1]); w.y = pkh(a[2], a[3]); *(u32x2*)(P.An + (size_t)row * DM + col) = w;
    return (hn[0] * hn[0] + hn[1] * hn[1]) + (hn[2] * hn[2] + hn[3] * hn[3]);
}
template <bool NEXT> struct EpiResid {
    ResidP P;
    __device__ __forceinline__ void operator()(const f32x4 (&acc)[2][2][4][2], const pg8::Unit& u, int wr, int wc, int fr, int fq) const {
#pragma unroll
        for (int ai = 0; ai < 2; ++ai)
#pragma unroll
            for (int m = 0; m < 4; ++m) { const int row = u.pm * 256 + ai * 128 + wr * 64 + m * 16 + fr;
                float sq = 0.f;
#pragma unroll
                for (int bj = 0; bj < 2; ++bj)
#pragma unroll
                    for (int n = 0; n < 2; ++n) sq += resid_frag<NEXT>(P, row, u.pn * 256 + bj * 128 + wc * 32 + n * 16 + 4 * fq, acc[ai][bj][m][n]);
                if (NEXT) { sq += __shfl_xor(sq, 16); sq += __shfl_xor(sq, 32); if (fq == 0) atomicAdd(P.ssq + row, sq); } }
    }
};
struct EpiCM {
    f16* T; int ld;
    __device__ __forceinline__ void operator()(const f32x4 (&acc)[2][2][4][2], const pg8::Unit& u, int wr, int wc, int fr, int fq) const {
#pragma unroll
        for (int ai = 0; ai < 2; ++ai)
#pragma unroll
            for (int m = 0; m < 4; ++m) { const int row = u.pm * 256 + ai * 128 + wr * 64 + m * 16 + 4 * fq;
#pragma unroll
                for (int bj = 0; bj < 2; ++bj)
#pragma unroll
                    for (int n = 0; n < 2; ++n) cm_frag(T, ld, u.pn * 256 + bj * 128 + wc * 32 + n * 16 + fr, row, acc[ai][bj][m][n]); }
    }
};
struct GuP { f16* ACT; const float* ssq; const float* shw; };
__device__ __forceinline__ void gu_frag(const GuP& P, int row, int hcol, int gcol, const f32x4 ga, const f32x4 ua, float rstd, int rmod) {
    const f32x4 g = ga * rstd + *(const f32x4*)(P.shw + rmod * 5632 + gcol), up = ua * rstd + *(const f32x4*)(P.shw + rmod * 5632 + gcol + 128);
    float o[4];
#pragma unroll
    for (int e = 0; e < 4; ++e) o[e] = g[e] / (1.f + __expf(-g[e])) * up[e];
    u32x2 w; w.x = pkh(o[0], o[1]); w.y = pkh(o[2], o[3]); *(u32x2*)(P.ACT + (size_t)row * DFF + hcol) = w;
}
struct EpiGU {
    GuP P;
    __device__ __forceinline__ void operator()(const f32x4 (&acc)[2][2][4][2], const pg8::Unit& u, int wr, int wc, int fr, int fq) const {
#pragma unroll
        for (int ai = 0; ai < 2; ++ai)
#pragma unroll
            for (int m = 0; m < 4; ++m) { const int row = u.pm * 256 + ai * 128 + wr * 64 + m * 16 + fr;
                const int rmod = row < MLAT ? (row >> 13) : 2; const float rstd = 1.f / sqrtf(P.ssq[row] * (1.f / DM) + RMS_EPS);
#pragma unroll
                for (int n = 0; n < 2; ++n) gu_frag(P, row, u.pn * 128 + wc * 32 + n * 16 + 4 * fq, u.pn * 256 + wc * 32 + n * 16 + 4 * fq, acc[ai][0][m][n], acc[ai][1][m][n], rstd, rmod); }
    }
};
struct QkvP { f16* Q; f16* KC; float qscale; const float* ssq; const float* shw; };
__device__ __forceinline__ void qkv_frag(const QkvP& P, int row, int c, const f32x4 acc, float rstd) {
    const bool lat = row < MLAT; const int which = c >> 10, col = c & 1023, h = col >> 6, d = col & 63;
    const int b = lat ? (row >> 13) : ((row - MLAT) >> 8), t = lat ? (row & 8191) : ((row - MLAT) & 255), rmod = lat ? b : 2;
    f16* dst = lat ? P.Q + (size_t)which * (16u << 20) + (((size_t)(b * NHEAD + h) * SEQ + t) * HD + d)
                   : P.KC + (size_t)(which > 0 ? which - 1 : 0) * (512u << 10) + (((size_t)(b * NHEAD + h) * CTXL + t) * HD + d);
    const float sc = which == 0 ? P.qscale : 1.f;
    const f32x4 v = (acc * rstd + *(const f32x4*)(P.shw + rmod * 3072 + c)) * sc; u32x2 w; w.x = pkh(v[0], v[1]); w.y = pkh(v[2], v[3]); *(u32x2*)dst = w;
}
struct EpiQKV {
    QkvP P;
    __device__ __forceinline__ void operator()(const f32x4 (&acc)[2][2][4][2], const pg8::Unit& u, int wr, int wc, int fr, int fq) const {
#pragma unroll
        for (int ai = 0; ai < 2; ++ai)
#pragma unroll
            for (int m = 0; m < 4; ++m) { const int row = u.pm * 256 + ai * 128 + wr * 64 + m * 16 + fr;
                const float rstd = 1.f / sqrtf(P.ssq[row] * (1.f / DM) + RMS_EPS);
#pragma unroll
                for (int bj = 0; bj < 2; ++bj)
#pragma unroll
                    for (int n = 0; n < 2; ++n) qkv_frag(P, row, u.pn * 256 + bj * 128 + wc * 32 + n * 16 + 4 * fq, acc[ai][bj][m][n], rstd); }
    }
};

__device__ __forceinline__ unsigned ctx_slot(int r, int c) { return (unsigned)(r * 512 + (((c & 16) | ((c & 15) ^ (r & 15))) << 4)); }
template <bool SWAPT> __device__ __forceinline__ void ctx_tile_mm(LAS unsigned char* lds, const f16* a0, const f16* blo, const f16* bhi, int K, int tid, int wr, int rb0, int rb1, int fr, int fq, f32x4& c0, f32x4& c1) {
    c0 = (f32x4){0.f, 0.f, 0.f, 0.f}; c1 = c0;
    const int sr = tid >> 5, sc = tid & 31;
    u32x4 ra[4], rb[4];
    const int nch = K >> 8;
#define CTX_LD(kc) do { _Pragma("unroll") for (int i = 0; i < 4; ++i) { const int r = sr + 16 * i; ra[i] = *(const u32x4*)(a0 + (size_t)r * K + (kc) * 256 + 8 * sc); \
        rb[i] = *(const u32x4*)((r < 32 ? blo + (size_t)r * K : bhi + (size_t)(r - 32) * K) + (kc) * 256 + 8 * sc); } } while (0)
#define CTX_ST(buf) do { _Pragma("unroll") for (int i = 0; i < 4; ++i) { const int r = sr + 16 * i; *(LAS u32x4*)(lds + (buf) * 65536 + ctx_slot(r, sc)) = ra[i]; *(LAS u32x4*)(lds + (buf) * 65536 + 32768 + ctx_slot(r, sc)) = rb[i]; } } while (0)
    __syncthreads();
    CTX_LD(0); CTX_ST(0);
    __syncthreads();
    for (int kc = 0; kc < nch; ++kc) {
        const int buf = kc & 1;
        if (kc + 1 < nch) CTX_LD(kc + 1);
#pragma unroll
        for (int j = 0; j < 8; ++j) {
            const f16x8 a = *(const LAS f16x8*)(lds + buf * 65536 + ctx_slot(16 * wr + fr, 4 * j + fq));
            const f16x8 b0 = *(const LAS f16x8*)(lds + buf * 65536 + 32768 + ctx_slot(rb0 + fr, 4 * j + fq));
            const f16x8 b1 = *(const LAS f16x8*)(lds + buf * 65536 + 32768 + ctx_slot(rb1 + fr, 4 * j + fq));
            if (SWAPT) { c0 = __builtin_amdgcn_mfma_f32_16x16x32_f16(a, b0, c0, 0, 0, 0); c1 = __builtin_amdgcn_mfma_f32_16x16x32_f16(a, b1, c1, 0, 0, 0); }
            else { c0 = __builtin_amdgcn_mfma_f32_16x16x32_f16(b0, a, c0, 0, 0, 0); c1 = __builtin_amdgcn_mfma_f32_16x16x32_f16(b1, a, c1, 0, 0, 0); }
        }
        if (kc + 1 < nch) { CTX_ST(buf ^ 1); }
        __syncthreads();
    }
#undef CTX_LD
#undef CTX_ST
}
#define CTX_TILE_SETUP(NT) LOCAL_IDS(); const int fr = lane & 15, fq = lane >> 4, wr = wave >> 1, wc = wave & 1; (void)fq; \
    for (int t = F.vcu; t < 8 * (NT); t += F.G) { const int tm = t / (NT), tn = t % (NT); const int row0 = MLAT + tm * 64, row = row0 + wr * 16;
__device__ __forceinline__ void ctx_inproj(Frame& F) {
    const f16* U = (const f16*)(F.ws + WS_U); const f16* W = (const f16*)(F.ws + WS_WIN); f16* PT = (f16*)(F.ws + WS_PT);
    CTX_TILE_SETUP(32)
        const int col = tn * 64 + wc * 32; f32x4 c0, c1;
        ctx_tile_mm<true>(F.lds, U + (size_t)row0 * DM, W + (size_t)(tn * 64) * DM, W + (size_t)(tn * 64 + 32) * DM, DM, tid, wr, wc * 32, wc * 32 + 16, fr, fq, c0, c1);
        cm_frag(PT, PT_LD, col + fr, row + 4 * fq, c0); cm_frag(PT, PT_LD, col + 16 + fr, row + 4 * fq, c1);
    }
}
template <bool NEXT> __device__ __forceinline__ void ctx_resid(Frame& F, const f16* A, int K, const f16* W, const ResidP& P) {
    CTX_TILE_SETUP(16)
        const int col = tn * 64 + wc * 32; f32x4 c0, c1;
        ctx_tile_mm<false>(F.lds, A + (size_t)row0 * K, W + (size_t)(tn * 64) * K, W + (size_t)(tn * 64 + 32) * K, K, tid, wr, wc * 32, wc * 32 + 16, fr, fq, c0, c1);
        float sq = resid_frag<NEXT>(P, row + fr, col + 4 * fq, c0) + resid_frag<NEXT>(P, row + fr, col + 16 + 4 * fq, c1);
        if (NEXT) { sq += __shfl_xor(sq, 16); sq += __shfl_xor(sq, 32); if (fq == 0) atomicAdd(P.ssq + row + fr, sq); }
    }
}
__device__ __forceinline__ void ctx_gu(Frame& F, const f16* A, const f16* W, const GuP& P) {
    CTX_TILE_SETUP(88)
        const int ht = tn * 32, gt = (ht >> 7) * 256 + (ht & 127); f32x4 c0, c1;
        ctx_tile_mm<false>(F.lds, A + (size_t)row0 * DM, W + (size_t)gt * DM, W + (size_t)(gt + 128) * DM, DM, tid, wr, wc * 16, 32 + wc * 16, fr, fq, c0, c1);
        const float rstd = 1.f / sqrtf(P.ssq[row + fr] * (1.f / DM) + RMS_EPS);
        gu_frag(P, row + fr, ht + wc * 16 + 4 * fq, gt + wc * 16 + 4 * fq, c0, c1, rstd, 2);
    }
}
__device__ __forceinline__ void ctx_kv(Frame& F, const f16* A, const f16* W, const QkvP& P) {
    CTX_TILE_SETUP(32)
        const int col = 1024 + tn * 64 + wc * 32; f32x4 c0, c1;
        ctx_tile_mm<false>(F.lds, A + (size_t)row0 * DM, W + (size_t)(1024 + tn * 64) * DM, W + (size_t)(1024 + tn * 64 + 32) * DM, DM, tid, wr, wc * 32, wc * 32 + 16, fr, fq, c0, c1);
        const float rstd = 1.f / sqrtf(P.ssq[row + fr] * (1.f / DM) + RMS_EPS);
        qkv_frag(P, row + fr, col + 4 * fq, c0, rstd); qkv_frag(P, row + fr, col + 16 + 4 * fq, c1, rstd);
    }
}

__device__ constexpr float C32T[16] = {1.f, 0.98078528040323f, 0.92387953251129f, 0.83146961230255f, 0.70710678118655f, 0.55557023301960f, 0.38268343236509f, 0.19509032201613f,
                                       0.f, -0.19509032201613f, -0.38268343236509f, -0.55557023301960f, -0.70710678118655f, -0.83146961230255f, -0.92387953251129f, -0.98078528040323f};
__device__ constexpr float S32T[16] = {0.f, 0.19509032201613f, 0.38268343236509f, 0.55557023301960f, 0.70710678118655f, 0.83146961230255f, 0.92387953251129f, 0.98078528040323f,
                                       1.f, 0.98078528040323f, 0.92387953251129f, 0.83146961230255f, 0.70710678118655f, 0.55557023301960f, 0.38268343236509f, 0.19509032201613f};
__device__ constexpr int BR5[32] = {0,16,8,24,4,20,12,28,2,18,10,26,6,22,14,30,1,17,9,25,5,21,13,29,3,19,11,27,7,23,15,31};
__device__ constexpr int BR4[16] = {0,8,4,12,2,10,6,14,1,9,5,13,3,11,7,15};
__device__ constexpr int BR3[8] = {0,4,2,6,1,5,3,7};
__device__ __forceinline__ constexpr int brev(int i, int bits) { return bits == 5 ? BR5[i] : (bits == 4 ? BR4[i] : BR3[i]); }
template <int R> __device__ __forceinline__ void dif_fwd(float (&re)[R], float (&im)[R]) {
    constexpr int LG = R == 32 ? 5 : (R == 16 ? 4 : (R == 8 ? 3 : (R == 4 ? 2 : 1)));
#pragma unroll
    for (int st = 0; st < LG; ++st) {
        const int m = R >> st, hm = m >> 1, ts = 32 / m;
#pragma unroll
        for (int b = 0; b < R; b += m)
#pragma unroll
            for (int j = 0; j < hm; ++j) {
                const int i0 = b + j, i1 = b + j + hm, tw = j * ts;
                const float ar = re[i0], ai = im[i0], cr = re[i1], ci = im[i1];
                re[i0] = ar + cr; im[i0] = ai + ci;
                const float dr = ar - cr, di = ai - ci;
                if (tw == 0) { re[i1] = dr; im[i1] = di; }
                else if (tw == 8) { re[i1] = di; im[i1] = -dr; }
                else { const float c = C32T[tw], s = S32T[tw]; re[i1] = dr * c + di * s; im[i1] = di * c - dr * s; }
            }
    }
}
template <int R> __device__ __forceinline__ void dit_inv(float (&re)[R], float (&im)[R]) {
    constexpr int LG = R == 32 ? 5 : (R == 16 ? 4 : (R == 8 ? 3 : (R == 4 ? 2 : 1)));
#pragma unroll
    for (int st = LG - 1; st >= 0; --st) {
        const int m = R >> st, hm = m >> 1, ts = 32 / m;
#pragma unroll
        for (int b = 0; b < R; b += m)
#pragma unroll
            for (int j = 0; j < hm; ++j) {
                const int i0 = b + j, i1 = b + j + hm, tw = j * ts;
                const float ar = re[i0], ai = im[i0], cr = re[i1], ci = im[i1];
                float tr, ti;
                if (tw == 0) { tr = cr; ti = ci; }
                else if (tw == 8) { tr = -ci; ti = cr; }
                else { const float c = C32T[tw], s = S32T[tw]; tr = cr * c - ci * s; ti = ci * c + cr * s; }
                re[i0] = ar + tr; im[i0] = ai + ti; re[i1] = ar - tr; im[i1] = ai - ti;
            }
    }
}
__device__ __forceinline__ int fpad(int i) { return i + (i >> 5); }
__device__ __forceinline__ void tw_fwd(float& x, float& y, float rev) { const float c = __builtin_amdgcn_cosf(rev), s = __builtin_amdgcn_sinf(rev); const float a = x * c + y * s, b = y * c - x * s; x = a; y = b; }
__device__ __forceinline__ void tw_inv(float& x, float& y, float rev) { const float c = __builtin_amdgcn_cosf(rev), s = __builtin_amdgcn_sinf(rev); const float a = x * c - y * s, b = y * c + x * s; x = a; y = b; }

template <int NB, bool REVP, bool FWD> __device__ __forceinline__ void tw_tree(float (&re)[1 << NB], float (&im)[1 << NB], float rev1, float rev0 = 0.f, bool has0 = false) {
    float wc[NB], ws[NB];
#pragma unroll
    for (int i = 0; i < NB; ++i) { const float r = __builtin_amdgcn_fractf(rev1 * (float)(1 << i)); wc[i] = __builtin_amdgcn_cosf(r); ws[i] = FWD ? -__builtin_amdgcn_sinf(r) : __builtin_amdgcn_sinf(r); }
    float c0 = 1.f, s0 = 0.f;
    if (has0) { const float r = __builtin_amdgcn_fractf(rev0); c0 = __builtin_amdgcn_cosf(r); s0 = FWD ? -__builtin_amdgcn_sinf(r) : __builtin_amdgcn_sinf(r); }
    float pc[NB + 1], ps[NB + 1];
    pc[0] = c0; ps[0] = s0;
#pragma unroll
    for (int p = 0; p < (1 << NB); ++p) {
#pragma unroll
        for (int lvl = 0; lvl < NB; ++lvl) {
            const int b = NB - 1 - lvl;
            if ((p & ((1 << b) - 1)) == 0) {
                const int kb = REVP ? (NB - 1 - b) : b;
                if ((p >> b) & 1) { pc[lvl + 1] = pc[lvl] * wc[kb] - ps[lvl] * ws[kb]; ps[lvl + 1] = pc[lvl] * ws[kb] + ps[lvl] * wc[kb]; }
                else { pc[lvl + 1] = pc[lvl]; ps[lvl + 1] = ps[lvl]; }
            }
        }
        if (p != 0 || has0) { const float x = re[p], y = im[p]; re[p] = x * pc[NB] - y * ps[NB]; im[p] = x * ps[NB] + y * pc[NB]; }
    }
}

__device__ __forceinline__ void fft_s2_fwd(LAS f32x2* buf, int tid) {
    asm volatile("" : "+v"(tid));
    const int kk = tid >> 5, n3 = tid & 31;
    LAS f32x2* pb = buf + fpad(kk * 1024 + n3);
    float re[32], im[32];
#pragma unroll
    for (int n2 = 0; n2 < 32; ++n2) { const f32x2 v = pb[33 * n2]; re[n2] = v.x; im[n2] = v.y; }
    dif_fwd<32>(re, im);
    tw_tree<5, true, true>(re, im, (float)n3 * (1.f / 1024.f));
#pragma unroll
    for (int p = 0; p < 32; ++p) pb[33 * brev(p, 5)] = (f32x2){re[p], im[p]};
}
__device__ __forceinline__ void fft_s2_inv(LAS f32x2* buf, int tid) {
    asm volatile("" : "+v"(tid));
    const int k1 = tid >> 5, n3 = tid & 31;
    LAS f32x2* pb = buf + fpad(k1 * 1024 + n3);
    float re[32], im[32];
#pragma unroll
    for (int p = 0; p < 32; ++p) { const f32x2 v = pb[33 * brev(p, 5)]; re[p] = v.x; im[p] = v.y; }
    dit_inv<32>(re, im);
    tw_tree<5, false, false>(re, im, (float)k1 * (1.f / 512.f), (float)(n3 * k1) * (1.f / 16384.f), true);
#pragma unroll
    for (int n2 = 0; n2 < 32; ++n2) pb[33 * n2] = (f32x2){re[n2], im[n2]};
}
__device__ __forceinline__ void fft_s3_conv(LAS f32x2* buf, int tid, const unsigned* H) {
    asm volatile("" : "+v"(tid));
    const int k2 = tid & 31;
    LAS f32x2* pb = buf + fpad((tid >> 5) * 1024 + k2 * 32);
    const unsigned* hp = H + tid;
    float re[32], im[32];
#pragma unroll
    for (int n3 = 0; n3 < 32; ++n3) { const f32x2 v = pb[n3]; re[n3] = v.x; im[n3] = v.y; }
    dif_fwd<32>(re, im);
#pragma unroll
    for (int p = 0; p < 32; ++p) { const f16x2 hh = __builtin_bit_cast(f16x2, hp[p * 512]); const float hx = (float)hh[0] * (1.f / 16384.f), hy = (float)hh[1] * (1.f / 16384.f);
        const float a = re[p] * hx - im[p] * hy, b = re[p] * hy + im[p] * hx; re[p] = a; im[p] = b; }
    dit_inv<32>(re, im);
    tw_tree<5, false, false>(re, im, (float)k2 * (1.f / 1024.f));
#pragma unroll
    for (int n3 = 0; n3 < 32; ++n3) pb[n3] = (f32x2){re[n3], im[n3]};
}

__device__ __forceinline__ void hyena_task(Frame& F, int c) {
    LAS f32x2* buf = (LAS f32x2*)F.lds;
    LAS float* scr = (LAS float*)(F.lds + SCR_OFF);
    int tid = threadIdx.x; asm volatile("" : "+v"(tid));
    const int lane = tid & 63, wave = __builtin_amdgcn_readfirstlane(tid >> 6);
    u16* PT = (u16*)(F.ws + WS_PT);
    const u16* FILT = (const u16*)(F.ws + WS_FILT);
    unsigned* HS = (unsigned*)(F.ws + WS_HS) + (size_t)blockIdx.x * 32768;
    unsigned* XS = (unsigned*)(F.ws + WS_XS) + (size_t)blockIdx.x * (32 * 512);
    const float* cw = F.in[13]; const float* cb = F.in[14]; const float* skip = F.in[21];
    {
        const u16* f1 = FILT + (size_t)(c) * FILT_T; const u16* f2 = FILT + (size_t)(512 + c) * FILT_T;
        const u16* b1 = FILT + (size_t)(1024 + c) * FILT_T; const u16* b2 = FILT + (size_t)(1536 + c) * FILT_T;
        float a1 = 0.f, a2 = 0.f;
        if (tid == 0) { a1 = fabsf(h2f(b1[0])); a2 = fabsf(h2f(b2[0])); }
#pragma unroll
        for (int jj = 0; jj < 2; ++jj) {
            __builtin_amdgcn_sched_barrier(0); int j = tid + 512 * jj; asm volatile("" : "+v"(j));
            float re[16], im[16];
#pragma unroll
            for (int n1 = 0; n1 < 16; ++n1) { const int n = n1 * 1024 + j;
                if (n1 < 8) { re[n1] = h2f(f1[n]); im[n1] = h2f(f2[n]); }
                else if (n == 8192) { re[n1] = 0.f; im[n1] = 0.f; }
                else { re[n1] = h2f(b1[16384 - n]); im[n1] = h2f(b2[16384 - n]); }
                a1 += fabsf(re[n1]); a2 += fabsf(im[n1]); }
            dif_fwd<16>(re, im);
#pragma unroll
            for (int p = 0; p < 1; ++p) tw_tree<4, true, true>(re, im, (float)j * (1.f / 16384.f));
#pragma unroll
        for (int p = 0; p < 16; ++p) (buf + fpad(j))[1056 * brev(p, 4)] = (f32x2){re[p], im[p]};
        }
        a1 = wave_sum(a1); a2 = wave_sum(a2);
        if (lane == 0) { scr[wave * 2] = a1; scr[wave * 2 + 1] = a2; }
        __syncthreads();
        float n1s = 0.f, n2s = 0.f;
#pragma unroll
        for (int w = 0; w < 8; ++w) { n1s += scr[2 * w]; n2s += scr[2 * w + 1]; }
        const float inv1 = 0.5f / n1s, inv2 = 0.5f / n2s;
        const float ska = skip[c], skb = skip[512 + c];
        fft_s2_fwd(buf, tid);
        __syncthreads();
        {
            const int k1 = tid >> 5, k2 = tid & 31;
            LAS f32x2* pb = buf + fpad(k1 * 1024 + k2 * 32);
            float re[32], im[32];
#pragma unroll
            for (int n3 = 0; n3 < 32; ++n3) { const f32x2 v = pb[n3]; re[n3] = v.x; im[n3] = v.y; }
            dif_fwd<32>(re, im);
#pragma unroll
            for (int p = 0; p < 32; ++p) pb[brev(p, 5)] = (f32x2){re[p], im[p]};
            __syncthreads();
            unsigned* hp = HS + tid;
#pragma unroll
            for (int p = 0; p < 32; ++p) {
                const int k = k1 + 16 * k2 + 512 * brev(p, 5), km = (16384 - k) & 16383;
                const f32x2 zm = buf[fpad((km & 15) * 1024 + ((km >> 4) & 31) * 32 + (km >> 9))];
                const float sr = re[p] + zm.x, si = im[p] - zm.y;
                const float dr = re[p] - zm.x, di = im[p] + zm.y;
                hp[p * 512] = pkh(sr * inv1 + ska, si * inv1);
                hp[16384 + p * 512] = pkh(di * inv2 + skb, -dr * inv2);
                if ((p & 3) == 3) __builtin_amdgcn_sched_barrier(0);
            }
        }
        __syncthreads();
    }
    unsigned vpk[16];
    {
        LAS u16* raw = (LAS u16*)F.lds;
#pragma unroll
        for (int w = 0; w < 3; ++w) {
            const u16* row = PT + (size_t)(512 + 512 * w + c) * PT_LD;
#pragma unroll
            for (int i = 0; i < 4; ++i) { const int e = (i * 512 + tid) * 8;
                *(LAS u32x4*)(raw + w * 16384 + e) = *(const u32x4*)(row + e); }
        }
        __syncthreads();
#pragma unroll
        for (int w = 0; w < 3; ++w) {
            const int ch = 512 * w + c;
            const float w0 = cw[ch], w1 = cw[1536 + ch], w2 = cw[3072 + ch], bias = cb[ch];
#pragma unroll
            for (int idx = 0; idx < 16; ++idx) { const int n = (idx & 7) * 1024 + tid + 512 * (idx >> 3);
                const LAS u16* p0 = raw + w * 16384 + n; const LAS u16* p1 = p0 + SEQ;
                const float a0 = n > 0 ? h2f(p0[-1]) : 0.f, a1 = h2f(p0[0]), a2 = n < SEQ - 1 ? h2f(p0[1]) : 0.f;
                const float c0 = n > 0 ? h2f(p1[-1]) : 0.f, c1 = h2f(p1[0]), c2 = n < SEQ - 1 ? h2f(p1[1]) : 0.f;
                const unsigned pk = pkh(w0 * a0 + w1 * a1 + w2 * a2 + bias, w0 * c0 + w1 * c1 + w2 * c2 + bias);
                if (w < 2) XS[(w * 16 + idx) * 512 + tid] = pk; else vpk[idx] = pk;
                if ((idx & 3) == 3) __builtin_amdgcn_sched_barrier(0); }
        }
        __syncthreads();
    }
#define XS_LD(w, idx, lo, hi) do { const f16x2 _v = __builtin_bit_cast(f16x2, XS[((w) * 16 + (idx)) * 512 + tid]); lo = (float)_v[0]; hi = (float)_v[1]; } while (0)
#pragma unroll
    for (int jj = 0; jj < 2; ++jj) {
        __builtin_amdgcn_sched_barrier(0); int j = tid + 512 * jj; asm volatile("" : "+v"(j));
        float re[16], im[16];
#pragma unroll
        for (int n1 = 0; n1 < 8; ++n1) { const f16x2 v = __builtin_bit_cast(f16x2, vpk[jj * 8 + n1]); re[n1] = (float)v[0]; im[n1] = (float)v[1]; }
#pragma unroll
        for (int n1 = 8; n1 < 16; ++n1) { re[n1] = 0.f; im[n1] = 0.f; }
        dif_fwd<16>(re, im);
#pragma unroll
        for (int p = 0; p < 1; ++p) tw_tree<4, true, true>(re, im, (float)j * (1.f / 16384.f));
#pragma unroll
        for (int p = 0; p < 16; ++p) (buf + fpad(j))[1056 * brev(p, 4)] = (f32x2){re[p], im[p]};
    }
    __syncthreads();
    fft_s2_fwd(buf, tid); __syncthreads();
    fft_s3_conv(buf, tid, HS); __syncthreads();
    fft_s2_inv(buf, tid); __syncthreads();
#pragma unroll
    for (int jj = 0; jj < 2; ++jj) {
        __builtin_amdgcn_sched_barrier(0); int j = tid + 512 * jj; asm volatile("" : "+v"(j));
        float re[16], im[16];
#pragma unroll
        for (int p = 0; p < 16; ++p) { const f32x2 v = (buf + fpad(j))[1056 * brev(p, 4)]; re[p] = v.x; im[p] = v.y; }
        dit_inv<16>(re, im);
#pragma unroll
        for (int n1 = 0; n1 < 8; ++n1) { float x0, x1; XS_LD(0, jj * 8 + n1, x0, x1); re[n1] *= x0; im[n1] *= x1; }
#pragma unroll
        for (int n1 = 8; n1 < 16; ++n1) { re[n1] = 0.f; im[n1] = 0.f; }
        dif_fwd<16>(re, im);
#pragma unroll
        for (int p = 0; p < 1; ++p) tw_tree<4, true, true>(re, im, (float)j * (1.f / 16384.f));
#pragma unroll
        for (int p = 0; p < 16; ++p) (buf + fpad(j))[1056 * brev(p, 4)] = (f32x2){re[p], im[p]};
    }
    __syncthreads();
    fft_s2_fwd(buf, tid); __syncthreads();
    fft_s3_conv(buf, tid, HS + 16384); __syncthreads();
    fft_s2_inv(buf, tid); __syncthreads();
    u16* yrow = PT + (size_t)(512 + c) * PT_LD;
#pragma unroll
    for (int jj = 0; jj < 2; ++jj) {
        __builtin_amdgcn_sched_barrier(0); int j = tid + 512 * jj; asm volatile("" : "+v"(j));
        float re[16], im[16];
#pragma unroll
        for (int p = 0; p < 16; ++p) { const f32x2 v = (buf + fpad(j))[1056 * brev(p, 4)]; re[p] = v.x; im[p] = v.y; }
        dit_inv<16>(re, im);
#pragma unroll
        for (int n1 = 0; n1 < 8; ++n1) { float x0, x1; XS_LD(1, jj * 8 + n1, x0, x1);
            yrow[n1 * 1024 + j] = __builtin_bit_cast(u16, (f16)(x0 * re[n1])); yrow[SEQ + n1 * 1024 + j] = __builtin_bit_cast(u16, (f16)(x1 * im[n1])); }
    }
#undef XS_LD
    __syncthreads();
}

__device__ __forceinline__ void fourier_task(Frame& F, int task) {
    LAS f32x2* buf = (LAS f32x2*)F.lds;
    int tid = threadIdx.x; asm volatile("" : "+v"(tid));
    const int b = task >> 7, g = (task >> 5) & 3, q = task & 31;
    u16* PT = (u16*)(F.ws + WS_PT);
    const int mA[2] = {q, q == 0 ? 32 : 64 - q};
    const size_t tok0 = (size_t)b * SEQ;
#pragma unroll
    for (int f = 0; f < 2; ++f) {
        const u16* rA = PT + (size_t)(128 * g + mA[f]) * PT_LD + tok0; const u16* rB = PT + (size_t)(128 * g + 64 + mA[f]) * PT_LD + tok0;
        const float sg = (f == 0 && q == 0) ? 1.f : -1.f;
#pragma unroll
        for (int jj = 0; jj < 2; ++jj) {
            __builtin_amdgcn_sched_barrier(0); int j = tid + 512 * jj; asm volatile("" : "+v"(j));
            float re[8], im[8];
#pragma unroll
            for (int n1 = 0; n1 < 8; ++n1) { re[n1] = h2f(rA[n1 * 1024 + j]); im[n1] = sg * h2f(rB[n1 * 1024 + j]); }
            dif_fwd<8>(re, im);
#pragma unroll
            for (int p = 0; p < 1; ++p) tw_tree<3, true, true>(re, im, (float)j * (1.f / 8192.f));
#pragma unroll
            for (int p = 0; p < 8; ++p) (buf + fpad(j))[1056 * (f * 8 + brev(p, 3))] = (f32x2){re[p], im[p]};
        }
    }
    __syncthreads();
    fft_s2_fwd(buf, tid);
    __syncthreads();
    {
        const int kk = tid >> 5, k2 = tid & 31, f = kk >> 3, k1 = kk & 7;
        LAS f32x2* pb = buf + fpad(kk * 1024 + k2 * 32);
        float re[32], im[32];
#pragma unroll
        for (int n3 = 0; n3 < 32; ++n3) { const f32x2 v = pb[n3]; re[n3] = v.x; im[n3] = v.y; }
        dif_fwd<32>(re, im);
        __syncthreads();
        { LAS f32x2* pn = buf + fpad(f * 8192 + k1 + 8 * k2);
#pragma unroll
        for (int p = 0; p < 32; ++p) pn[264 * brev(p, 5)] = (f32x2){re[p], im[p]}; }
    }
    __syncthreads();
#pragma unroll
    for (int f = 0; f < 2; ++f) {
        const bool packed = (f == 0 && q == 0);
        const int m = mA[f];
        u16* o1 = PT + (size_t)(128 * g + (packed ? 0 : m)) * PT_LD + tok0;
        u16* o2 = PT + (size_t)(128 * g + (packed ? 64 : 128 - m)) * PT_LD + tok0;
        for (int l = tid; l < SEQ; l += 512) {
            const f32x2 a = buf[fpad(f * 8192 + l)], c = buf[fpad(f * 8192 + ((SEQ - l) & (SEQ - 1)))];
            const float y1 = packed ? 0.5f * (a.x + c.x) : a.x, y2 = packed ? 0.5f * (a.y + c.y) : c.x;
            o1[l] = __builtin_bit_cast(u16, (f16)y1); o2[l] = __builtin_bit_cast(u16, (f16)y2);
        }
    }
    __syncthreads();
}

__device__ __forceinline__ void fourier_ctx_task(Frame& F, int task) {
    LAS float* zr = (LAS float*)F.lds;
    LAS float* zi = zr + 512;
    LAS float* tc = zr + 1024;
    LAS float* ts = zr + 1280;
    LAS float* fr = zr + 1536;
    LAS float* fi = zr + 2048;
    int tid = threadIdx.x; asm volatile("" : "+v"(tid));
    const int f = tid >> 8, k = tid & 255;
    const int b = task >> 7, g = (task >> 5) & 3, q = task & 31;
    u16* PT = (u16*)(F.ws + WS_PT);
    const int m = f == 0 ? q : (q == 0 ? 32 : 64 - q);
    const bool packed = (f == 0 && q == 0);
    const size_t tok0 = (size_t)MLAT + (size_t)b * CTXL;
    const u16* rA = PT + (size_t)(128 * g + m) * PT_LD + tok0; const u16* rB = PT + (size_t)(128 * g + 64 + m) * PT_LD + tok0;
    zr[tid] = h2f(rA[k]); zi[tid] = (packed ? 1.f : -1.f) * h2f(rB[k]);
    if (tid < 256) { tc[tid] = cos_rev((float)tid * (1.f / 256.f)); ts[tid] = sin_rev((float)tid * (1.f / 256.f)); }
    __syncthreads();
    float ar = 0.f, ai = 0.f;
    for (int l = 0; l < 256; ++l) { const float x = zr[f * 256 + l], y = zi[f * 256 + l]; const int e = (k * l) & 255; const float c = tc[e], s = ts[e];
        ar += x * c + y * s; ai += y * c - x * s; }
    fr[tid] = ar; fi[tid] = ai;
    __syncthreads();
    const int km = f * 256 + ((256 - k) & 255);
    const float sc = 5.656854249492381f;
    const float y1 = packed ? 0.5f * (ar + fr[km]) : ar, y2 = packed ? 0.5f * (ai + fi[km]) : fr[km];
    u16* o1 = PT + (size_t)(128 * g + (packed ? 0 : m)) * PT_LD + tok0; u16* o2 = PT + (size_t)(128 * g + (packed ? 64 : 128 - m)) * PT_LD + tok0;
    o1[k] = __builtin_bit_cast(u16, (f16)(y1 * sc)); o2[k] = __builtin_bit_cast(u16, (f16)(y2 * sc));
    __syncthreads();
}
__device__ __forceinline__ void hyena_ctx_wave(Frame& F, int c, int b, int lane, LAS float* wl) {
    LAS float* hh = wl;
    LAS float* vv = wl + 1024;
    u16* PT = (u16*)(F.ws + WS_PT);
    const u16* FILT = (const u16*)(F.ws + WS_FILT);
    const float* cw = F.in[13]; const float* cb = F.in[14]; const float* skip = F.in[21];
    float n0 = 0.f, n1 = 0.f;
#pragma unroll
    for (int j = 0; j < 4; ++j) { const int t = lane + 64 * j;
        const float f0 = h2f(FILT[(size_t)(c) * FILT_T + SEQ + t]), f1 = h2f(FILT[(size_t)(512 + c) * FILT_T + SEQ + t]);
        const float g0 = h2f(FILT[(size_t)(1024 + c) * FILT_T + SEQ + t]), g1 = h2f(FILT[(size_t)(1536 + c) * FILT_T + SEQ + t]);
        hh[255 + t] = f0; hh[512 + 255 + t] = f1; if (t > 0) { hh[255 - t] = g0; hh[512 + 255 - t] = g1; }
        n0 += fabsf(f0) + fabsf(g0); n1 += fabsf(f1) + fabsf(g1); }
    if (lane == 0) { hh[511] = 0.f; hh[1023] = 0.f; }
    n0 = wave_sum(n0); n1 = wave_sum(n1);
    const float i0 = 1.f / n0, i1 = 1.f / n1;
    const size_t tokb = (size_t)MLAT + (size_t)b * CTXL;
    float x1[4], x2[4], v[4];
#pragma unroll
    for (int w = 0; w < 3; ++w) { const int ch = 512 * w + c; const u16* p = PT + (size_t)(512 + ch) * PT_LD + tokb + 4 * lane;
        const float w0 = cw[ch], w1 = cw[1536 + ch], w2 = cw[3072 + ch], bias = cb[ch];
        float a[6];
        a[0] = lane > 0 ? h2f(p[-1]) : 0.f; a[5] = lane < 63 ? h2f(p[4]) : 0.f;
#pragma unroll
        for (int j = 0; j < 4; ++j) a[1 + j] = h2f(p[j]);
#pragma unroll
        for (int j = 0; j < 4; ++j) { const float r = w0 * a[j] + w1 * a[j + 1] + w2 * a[j + 2] + bias; if (w == 0) x1[j] = r; else if (w == 1) x2[j] = r; else v[j] = r; } }
#pragma unroll
    for (int o = 0; o < 2; ++o) {
        *(LAS f32x4*)(vv + 4 * lane) = (f32x4){v[0], v[1], v[2], v[3]};
        LDS_WAIT(); asm volatile("" ::: "memory");
        float y0 = 0.f, y1 = 0.f, y2 = 0.f, y3 = 0.f;
        const LAS float* ho = hh + 512 * o + 255 + 4 * lane;
        float w0 = ho[0], w1 = ho[1], w2 = ho[2], w3 = ho[3];
#pragma unroll 8
        for (int s = 0; s < 256; ++s) { const float u = vv[s];
            y0 += u * w0; y1 += u * w1; y2 += u * w2; y3 += u * w3;
            w3 = w2; w2 = w1; w1 = w0; const int idx = 255 + 4 * lane - s - 1; w0 = idx >= 0 ? ho[-s - 1] : 0.f; }
        const float inv = o == 0 ? i0 : i1, sk = skip[o * 512 + c];
        v[0] = (o == 0 ? x1[0] : x2[0]) * (y0 * inv + sk * v[0]); v[1] = (o == 0 ? x1[1] : x2[1]) * (y1 * inv + sk * v[1]);
        v[2] = (o == 0 ? x1[2] : x2[2]) * (y2 * inv + sk * v[2]); v[3] = (o == 0 ? x1[3] : x2[3]) * (y3 * inv + sk * v[3]);
        LDS_WAIT(); asm volatile("" ::: "memory");
    }
    u32x2 w; w.x = pkh(v[0], v[1]); w.y = pkh(v[2], v[3]);
    *(u32x2*)(PT + (size_t)(512 + c) * PT_LD + tokb + 4 * lane) = w;
}
__device__ __forceinline__ void hyena_ctx_all(Frame& F) {
    LOCAL_IDS();
    if ((wave & 1) == 0) { LAS float* wl = (LAS float*)(F.lds + wave * 8192);
        for (int task = F.vcu + 256 * (wave >> 1); task < 1024; task += 4 * F.G) hyena_ctx_wave(F, task >> 1, task & 1, lane, wl); }
    __syncthreads();
}
#ifdef PROBE_P3
#define P3T(k, stmt) do { const unsigned long long t0_ = __builtin_amdgcn_s_memrealtime(); stmt; if (PROBE_P3 == (k)) F.pacc += __builtin_amdgcn_s_memrealtime() - t0_; } while (0)
#else
#define P3T(k, stmt) do { stmt; } while (0)
#endif
__device__ __forceinline__ void p3_fft(Frame& F) {
    P3T(1, for (int c = F.vcu; c < 512; c += F.G) hyena_task(F, c));
    P3T(2, for (int t = F.vcu; t < 256; t += F.G) fourier_task(F, t));
    P3T(3, for (int t = F.vcu; t < 256; t += F.G) fourier_ctx_task(F, t));
    P3T(4, hyena_ctx_all(F));
}

__device__ __forceinline__ void p4_transpose(Frame& F) {
    LOCAL_IDS();
    const int gw = F.vcu * NWAVES + wave, NGW = F.G * NWAVES;
    const u16* YT = (const u16*)(F.ws + WS_PT); u16* Y = (u16*)(F.ws + WS_Y);
    LAS u16* scr = (LAS u16*)(F.lds + wave * 16384);
    constexpr int NRB = MALL / 64;
    for (int it = gw; it < 16 * NRB; it += NGW) {
        const int cb = it / NRB, rb = it % NRB;
#pragma unroll
        for (int i = 0; i < 8; ++i) { const int ch = (lane >> 3) + 8 * i, seg = lane & 7;
            const u32x4 v = *(const u32x4*)(YT + (size_t)(cb * 64 + ch) * PT_LD + rb * 64 + 8 * seg);
            *(LAS u32x4*)(scr + ch * 72 + 8 * seg) = v; }
        LDS_WAIT(); asm volatile("" ::: "memory");
#pragma unroll
        for (int i = 0; i < 8; ++i) { const int tk = (lane >> 3) + 8 * i, seg = lane & 7;
            unsigned w[4];
#pragma unroll
            for (int e = 0; e < 4; ++e) { const unsigned lo = scr[(8 * seg + 2 * e) * 72 + tk], hi = scr[(8 * seg + 2 * e + 1) * 72 + tk]; w[e] = lo | (hi << 16); }
            *(u32x4*)(Y + (size_t)(rb * 64 + tk) * DM + cb * 64 + 8 * seg) = (u32x4){w[0], w[1], w[2], w[3]}; }
        LDS_WAIT(); asm volatile("" ::: "memory");
    }
}

constexpr int NA_KOFF = 0, NA_VOFF = 73728, NA_BIAS = 147456;
typedef short v4i16_t __attribute__((ext_vector_type(4)));
__device__ __forceinline__ f16x4 lds_tr(unsigned addr) { return __builtin_bit_cast(f16x4, __builtin_amdgcn_ds_read_tr16_b64_v4i16((LAS v4i16_t*)addr)); }
template <bool VSWZ> __device__ __forceinline__ void na_stage(const f16* src, unsigned ldsbase, int nchunk, int tid) {
    for (int cidx = tid; cidx < nchunk; cidx += 512) {
        const int key = cidx >> 3, ch = cidx & 7;
        const u32x4 v = *(const u32x4*)(src + (size_t)cidx * 8);
        const int slot = VSWZ ? ((((ch >> 1) ^ ((key >> 1) & 3)) << 1) | (ch & 1)) : (ch ^ (key & 7));
        *(LAS u32x4*)(ldsbase + key * 128 + slot * 16) = v;
    }
}
__device__ __forceinline__ void p11_na(Frame& F) {
    LOCAL_IDS();
    const f16* Q = (const f16*)(F.ws + WS_Q); const f16* K = (const f16*)(F.ws + WS_K); const f16* V = (const f16*)(F.ws + WS_V);
    const f16* KC = (const f16*)(F.ws + WS_KC); const f16* VC = (const f16*)(F.ws + WS_VC); f16* O = (f16*)(F.ws + WS_O);
    const unsigned lds0 = (unsigned)(uintptr_t)F.lds;
    for (int it = F.vcu * 8; it < 2048; it += F.G * 8) {
        { const int h = (it >> 6) & 15; const float* src = F.in[24] + (size_t)h * 465; LAS float* tb = (LAS float*)(F.lds + NA_BIAS);
          __syncthreads();
          if (tid < 465) tb[tid] = src[tid] * LOG2E;
        }
#pragma unroll 1
        for (int ii = 0; ii < 8; ++ii) {
            const int item = it + ii; if (item >= 2048) break;
            int tid = threadIdx.x; asm volatile("" : "+v"(tid));
            const int lane = tid & 63, wave = __builtin_amdgcn_readfirstlane(tid >> 6);
            const int bh = item >> 6, rp = item & 63, b = bh >> 4, h = bh & 15;
            const int r0 = 2 * rp, r = r0 + (wave >> 2), chunk = wave & 3;
            const int rsA = r0 - 4 < 0 ? 0 : (r0 - 4 > 120 ? 120 : r0 - 4);
            const int rs = r - 4 < 0 ? 0 : (r - 4 > 120 ? 120 : r - 4);
            const int rsB = r0 + 1 - 4 < 0 ? 0 : (r0 + 1 - 4 > 120 ? 120 : r0 + 1 - 4);
            const int nrows = 8 + (rsB - rsA);
            __syncthreads();
            na_stage<false>(K + ((size_t)bh * SEQ + rsA * 64) * HD, lds0 + NA_KOFF, nrows * 512, tid);
            na_stage<true>(V + ((size_t)bh * SEQ + rsA * 64) * HD, lds0 + NA_VOFF, nrows * 512, tid);
            const int q = lane & 15, g = lane >> 4;
            const int kstart = chunk == 0 ? 0 : (chunk == 1 ? 8 : (chunk == 2 ? 24 : 32));
            const int off = chunk == 0 ? 15 : (chunk == 3 ? -1 : 7);
            const int ws = chunk == 0 ? (q > 8 ? q - 8 : 0) : (chunk == 3 ? (q + 8 < 16 ? q + 8 : 16) : q);
            const f16* Qp = Q + ((size_t)bh * SEQ + r * 64 + 16 * chunk + q) * HD + 8 * g;
            const f16x8 q0 = *(const f16x8*)Qp, q1 = *(const f16x8*)(Qp + 32);
            const int lr = rs - rsA;
            unsigned ka[2][2];
#pragma unroll
            for (int kb = 0; kb < 2; ++kb)
#pragma unroll
                for (int ks = 0; ks < 2; ++ks) { const int key = 64 * lr + kstart + 16 * kb + q; ka[kb][ks] = lds0 + NA_KOFF + key * 128 + (((4 * ks + g) ^ (key & 7)) << 4); }
            unsigned va[4];
            { const int qq = (lane & 15) >> 2, p = lane & 3; const int key = 64 * lr + kstart + 4 * g + qq;
#pragma unroll
              for (int db = 0; db < 4; ++db) va[db] = lds0 + NA_VOFF + key * 128 + ((db ^ ((key >> 1) & 3)) << 5) + 8 * p; }
            int bidx[2][4];
#pragma unroll
            for (int kb = 0; kb < 2; ++kb)
#pragma unroll
                for (int e = 0; e < 4; ++e) { const int kc = 16 * kb + 4 * g + e; const bool ok = kc >= ws && kc < ws + 16; const int dc = kc - q + off; bidx[kb][e] = ok ? ((rs - r + 7) * 31 + dc) : -1; }
            f32x4 o[4];
#pragma unroll
            for (int db = 0; db < 4; ++db) o[db] = (f32x4){0.f, 0.f, 0.f, 0.f};
            float m = -INFINITY, l = 0.f;
            const LAS float* rpb = (const LAS float*)(F.lds + NA_BIAS);
            __syncthreads();
#define NA_STEP(S0, S1, KA00, KA01, KA10, KA11, VOFF) do { \
                S0 = __builtin_amdgcn_mfma_f32_16x16x32_f16(*(const LAS f16x8*)(KA00), q0, S0, 0, 0, 0); \
                S0 = __builtin_amdgcn_mfma_f32_16x16x32_f16(*(const LAS f16x8*)(KA01), q1, S0, 0, 0, 0); \
                S1 = __builtin_amdgcn_mfma_f32_16x16x32_f16(*(const LAS f16x8*)(KA10), q0, S1, 0, 0, 0); \
                S1 = __builtin_amdgcn_mfma_f32_16x16x32_f16(*(const LAS f16x8*)(KA11), q1, S1, 0, 0, 0); \
                float mx_ = fmaxf(fmaxf(fmaxf(S0[0], S0[1]), fmaxf(S0[2], S0[3])), fmaxf(fmaxf(S1[0], S1[1]), fmaxf(S1[2], S1[3]))); \
                mx_ = fmaxf(mx_, __shfl_xor(mx_, 16)); mx_ = fmaxf(mx_, __shfl_xor(mx_, 32)); \
                const float mn_ = fmaxf(m, mx_); const float alpha_ = __builtin_amdgcn_exp2f(m - mn_); m = mn_; \
                f16x8 pf_; float ps_ = 0.f; \
                _Pragma("unroll") for (int e = 0; e < 4; ++e) { const float p0_ = __builtin_amdgcn_exp2f(S0[e] - mn_), p1_ = __builtin_amdgcn_exp2f(S1[e] - mn_); ps_ += p0_ + p1_; pf_[e] = (f16)p0_; pf_[4 + e] = (f16)p1_; } \
                l = l * alpha_ + ps_; \
                _Pragma("unroll") for (int db = 0; db < 4; ++db) { const f16x4 v0_ = lds_tr(va[db] + (VOFF)), v1_ = lds_tr(va[db] + (VOFF) + 2048); \
                    const f16x8 vv_ = {v0_[0], v0_[1], v0_[2], v0_[3], v1_[0], v1_[1], v1_[2], v1_[3]}; \
                    o[db] = __builtin_amdgcn_mfma_f32_16x16x32_f16(vv_, pf_, o[db] * alpha_, 0, 0, 0); } } while (0)
#pragma unroll
            for (int i = 0; i < 8; ++i) {
                f32x4 s0, s1;
#pragma unroll
                for (int e = 0; e < 4; ++e) { s0[e] = bidx[0][e] >= 0 ? rpb[bidx[0][e] + 31 * i] : -INFINITY; s1[e] = bidx[1][e] >= 0 ? rpb[bidx[1][e] + 31 * i] : -INFINITY; }
                NA_STEP(s0, s1, ka[0][0] + 8192 * i, ka[0][1] + 8192 * i, ka[1][0] + 8192 * i, ka[1][1] + 8192 * i, 8192 * i);
            }
            __syncthreads();
            na_stage<false>(KC + (size_t)bh * CTXL * HD, lds0 + NA_KOFF, 2048, tid);
            na_stage<true>(VC + (size_t)bh * CTXL * HD, lds0 + NA_VOFF, 2048, tid);
            unsigned kc2[2][2];
#pragma unroll
            for (int kb = 0; kb < 2; ++kb)
#pragma unroll
                for (int ks = 0; ks < 2; ++ks) { const int key = 16 * kb + q; kc2[kb][ks] = lds0 + NA_KOFF + key * 128 + (((4 * ks + g) ^ (key & 7)) << 4); }
            { const int qq = (lane & 15) >> 2, p = lane & 3; const int key = 4 * g + qq;
#pragma unroll
              for (int db = 0; db < 4; ++db) va[db] = lds0 + NA_VOFF + key * 128 + ((db ^ ((key >> 1) & 3)) << 5) + 8 * p; }
            __syncthreads();
#pragma unroll
            for (int i = 0; i < 8; ++i) {
                f32x4 s0 = {0.f, 0.f, 0.f, 0.f}, s1 = s0;
                NA_STEP(s0, s1, kc2[0][0] + 4096 * i, kc2[0][1] + 4096 * i, kc2[1][0] + 4096 * i, kc2[1][1] + 4096 * i, 4096 * i);
            }
#undef NA_STEP
            l += __shfl_xor(l, 16); l += __shfl_xor(l, 32);
            const float rinv = 1.f / l;
            f16* op = O + ((size_t)b * SEQ + r * 64 + 16 * chunk + q) * DM + h * 64 + 4 * g;
#pragma unroll
            for (int db = 0; db < 4; ++db) { const f32x4 v = o[db] * rinv; u32x2 w; w.x = pkh(v[0], v[1]); w.y = pkh(v[2], v[3]); *(u32x2*)(op + 16 * db) = w; }
        }
    }
    __syncthreads();
}

struct Args { const float* in[26]; float* out; unsigned char* ws; int ph_lo, ph_hi; };
constexpr int NPHASE = 14;

__global__ void __launch_bounds__(NWAVES * 64, 2) fwd_kernel(Args args) {
    extern __shared__ __attribute__((aligned(16))) unsigned char lds[];
    Frame F;
    F.lds = (LAS unsigned char*)lds;
    F.G = gridDim.x; { const int bx = blockIdx.x; F.vcu = (F.G % 8 == 0) ? (bx % 8) * (F.G / 8) + bx / 8 : bx; }
    F.in = args.in;
    F.out = args.out; F.ws = args.ws;
    volatile LAS unsigned* MISC = (volatile LAS unsigned*)(F.lds + MISC_OFF);
    if (threadIdx.x < 64) MISC[threadIdx.x] = 0u;
    __syncthreads();
    unsigned* ctl = (unsigned*)(F.ws + WS_CTL);
    XcdBarrier bar; bar.bar = ctl + CW_BAR; bar.x = 0; bar.st = nullptr;
    const int lo = args.ph_lo, hi = args.ph_hi;
    if (hi - lo > 1) bar = xcd_barrier_post(ctl + CW_BAR, MISC + 8);
#define REFRESH() do { \
        { int z_ = 0; asm volatile("" : "+s"(z_)); F.in = args.in + z_; F.ws = args.ws + z_; F.out = args.out + z_; } \
        ws = F.ws; MOD = (const float*)(ws + WS_MOD); HC = (float*)(ws + WS_HC); SSQ = (float*)(ws + WS_SSQ); SHW = (const float*)(ws + WS_SHW); } while (0)
#ifndef PH_MASK
#define PH_MASK 0x3FFF
#endif
#define IN(k) (((PH_MASK >> (k)) & 1) && lo <= (k) && (k) < hi)
#define SEAM(k) do { if (lo <= (k) && (k) + 1 < hi) xcd_barrier(bar); } while (0)
    unsigned char* ws; const float* MOD; float* HC; float* SSQ; const float* SHW;
    LAS unsigned char* ring = F.lds;

    F.pacc = 0;
#ifdef PROBE_MASK
    unsigned long long probe_acc = 0;
#endif
    for (int ph = lo; ph < hi; ++ph) {
#ifdef PROBE_MASK
        const unsigned long long probe_t0 = __builtin_amdgcn_s_memrealtime();
#endif
        REFRESH();
        switch (ph) {
    case 0: if (!((PH_MASK >> 0) & 1)) break; { p0_prep(F); } break;
    case 1: if (!((PH_MASK >> 1) & 1)) break; { norm_phase(F, F.in[0], F.in[2], F.in[6], 0, 0, 1024, (f16*)(ws + WS_U), MALL); filt_gemm(F); shw_tasks(F); } break;
    case 2: if (!((PH_MASK >> 2) & 1)) break; {
        pg8::Gemm g{(const f16*)(ws + WS_U), (const f16*)(ws + WS_WIN), MLAT, 2048, 1024}; pg8::StaticOrder S; S.init(MLAT, 2048, F.G, (int)blockIdx.x);
        EpiCM E{(f16*)(ws + WS_PT), PT_LD};
        pg8::gemm_phase<EpiCM, pg8::StaticOrder, true>(ring, g, S, E);
        ctx_inproj(F);
    } break;
    case 3: if (!((PH_MASK >> 3) & 1)) break; { p3_fft(F); } break;
    case 4: if (!((PH_MASK >> 4) & 1)) break; { p4_transpose(F); } break;
    case 5: if (!((PH_MASK >> 5) & 1)) break; {
        pg8::Gemm g{(const f16*)(ws + WS_Y), (const f16*)(ws + WS_WOUT0), MLAT, 1024, 1024}; pg8::StaticOrder S; S.init(MLAT, 1024, F.G, (int)blockIdx.x);
        EpiResid<true> E{{F.in[0], F.in[2], F.out, HC, MOD + 2048, (f16*)(ws + WS_U2), F.in[7], MOD + 4096, SSQ}};
        pg8::gemm_phase<EpiResid<true>, pg8::StaticOrder, false>(ring, g, S, E);
        ctx_resid<true>(F, (const f16*)(ws + WS_Y), 1024, (const f16*)(ws + WS_WOUT0), E.P);
    } break;
    case 6: if (!((PH_MASK >> 6) & 1)) break; {
        pg8::Gemm g{(const f16*)(ws + WS_U2), (const f16*)(ws + WS_WGU0), MLAT, 2 * DFF, 1024}; pg8::StaticOrder S; S.init(MLAT, 2 * DFF, F.G, (int)blockIdx.x);
        EpiGU E{{(f16*)(ws + WS_ACT), SSQ, SHW}};
        pg8::gemm_phase<EpiGU, pg8::StaticOrder, false>(ring, g, S, E);
        ctx_gu(F, (const f16*)(ws + WS_U2), (const f16*)(ws + WS_WGU0), E.P);
    } break;
    case 7: if (!((PH_MASK >> 7) & 1)) break; {
        pg8::Gemm g{(const f16*)(ws + WS_ACT), (const f16*)(ws + WS_WD0), MLAT, 1024, DFF}; pg8::StaticOrder S; S.init(MLAT, 1024, F.G, (int)blockIdx.x);
        EpiResid<true> E{{F.out, HC, F.out, HC, MOD + 5120, (f16*)(ws + WS_U1), F.in[6] + 1024, MOD + 3 * 6144 + 1024, SSQ + MALL}};
        pg8::gemm_phase<EpiResid<true>, pg8::StaticOrder, false>(ring, g, S, E);
        ctx_resid<true>(F, (const f16*)(ws + WS_ACT), DFF, (const f16*)(ws + WS_WD0), E.P);
    } break;
    case 8: if (!((PH_MASK >> 8) & 1)) break; {
        pg8::Gemm g{(const f16*)(ws + WS_U1), (const f16*)(ws + WS_WQKV), MLAT, 3072, 1024}; pg8::StaticOrder S; S.init(MLAT, 3072, F.G, (int)blockIdx.x);
        EpiQKV E{{(f16*)(ws + WS_Q), (f16*)(ws + WS_KC), 0.125f * LOG2E, SSQ + MALL, SHW + 3 * 5632}};
        static_assert(WS_K - WS_Q == 32 * MiB && WS_V - WS_K == 32 * MiB && WS_VC - WS_KC == 1 * MiB, "EpiQKV strides");
        pg8::gemm_phase<EpiQKV, pg8::StaticOrder, false>(ring, g, S, E);
        ctx_kv(F, (const f16*)(ws + WS_U1), (const f16*)(ws + WS_WQKV), E.P);
    } break;
    case 9: if (!((PH_MASK >> 9) & 1)) break; { p11_na(F); } break;
    case 10: if (!((PH_MASK >> 10) & 1)) break; {
        pg8::Gemm g{(const f16*)(ws + WS_O), (const f16*)(ws + WS_WO1), MLAT, 1024, 1024}; pg8::StaticOrder S; S.init(MLAT, 1024, F.G, (int)blockIdx.x);
        EpiResid<true> E{{F.out, HC, F.out, HC, MOD + 3 * 6144 + 2048, (f16*)(ws + WS_U3), F.in[7] + 1024, MOD + 3 * 6144 + 4096, SSQ + 2 * MALL}};
        pg8::gemm_phase<EpiResid<true>, pg8::StaticOrder, false>(ring, g, S, E);
    } break;
    case 11: if (!((PH_MASK >> 11) & 1)) break; {
        pg8::Gemm g{(const f16*)(ws + WS_U3), (const f16*)(ws + WS_WGU1), MLAT, 2 * DFF, 1024}; pg8::StaticOrder S; S.init(MLAT, 2 * DFF, F.G, (int)blockIdx.x);
        EpiGU E{{(f16*)(ws + WS_ACT1), SSQ + 2 * MALL, SHW + 3 * 5632 + 3 * 3072}};
        pg8::gemm_phase<EpiGU, pg8::StaticOrder, false>(ring, g, S, E);
    } break;
    case 12: if (!((PH_MASK >> 12) & 1)) break; {
        pg8::Gemm g{(const f16*)(ws + WS_ACT1), (const f16*)(ws + WS_WD1), MLAT, 1024, DFF}; pg8::StaticOrder S; S.init(MLAT, 1024, F.G, (int)blockIdx.x);
        EpiResid<false> E{{F.out, HC, F.out, HC, MOD + 3 * 6144 + 5120, nullptr, nullptr, nullptr, nullptr}};
        pg8::gemm_phase<EpiResid<false>, pg8::StaticOrder, false>(ring, g, S, E);
    } break;
    case 13: if (!((PH_MASK >> 13) & 1)) break; { final_phase(F); } break;
        default: break;
        }
        if (ph + 1 < hi) xcd_barrier(bar);
#ifdef PROBE_MASK
        if ((PROBE_MASK >> ph) & 1) probe_acc += __builtin_amdgcn_s_memrealtime() - probe_t0;
#endif
    }
#ifdef PROBE_MASK
    if (blockIdx.x == 0) { const unsigned long long t0 = __builtin_amdgcn_s_memrealtime(); while (__builtin_amdgcn_s_memrealtime() - t0 < (unsigned long long)PROBE_AMP * (probe_acc + F.pacc)) __builtin_amdgcn_s_sleep(8); }
#endif
#undef IN
#undef SEAM
}

#ifdef DBG_STOP
__global__ void dbg_dump(const u16* src, float* out, size_t n, size_t nvalid) { for (size_t i = (size_t)blockIdx.x * blockDim.x + threadIdx.x; i < n; i += (size_t)gridDim.x * blockDim.x) out[i] = i < nvalid ? h2f(src[i]) : 0.f; }
__global__ void dbg_dump32(const float* src, float* out, size_t n, size_t nvalid) { for (size_t i = (size_t)blockIdx.x * blockDim.x + threadIdx.x; i < n; i += (size_t)gridDim.x * blockDim.x) out[i] = i < nvalid ? src[i] : 0.f; }
#endif
extern "C" void kernel_launch(void* const* d_in, const int* in_sizes, int n_in, void* d_out, int out_size, void* d_ws, size_t ws_size, hipStream_t stream) {
    static int grid = 0;
    if (grid == 0) {
        if (n_in != 26 || out_size != MLAT * DM || ws_size < WS_END) { fprintf(stderr, "kernel_launch: unexpected shapes (n_in %d out %d ws %zu)\n", n_in, out_size, ws_size); grid = -1; return; }
        int dev = 0, cus = 0;
        if (hipGetDevice(&dev) != hipSuccess || hipDeviceGetAttribute(&cus, hipDeviceAttributeMultiprocessorCount, dev) != hipSuccess) { grid = -1; return; }
        if (hipFuncSetAttribute((const void*)fwd_kernel, hipFuncAttributeMaxDynamicSharedMemorySize, LDS_BYTES) != hipSuccess) { fprintf(stderr, "kernel_launch: hipFuncSetAttribute failed\n"); grid = -1; return; }
        int per_cu = 0;
        if (hipOccupancyMaxActiveBlocksPerMultiprocessor(&per_cu, (const void*)fwd_kernel, NWAVES * 64, LDS_BYTES) != hipSuccess || per_cu < 1) fprintf(stderr, "kernel_launch: occupancy query reports %d\n", per_cu);
        (void)hipGetLastError();
        grid = cus;
    }
    if (grid < 0) return;
    (void)hipMemsetAsync((char*)d_ws + WS_CTL, 0, CTL_ZERO_BYTES, stream);
    Args a{};
    for (int i = 0; i < 26; ++i) a.in[i] = (const float*)d_in[i];
    a.out = (float*)d_out; a.ws = (unsigned char*)d_ws;
#ifdef DBG_STOP
    for (int p = 0; p <= DBG_STOP; ++p) { a.ph_lo = p; a.ph_hi = p + 1; hipLaunchKernelGGL(fwd_kernel, dim3(grid), dim3(NWAVES * 64), LDS_BYTES, stream, a); }
#if DBG_F32 == 2
#elif DBG_F32
    hipLaunchKernelGGL(dbg_dump32, dim3(2048), dim3(256), 0, stream, (const float*)((const char*)d_ws + DBG_OFF), (float*)d_out, (size_t)MLAT * DM, (size_t)DBG_N);
#else
    hipLaunchKernelGGL(dbg_dump, dim3(2048), dim3(256), 0, stream, (const u16*)((const char*)d_ws + DBG_OFF), (float*)d_out, (size_t)MLAT * DM, (size_t)DBG_N);
#endif
#elif MK_PER_PHASE
    for (int p = 0; p < NPHASE; ++p) { a.ph_lo = p; a.ph_hi = p + 1; hipLaunchKernelGGL(fwd_kernel, dim3(grid), dim3(NWAVES * 64), LDS_BYTES, stream, a); }
#else
    a.ph_lo = 0; a.ph_hi = NPHASE;
    hipLaunchKernelGGL(fwd_kernel, dim3(grid), dim3(NWAVES * 64), LDS_BYTES, stream, a);
#endif
}
```

```cpp
#include <hip/hip_runtime.h>
#include <cstdio>
#include <cstdint>

#ifndef MK_PER_PHASE
#define MK_PER_PHASE 0
#endif

#define LAS __attribute__((address_space(3)))
#define GAS __attribute__((address_space(1)))
typedef _Float16 f16;
typedef _Float16 f16x8 __attribute__((ext_vector_type(8)));
typedef _Float16 f16x4 __attribute__((ext_vector_type(4)));
typedef _Float16 f16x2 __attribute__((ext_vector_type(2)));
typedef float f32x4 __attribute__((ext_vector_type(4)));
typedef float f32x2 __attribute__((ext_vector_type(2)));
typedef unsigned u32x4 __attribute__((ext_vector_type(4)));
typedef unsigned u32x2 __attribute__((ext_vector_type(2)));
typedef unsigned short u16;

__device__ __forceinline__ unsigned pkh(float lo, float hi) { f16x2 v = {(f16)lo, (f16)hi}; return __builtin_bit_cast(unsigned, v); }
__device__ __forceinline__ float h2f(u16 b) { return (float)__builtin_bit_cast(f16, b); }

constexpr int DM = 1024, BATCH = 2, SEQ = 8192, CTXL = 256, DFF = 2816;
constexpr int MLAT = BATCH * SEQ;
constexpr int MCTX = BATCH * CTXL;
constexpr int MALL = MLAT + MCTX;
constexpr int NHEAD = 16, HD = 64;
constexpr int FILT_T = SEQ + CTXL;
constexpr float RMS_EPS = 1e-6f;
constexpr float LOG2E = 1.4426950408889634f;

namespace pg8 {
constexpr int BM = 256, BK = 64, HALF = 128, HTB = HALF * BK * 2, STAGE_BYTES = 8 * HTB, NXCD = 8, WGM = 8;
__host__ __device__ __forceinline__ int lds_byte(int r, int c) { const int st = (r >> 4) * 2 + (c >> 5), rr = r & 15, cc = c & 31, ob = rr * 64 + cc * 2; return st * 1024 + (ob ^ (((ob >> 9) & 1) << 5)); }
__host__ __device__ __forceinline__ void stage_rc(int b, int& R, int& C) { const int st = b / 1024, sb = b % 1024, swz = sb ^ (((sb >> 9) & 1) << 5); R = (st >> 1) * 16 + swz / 64; C = (st & 1) * 32 + (swz % 64) / 2; }

struct Unit { int pm, pn; };
struct Gemm { const f16* A; const f16* Bt; int M, N, K; };

struct StaticOrder {
    int nM, nN, nwg, G, c;
    __device__ void init(int M, int N, int G_, int c_) { nM = M / BM; nN = N / BM; nwg = nM * nN; G = G_; c = c_; }
    __device__ bool next(int i, Unit& u) const {
        const long L = (long)i * G + c; if (L >= nwg) return false;
        int wgid = (int)L; { const int q = nwg / NXCD, r = nwg % NXCD, xcd = wgid % NXCD, off = wgid / NXCD; wgid = (xcd < r ? xcd * (q + 1) : r * (q + 1) + (xcd - r) * q) + off; }
        const int nig = WGM * nN, gid = wgid / nig, fm = gid * WGM, gsz = (nM - fm) < WGM ? (nM - fm) : WGM;
        u.pm = fm + ((wgid % nig) % gsz); u.pn = (wgid % nig) / gsz; return true;
    }
};
struct QkvOrder {
    int G, c;
    __device__ bool next(int i, Unit& u) const {
        const long L = (long)i * G + c; if (L >= 784) return false;
        if (L >= 768) { const int r = (int)L - 768; u.pm = 64 + (r & 1); u.pn = 4 + (r >> 1); return true; }
        int wgid = (int)L; { const int q = 768 / NXCD, xcd = wgid % NXCD, off = wgid / NXCD; wgid = xcd * q + off; }
        const int nig = WGM * 12, gid = wgid / nig, fm = gid * WGM;
        u.pm = fm + ((wgid % nig) % WGM); u.pn = (wgid % nig) / WGM; return true;
    }
};

template <class Epi, class Sched, bool SWAP>
__device__ __forceinline__ void gemm_phase(LAS unsigned char* lds, const Gemm g, const Sched& S, const Epi& E) {
    int tid = threadIdx.x; asm volatile("" : "+v"(tid));
    const int wid = __builtin_amdgcn_readfirstlane(tid >> 6), lane = tid & 63, wr = wid >> 2, wc = wid & 3, fr = lane & 15, fq = lane >> 4;
    const int K = g.K, nt = K / BK;
    unsigned voffA[2];
#pragma unroll
    for (int i = 0; i < 2; ++i) { int R, C; stage_rc(tid * 16 + i * 8192, R, C); voffA[i] = (unsigned)(R * K + C) * 2u; }
    const size_t kstep = (size_t)(BK * 2);
    const size_t hstep = (size_t)HALF * K * 2;
    const size_t tstep = 2 * hstep;
    const unsigned ldsw = (unsigned)wid * 1024u;
    const int aoff = lds_byte(wr * 64 + fr, fq * 8), boff = lds_byte(wc * 32 + fr, fq * 8);
#define PG8_SA(b, h) (((b) * 2 + (h)) * HTB)
#define PG8_SB(b, h) ((4 + (b) * 2 + (h)) * HTB)
#define PG8_STAGE(bufoff, gbase) do { _Pragma("unroll") for (int _i = 0; _i < 2; ++_i) \
        __builtin_amdgcn_global_load_lds((const unsigned*)((const char*)(gbase) + voffA[_i]), (LAS unsigned*)(lds + (bufoff) + ldsw + _i * 8192), 16, 0, 0); } while (0)
#define PG8_LDA(dst, b, h) do { _Pragma("unroll") for (int m = 0; m < 4; ++m) _Pragma("unroll") for (int k = 0; k < 2; ++k) dst[m][k] = *(const LAS f16x8*)(lds + PG8_SA(b, h) + aoff + m * 2048 + k * 1024); } while (0)
#define PG8_LDB(dst, b, h) do { _Pragma("unroll") for (int n = 0; n < 2; ++n) _Pragma("unroll") for (int k = 0; k < 2; ++k) dst[n][k] = *(const LAS f16x8*)(lds + PG8_SB(b, h) + boff + n * 2048 + k * 1024); } while (0)
#define PG8_MMA(ai, bj, At, Bt) do { __builtin_amdgcn_s_setprio(1); _Pragma("unroll") for (int m = 0; m < 4; ++m) _Pragma("unroll") for (int n = 0; n < 2; ++n) _Pragma("unroll") for (int k = 0; k < 2; ++k) \
        acc[ai][bj][m][n] = SWAP ? __builtin_amdgcn_mfma_f32_16x16x32_f16(At[m][k], Bt[n][k], acc[ai][bj][m][n], 0, 0, 0) \
                                 : __builtin_amdgcn_mfma_f32_16x16x32_f16(Bt[n][k], At[m][k], acc[ai][bj][m][n], 0, 0, 0); __builtin_amdgcn_s_setprio(0); } while (0)
#define PG8_WAIT_V(n) asm volatile("s_waitcnt vmcnt(" #n ")" ::: "memory")
#define PG8_WAIT_L(n) asm volatile("s_waitcnt lgkmcnt(" #n ")" ::: "memory")
#define PG8_BAR __builtin_amdgcn_s_barrier()
#define PG8_SCHED __builtin_amdgcn_sched_barrier(0)
    Unit cur, nxt; int ui = 0;
    if (!S.next(0, cur)) return;
    f32x4 acc[2][2][4][2];
#pragma unroll
    for (int a = 0; a < 2; ++a)
#pragma unroll
        for (int b = 0; b < 2; ++b)
#pragma unroll
            for (int m = 0; m < 4; ++m)
#pragma unroll
                for (int n = 0; n < 2; ++n) acc[a][b][m][n] = (f32x4){0.f, 0.f, 0.f, 0.f};
    f16x8 At[4][2], B0[2][2], B1[2][2];
    const char* cA = (const char*)g.A + (size_t)cur.pm * tstep; const char* cB = (const char*)g.Bt + (size_t)cur.pn * tstep;
    PG8_STAGE(PG8_SB(0, 0), cB); PG8_STAGE(PG8_SB(0, 1), cB + hstep); PG8_STAGE(PG8_SA(0, 0), cA); PG8_STAGE(PG8_SA(0, 1), cA + hstep);
    if (wr == 1) PG8_BAR;
    PG8_WAIT_V(2); PG8_BAR;
    PG8_STAGE(PG8_SB(1, 0), cB + kstep); PG8_STAGE(PG8_SA(1, 0), cA + kstep); PG8_STAGE(PG8_SB(1, 1), cB + hstep + kstep);
    PG8_WAIT_V(6); PG8_BAR;
    for (;;) {
        const bool has_next = S.next(ui + 1, nxt);
        const char* nA = has_next ? (const char*)g.A + (size_t)nxt.pm * tstep : cA; const char* nB = has_next ? (const char*)g.Bt + (size_t)nxt.pn * tstep : cB;
        for (int t = 0; t < nt; t += 2) {
            const bool last = (t == nt - 2);
            const char* a1 = cA + (size_t)(t + 1) * kstep;
            const char* a2 = last ? nA : cA + (size_t)(t + 2) * kstep; const char* b2 = last ? nB : cB + (size_t)(t + 2) * kstep;
            const char* a3 = a2 + kstep; const char* b3 = b2 + kstep;
            PG8_LDB(B0, 0, 0); PG8_LDB(B1, 0, 1); PG8_SCHED; PG8_LDA(At, 0, 0); PG8_STAGE(PG8_SA(1, 1), a1 + hstep);
            PG8_WAIT_V(8); PG8_WAIT_L(0); PG8_BAR; PG8_MMA(0, 0, At, B0); PG8_MMA(0, 1, At, B1); PG8_BAR; PG8_SCHED;
            PG8_LDA(At, 0, 1); PG8_STAGE(PG8_SB(0, 0), b2); PG8_STAGE(PG8_SB(0, 1), b2 + hstep); PG8_STAGE(PG8_SA(0, 0), a2);
            PG8_WAIT_V(8); PG8_WAIT_L(0); PG8_BAR; PG8_MMA(1, 0, At, B0); PG8_MMA(1, 1, At, B1); PG8_BAR; PG8_SCHED;
            PG8_LDB(B0, 1, 0); PG8_LDB(B1, 1, 1); PG8_SCHED; PG8_LDA(At, 1, 0); PG8_STAGE(PG8_SA(0, 1), a2 + hstep);
            PG8_WAIT_V(8); PG8_WAIT_L(0); PG8_BAR; PG8_MMA(0, 0, At, B0); PG8_MMA(0, 1, At, B1); PG8_BAR; PG8_SCHED;
            PG8_LDA(At, 1, 1); PG8_STAGE(PG8_SB(1, 0), b3); PG8_STAGE(PG8_SB(1, 1), b3 + hstep); PG8_STAGE(PG8_SA(1, 0), a3);
            PG8_WAIT_V(8); PG8_WAIT_L(0); PG8_BAR; PG8_MMA(1, 0, At, B0); PG8_MMA(1, 1, At, B1); PG8_BAR; PG8_SCHED;
        }
        if (wr == 0) PG8_BAR;
        E(acc, cur, wr, wc, fr, fq);
        if (!has_next) break;
#pragma unroll
        for (int a = 0; a < 2; ++a)
#pragma unroll
            for (int b = 0; b < 2; ++b)
#pragma unroll
                for (int m = 0; m < 4; ++m)
#pragma unroll
                    for (int n = 0; n < 2; ++n) acc[a][b][m][n] = (f32x4){0.f, 0.f, 0.f, 0.f};
        cur = nxt; cA = nA; cB = nB; ++ui;
        if (wr == 1) PG8_BAR;
    }
    PG8_WAIT_V(0);
    PG8_BAR;
#undef PG8_SA
#undef PG8_SB
#undef PG8_STAGE
#undef PG8_LDA
#undef PG8_LDB
#undef PG8_MMA
#undef PG8_WAIT_V
#undef PG8_WAIT_L
#undef PG8_BAR
#undef PG8_SCHED
}
}

constexpr size_t MiB = 1u << 20;
constexpr size_t WS_CTL = 0, CTL_ZERO_BYTES = 512 * 1024;
constexpr size_t WS_SSQ = 65536;
constexpr size_t WS_SHW = 1 * MiB + 256 * 1024;
constexpr size_t WS_MOD  = 1 * MiB;
constexpr size_t WS_HID2 = 2 * MiB;
constexpr size_t WS_HC   = 5 * MiB;
constexpr size_t WS_WIN  = 8 * MiB;
constexpr size_t WS_WOUT0 = 12 * MiB;
constexpr size_t WS_WGU0 = 14 * MiB;
constexpr size_t WS_WD0  = 26 * MiB;
constexpr size_t WS_WGU1 = 32 * MiB;
constexpr size_t WS_WD1  = 44 * MiB;
constexpr size_t WS_WQKV = 50 * MiB;
constexpr size_t WS_WO1  = 56 * MiB;
constexpr size_t WS_PT   = 64 * MiB;
constexpr size_t WS_FILT = 130 * MiB;
constexpr size_t WS_U    = 163 * MiB;
constexpr size_t WS_HS   = 163 * MiB;
constexpr size_t WS_XS   = 228 * MiB;
constexpr size_t WS_Y    = 130 * MiB;
constexpr size_t WS_U2   = 64 * MiB;
constexpr size_t WS_ACT  = 100 * MiB;
constexpr size_t WS_U1   = 64 * MiB;
constexpr size_t WS_Q    = 100 * MiB;
constexpr size_t WS_K    = 132 * MiB;
constexpr size_t WS_V    = 164 * MiB;
constexpr size_t WS_KC   = 198 * MiB;
constexpr size_t WS_VC   = 199 * MiB;
constexpr size_t WS_O    = 64 * MiB;
constexpr size_t WS_U3   = 100 * MiB;
constexpr size_t WS_ACT1 = 132 * MiB;
constexpr size_t WS_END  = 256 * MiB;
constexpr int PT_LD = MALL;

constexpr int CW_BAR = 4096;

constexpr int LDS_BYTES = 163840;
constexpr int FFT_BYTES = 16384 * 33 / 32 * 8;
constexpr int SCR_OFF = FFT_BYTES;
constexpr int MISC_OFF = LDS_BYTES - 256;
constexpr int NWAVES = 8;

#define RLX_AGENT __ATOMIC_RELAXED, __HIP_MEMORY_SCOPE_AGENT
#define LDS_WAIT() asm volatile("s_waitcnt lgkmcnt(0)" ::: "memory")
#define VM_WAIT() asm volatile("s_waitcnt vmcnt(0)" ::: "memory")

#define XB_TMO      128
#define XB_XCNT(j)  (256  + 64 * (j))
#define XB_XSUB(j)  (1280 + 64 * (j))
#define XB_XGEN(j)  (2304 + 64 * (j))
#define XB_TOP      3328
#define XB_TOPGEN   3392
#define XCD_BAR_WORDS 3456
#define XB_SPIN_CAP (1u << 18)
__device__ __forceinline__ unsigned xb_ld(unsigned* p)              { return __hip_atomic_load(p, __ATOMIC_RELAXED, __HIP_MEMORY_SCOPE_AGENT); }
__device__ __forceinline__ unsigned xb_add(unsigned* p, unsigned v) { return __hip_atomic_fetch_add(p, v, __ATOMIC_RELAXED, __HIP_MEMORY_SCOPE_AGENT); }
__device__ __forceinline__ unsigned xb_xcc_id() { return (unsigned)__builtin_amdgcn_s_getreg((3 << 11) | 20) & 0xFu; }
#define XB_SPIN(cond, bar) do { unsigned _sp = 0; while (cond) { __builtin_amdgcn_s_sleep(1); \
    if ((++_sp & 255u) == 0u) { if (xb_ld(&(bar)[XB_TMO])) break; if (_sp > XB_SPIN_CAP) { atomicAdd(&(bar)[XB_TMO], 1u); break; } } } } while (0)
struct XcdBarrier { unsigned* bar; unsigned x; volatile LAS unsigned* st; };
__device__ __forceinline__ XcdBarrier xcd_barrier_post(unsigned* bar, volatile LAS unsigned* st) {
    XcdBarrier b; b.bar = bar; b.x = xb_xcc_id(); b.st = st;
    if (threadIdx.x == 0) (void)xb_add(&bar[XB_XCNT(b.x)], 1u);
    return b;
}
__device__ __forceinline__ void xcd_barrier_complete(unsigned* bar, unsigned x, unsigned& nloc, unsigned& nx) {
    const unsigned G = gridDim.x * gridDim.y * gridDim.z;
    unsigned sum, cnt, mine, sp = 0u;
    for (;;) {
        sum = 0u; cnt = 0u; mine = 0u;
#pragma unroll
        for (unsigned j = 0; j < 16; ++j) { const unsigned c = xb_ld(&bar[XB_XCNT(j)]); sum += c; cnt += (c > 0u) ? 1u : 0u; mine = (j == x) ? c : mine; }
        if (sum == G) break;
        __builtin_amdgcn_s_sleep(1);
        if ((++sp & 255u) == 0u) { if (xb_ld(&bar[XB_TMO])) break; if (sp > XB_SPIN_CAP) { atomicAdd(&bar[XB_TMO], 1u); break; } }
    }
    nloc = mine > 0u ? mine : 1u; nx = cnt > 0u ? cnt : 1u;
}
__device__ __forceinline__ void xcd_barrier(const XcdBarrier& b) {
    asm volatile("s_waitcnt vmcnt(0)" ::: "memory");
    __syncthreads();
    if (threadIdx.x == 0) {
        unsigned* bar = b.bar;
        __builtin_amdgcn_s_waitcnt(0);
        unsigned nloc = b.st[0], nx = b.st[1];
        if (nloc == 0u) { xcd_barrier_complete(bar, b.x, nloc, nx); b.st[0] = nloc; b.st[1] = nx; }
        const unsigned old = xb_add(&bar[XB_XSUB(b.x)], 1u);
        const unsigned gen = old / nloc;
        if (old + 1u == (gen + 1u) * nloc) {
            __builtin_amdgcn_fence(__ATOMIC_RELEASE, "agent");
            asm volatile("s_waitcnt vmcnt(0)" ::: "memory");
            const unsigned og = xb_add(&bar[XB_TOP], 1u);
            const unsigned tg = og / nx;
            if (og + 1u == (tg + 1u) * nx) xb_add(&bar[XB_TOPGEN], 1u);
            else XB_SPIN(xb_ld(&bar[XB_TOPGEN]) == tg, bar);
            __builtin_amdgcn_fence(__ATOMIC_ACQUIRE, "agent");
            xb_add(&bar[XB_XGEN(b.x)], 1u);
            asm volatile("s_waitcnt vmcnt(0)" ::: "memory");
        } else {
            XB_SPIN(xb_ld(&bar[XB_XGEN(b.x)]) == gen, bar);
            __builtin_amdgcn_fence(__ATOMIC_ACQUIRE, "agent");
            asm volatile("s_waitcnt vmcnt(0)" ::: "memory");
        }
    }
    __syncthreads();
}

struct Frame {
    LAS unsigned char* lds;
    int vcu, G;
    unsigned long long pacc;
    const float* const* in;
    float* out; unsigned char* ws;
};
#define LOCAL_IDS() int tid = threadIdx.x; asm volatile("" : "+v"(tid)); const int lane = tid & 63; const int wave = __builtin_amdgcn_readfirstlane(tid >> 6); (void)lane; (void)wave
__device__ __forceinline__ float wave_sum(float v) {
#pragma unroll
    for (int o = 1; o < 64; o <<= 1) v += __shfl_xor(v, o);
    return v;
}
__device__ __forceinline__ float silu_f(float x) { return x / (1.f + __expf(-x)); }
__device__ __forceinline__ float sin_rev(float r) { return __builtin_amdgcn_sinf(__builtin_amdgcn_fractf(r)); }
__device__ __forceinline__ float cos_rev(float r) { return __builtin_amdgcn_cosf(__builtin_amdgcn_fractf(r)); }
__device__ __forceinline__ float sin_rad(float x) { return sin_rev(x * 0.15915494309189535f); }

__device__ __forceinline__ void transpose_item(const float* W, int N, f16* WT, int ldt, int k0, int n0, int drow0, LAS float* scr, int lane) {
    { f32x4 v[8];
#pragma unroll
      for (int i = 0; i < 8; ++i) v[i] = *(const f32x4*)(W + (size_t)(k0 + 8 * i + (lane >> 3)) * N + n0 + 4 * (lane & 7));
#pragma unroll
      for (int i = 0; i < 8; ++i) { LAS float* d = scr + (8 * i + (lane >> 3)) * 33 + 4 * (lane & 7); d[0] = v[i][0]; d[1] = v[i][1]; d[2] = v[i][2]; d[3] = v[i][3]; } }
    LDS_WAIT(); asm volatile("" ::: "memory");
    const int c = lane & 7;
#pragma unroll
    for (int j = 0; j < 4; ++j) { const int n = (lane >> 3) + 8 * j; const LAS float* s = scr + (8 * c) * 33 + n;
        u32x4 o; o.x = pkh(s[0 * 33], s[1 * 33]); o.y = pkh(s[2 * 33], s[3 * 33]); o.z = pkh(s[4 * 33], s[5 * 33]); o.w = pkh(s[6 * 33], s[7 * 33]);
        *(u32x4*)(WT + (size_t)(drow0 + n0 + n) * ldt + k0 + 8 * c) = o; }
    LDS_WAIT(); asm volatile("" ::: "memory");
}
__device__ __forceinline__ void fold_item(const float* Win, f16* WT, int g, int k0, LAS float* scr, int lane) {
    LAS float* wrow = scr;
    LAS float* tcs = scr + 256;
#pragma unroll
    for (int i = 0; i < 4; ++i) { const int e = i * 64 + lane; wrow[e] = Win[(size_t)(k0 + (e >> 7)) * 2048 + 128 * g + (e & 127)]; }
    { const float r0 = (float)lane * (1.f / 128.f), r1 = (float)(lane + 64) * (1.f / 128.f);
      tcs[lane] = cos_rev(r0); tcs[lane + 64] = cos_rev(r1); tcs[128 + lane] = sin_rev(r0); tcs[128 + lane + 64] = sin_rev(r1); }
    LDS_WAIT(); asm volatile("" ::: "memory");
#pragma unroll
    for (int half = 0; half < 2; ++half) {
        const int mp = lane + 64 * half;
        const int m = (mp <= 64) ? mp : mp - 64; const int tb = (mp <= 64) ? 0 : 128;
        float a0 = 0.f, a1 = 0.f, b0 = 0.f, b1 = 0.f;
#pragma unroll 8
        for (int c = 0; c < 128; c += 2) { const float f0 = tcs[tb + ((m * c) & 127)], f1 = tcs[tb + ((m * (c + 1)) & 127)];
            a0 += wrow[c] * f0; a1 += wrow[128 + c] * f0; b0 += wrow[c + 1] * f1; b1 += wrow[128 + c + 1] * f1; }
        const float s = 1.f / 1024.f;
        *(unsigned*)(WT + (size_t)(128 * g + mp) * 1024 + k0) = pkh((a0 + b0) * s, (a1 + b1) * s);
    }
    LDS_WAIT(); asm volatile("" ::: "memory");
}
__device__ __forceinline__ void hid_rows(Frame& F, int gw, int NGW) {
    LOCAL_IDS();
    const float* w1 = F.in[15]; const float* b1 = F.in[16]; const float* fr = F.in[17]; const float* w2 = F.in[18]; const float* b2 = F.in[19];
    float* HID2 = (float*)(F.ws + WS_HID2);
    LAS float* wl = (LAS float*)F.lds;
    __syncthreads();
    for (int e = tid; e < 33 * 64; e += 512) wl[e] = w1[e];
    for (int e = tid; e < 64 * 64; e += 512) wl[33 * 64 + e] = w2[e];
    __syncthreads();
    const int j = lane;
    const float bb1 = b1[j], bb2 = b2[j], fq = fr[j];
    for (int t = gw; t < FILT_T; t += NGW) {
        const int L = t < SEQ ? SEQ : CTXL, tt = t < SEQ ? t : t - SEQ;
        float z = 0.f;
        if (j == 0) z = (float)tt / (float)(L - 1);
        else if (j < 33) { const int bnd = (j - 1) & 15; const float band = 1e-4f + (float)bnd * ((15.f - 1e-4f) / 15.f);
            const float rev = (float)tt * band / (float)L;
            z = (j <= 16) ? cos_rev(rev) : -sin_rev(rev); }
        float a1 = bb1;
#pragma unroll
        for (int i = 0; i < 33; ++i) a1 += __builtin_bit_cast(float, __builtin_amdgcn_readlane(__builtin_bit_cast(int, z), i)) * wl[i * 64 + j];
        const float h1 = sin_rad(fq * a1);
        float a2 = bb2;
#pragma unroll
        for (int i = 0; i < 64; ++i) a2 += __builtin_bit_cast(float, __builtin_amdgcn_readlane(__builtin_bit_cast(int, h1), i)) * wl[(33 + i) * 64 + j];
        HID2[(size_t)t * 64 + j] = sin_rad(fq * a2);
    }
    __syncthreads();
}
__device__ __forceinline__ void ada_items(Frame& F) {
    LOCAL_IDS();
    const float* c = F.in[1]; const float* cctx = F.in[3]; const float* aw = F.in[4]; const float* ab = F.in[5];
    float* MOD = (float*)(F.ws + WS_MOD);
    LAS float* sl = (LAS float*)F.lds;
    LAS float* red = (LAS float*)(F.lds + 16384);
    bool have = false;
    for (int it = F.vcu; it < 192; it += F.G) {
        if (!have) { for (int e = tid; e < 3072; e += 512) { const int r = e >> 10, k = e & 1023; const float v = r < 2 ? c[r * 1024 + k] : cctx[k]; sl[e] = silu_f(v); } have = true; __syncthreads(); }
        const int layer = it / 96, n0 = (it % 96) * 64;
        const int kq = tid >> 4, cq = tid & 15;
        f32x4 a0 = {0.f, 0.f, 0.f, 0.f}, a1 = a0, a2 = a0;
        const float* wp = aw + ((size_t)layer * 1024) * 6144 + n0 + 4 * cq;
#pragma unroll 4
        for (int kk = kq; kk < 1024; kk += 32) { const f32x4 w = *(const f32x4*)(wp + (size_t)kk * 6144);
            a0 += w * sl[kk]; a1 += w * sl[1024 + kk]; a2 += w * sl[2048 + kk]; }
#pragma unroll
        for (int e = 0; e < 4; ++e) { red[(kq * 3 + 0) * 64 + 4 * cq + e] = a0[e]; red[(kq * 3 + 1) * 64 + 4 * cq + e] = a1[e]; red[(kq * 3 + 2) * 64 + 4 * cq + e] = a2[e]; }
        __syncthreads();
        if (tid < 192) { const int r = tid >> 6, col = tid & 63; float s = ab[layer * 6144 + n0 + col];
            for (int q = 0; q < 32; ++q) s += red[(q * 3 + r) * 64 + col];
            MOD[(size_t)(layer * 3 + r) * 6144 + n0 + col] = s; }
        __syncthreads();
    }
}
__device__ __forceinline__ void p0_prep(Frame& F) {
    LOCAL_IDS();
    const int gw = F.vcu * NWAVES + wave, NGW = F.G * NWAVES;
    ada_items(F);
    __syncthreads();
    LAS float* scr = (LAS float*)(F.lds + wave * 16384);
    f16* Win_t = (f16*)(F.ws + WS_WIN);
    constexpr int I_WIN = 16 * 48, I_WOUT = 16 * 32, I_G = 16 * 88, I_D = 44 * 32, I_QKV = 16 * 96, I_O1 = 16 * 32;
    constexpr int NIT = I_WIN + I_WOUT + 4 * I_G + 2 * I_D + I_QKV + I_O1;
    for (int it = gw; it < NIT; it += NGW) {
        int r = it;
        if (r < I_WIN) { const int kb = r / 48, nb = r % 48; transpose_item(F.in[11], 2048, Win_t, 1024, 64 * kb, 512 + 32 * nb, 0, scr, lane); continue; } r -= I_WIN;
        if (r < I_WOUT) { const int kb = r / 32, nb = r % 32; transpose_item(F.in[12], 1024, (f16*)(F.ws + WS_WOUT0), 1024, 64 * kb, 32 * nb, 0, scr, lane); continue; } r -= I_WOUT;
        if (r < 4 * I_G) { const int which = r / I_G, rr = r % I_G, layer = which >> 1, up = which & 1; const int kb = rr / 88, nb = rr % 88, n0 = 32 * nb;
            const float* src = (up ? F.in[9] : F.in[8]) + (size_t)layer * 1024 * DFF;
            f16* dst = (f16*)(F.ws + (layer ? WS_WGU1 : WS_WGU0));
            const int drow0 = (n0 >> 7) * 256 + (up ? 128 : 0) + (n0 & 127) - n0;
            transpose_item(src, DFF, dst, 1024, 64 * kb, n0, drow0, scr, lane); continue; } r -= 4 * I_G;
        if (r < 2 * I_D) { const int layer = r / I_D, rr = r % I_D; const int kb = rr / 32, nb = rr % 32;
            transpose_item(F.in[10] + (size_t)layer * DFF * 1024, 1024, (f16*)(F.ws + (layer ? WS_WD1 : WS_WD0)), DFF, 64 * kb, 32 * nb, 0, scr, lane); continue; } r -= 2 * I_D;
        if (r < I_QKV) { const int kb = r / 96, nb = r % 96; transpose_item(F.in[22], 3072, (f16*)(F.ws + WS_WQKV), 1024, 64 * kb, 32 * nb, 0, scr, lane); continue; } r -= I_QKV;
        { const int kb = r / 32, nb = r % 32; transpose_item(F.in[23], 1024, (f16*)(F.ws + WS_WO1), 1024, 64 * kb, 32 * nb, 0, scr, lane); }
    }
    for (int it = gw; it < 2048; it += NGW) fold_item(F.in[11], Win_t, it >> 9, (it & 511) * 2, scr, lane);
    hid_rows(F, gw, NGW);
}

__device__ __forceinline__ void norm_mod_row(const float* xrow, const float* g, const float* sh, const float* sc, f16* orow, int lane) {
    const f32x4* xr = (const f32x4*)xrow + lane;
    f32x4 v[4]; float s = 0.f;
#pragma unroll
    for (int j = 0; j < 4; ++j) { v[j] = xr[64 * j]; s += (v[j].x * v[j].x + v[j].y * v[j].y) + (v[j].z * v[j].z + v[j].w * v[j].w); }
    const float rstd = 1.f / sqrtf(wave_sum(s) * (1.f / DM) + RMS_EPS);
    u32x2* o8 = (u32x2*)orow + lane;
#pragma unroll
    for (int j = 0; j < 4; ++j) { const f32x4 gg = ((const f32x4*)g)[lane + 64 * j], s1 = ((const f32x4*)sc)[lane + 64 * j], s0 = ((const f32x4*)sh)[lane + 64 * j];
        const f32x4 y = (v[j] * rstd) * gg * (s1 + 1.f) + s0;
        u32x2 w; w.x = pkh(y.x, y.y); w.y = pkh(y.z, y.w); o8[64 * j] = w; }
}
__device__ __forceinline__ void norm_phase(Frame& F, const float* hl, const float* hc, const float* g, int layer, int sh_off, int sc_off, f16* U, int nrows) {
    LOCAL_IDS();
    const int gw = F.vcu * NWAVES + wave, NGW = F.G * NWAVES;
    const float* MOD = (const float*)(F.ws + WS_MOD) + (size_t)layer * 3 * 6144;
    for (int m0 = gw; m0 < nrows; m0 += 2 * NGW) {
        const int m1 = m0 + NGW; const bool two = m1 < nrows;
        const float* s0 = m0 < MLAT ? hl + (size_t)m0 * DM : hc + (size_t)(m0 - MLAT) * DM;
        const float* s1 = two ? (m1 < MLAT ? hl + (size_t)m1 * DM : hc + (size_t)(m1 - MLAT) * DM) : s0;
        const f32x4* x0 = (const f32x4*)s0 + lane; const f32x4* x1 = (const f32x4*)s1 + lane;
        f32x4 v0[4], v1[4]; float q0 = 0.f, q1 = 0.f;
#pragma unroll
        for (int j = 0; j < 4; ++j) { v0[j] = x0[64 * j]; v1[j] = x1[64 * j]; }
#pragma unroll
        for (int j = 0; j < 4; ++j) { q0 += (v0[j].x * v0[j].x + v0[j].y * v0[j].y) + (v0[j].z * v0[j].z + v0[j].w * v0[j].w); q1 += (v1[j].x * v1[j].x + v1[j].y * v1[j].y) + (v1[j].z * v1[j].z + v1[j].w * v1[j].w); }
        const float rs0 = 1.f / sqrtf(wave_sum(q0) * (1.f / DM) + RMS_EPS), rs1 = 1.f / sqrtf(wave_sum(q1) * (1.f / DM) + RMS_EPS);
        const int r0 = m0 < MLAT ? (m0 >> 13) : 2, r1 = m1 < MLAT ? (m1 >> 13) : 2;
#pragma unroll
        for (int j = 0; j < 4; ++j) { const f32x4 gg = ((const f32x4*)g)[lane + 64 * j];
            { const f32x4 sc = ((const f32x4*)(MOD + r0 * 6144 + sc_off))[lane + 64 * j], sh = ((const f32x4*)(MOD + r0 * 6144 + sh_off))[lane + 64 * j];
              const f32x4 y = (v0[j] * rs0) * gg * (sc + 1.f) + sh; u32x2 w; w.x = pkh(y.x, y.y); w.y = pkh(y.z, y.w); ((u32x2*)(U + (size_t)m0 * DM))[lane + 64 * j] = w; }
            if (two) { const f32x4 sc = ((const f32x4*)(MOD + r1 * 6144 + sc_off))[lane + 64 * j], sh = ((const f32x4*)(MOD + r1 * 6144 + sh_off))[lane + 64 * j];
              const f32x4 y = (v1[j] * rs1) * gg * (sc + 1.f) + sh; u32x2 w; w.x = pkh(y.x, y.y); w.y = pkh(y.z, y.w); ((u32x2*)(U + (size_t)m1 * DM))[lane + 64 * j] = w; } }
    }
}
__device__ __forceinline__ void final_phase(Frame& F) {
    LOCAL_IDS();
    const int gw = F.vcu * NWAVES + wave, NGW = F.G * NWAVES;
    const float* g = F.in[25];
    for (int m = gw; m < MLAT; m += NGW) {
        f32x4* xr = (f32x4*)(F.out + (size_t)m * DM) + lane;
        f32x4 v[4]; float s = 0.f;
#pragma unroll
        for (int j = 0; j < 4; ++j) { v[j] = xr[64 * j]; s += (v[j].x * v[j].x + v[j].y * v[j].y) + (v[j].z * v[j].z + v[j].w * v[j].w); }
        const float rstd = 1.f / sqrtf(wave_sum(s) * (1.f / DM) + RMS_EPS);
#pragma unroll
        for (int j = 0; j < 4; ++j) xr[64 * j] = (v[j] * rstd) * ((const f32x4*)g)[lane + 64 * j];
    }
}

__device__ __forceinline__ void filt_gemm(Frame& F) {
    LOCAL_IDS();
    const int gw = F.vcu * NWAVES + wave, NGW = F.G * NWAVES;
    const float* HID2 = (const float*)(F.ws + WS_HID2); const float* w3 = F.in[20];
    f16* FILT = (f16*)(F.ws + WS_FILT);
    const int li = lane & 15, lg = lane >> 4;
    constexpr int NTB = FILT_T / 64;
    LAS u16* stg = (LAS u16*)(F.lds + wave * 4096);
    const int cb = gw & 127, ch0 = cb * 16;
    f16x8 bw[2];
#pragma unroll
    for (int ks = 0; ks < 2; ++ks)
#pragma unroll
        for (int j = 0; j < 8; ++j) bw[ks][j] = (f16)w3[(size_t)(32 * ks + 8 * lg + j) * 2048 + ch0 + li];
    const int c = (ch0 + li) & 511;
    const float mind = -3.0701134573253945f, maxd = -15.350567286626973f;
    const float delta = fabsf(mind + (float)c * ((maxd - mind) / 511.f));
    for (int tb = gw >> 7; tb < NTB; tb += NGW >> 7) {
        const int t0 = tb * 64;
#pragma unroll
        for (int s = 0; s < 4; ++s) {
            f32x4 acc = {0.f, 0.f, 0.f, 0.f};
            const f32x4* hp = (const f32x4*)(HID2 + (size_t)(t0 + 16 * s + li) * 64 + 8 * lg);
#pragma unroll
            for (int ks = 0; ks < 2; ++ks) { const f32x4 h0 = hp[8 * ks], h1 = hp[8 * ks + 1];
                f16x8 hi, lo;
#pragma unroll
                for (int e = 0; e < 4; ++e) { hi[e] = (f16)h0[e]; lo[e] = (f16)(h0[e] - (float)hi[e]); hi[4 + e] = (f16)h1[e]; lo[4 + e] = (f16)(h1[e] - (float)hi[4 + e]); }
                acc = __builtin_amdgcn_mfma_f32_16x16x32_f16(hi, bw[ks], acc, 0, 0, 0);
                acc = __builtin_amdgcn_mfma_f32_16x16x32_f16(lo, bw[ks], acc, 0, 0, 0); }
            const int tq = t0 + 16 * s + 4 * lg;
            float o[4];
#pragma unroll
            for (int e = 0; e < 4; ++e) { const int t = tq + e; const float t01 = t < SEQ ? (float)t * (1.f / (SEQ - 1)) : (float)(t - SEQ) * (1.f / (CTXL - 1)); o[e] = acc[e] * __expf(-t01 * delta); }
            u32x2 w; w.x = pkh(o[0], o[1]); w.y = pkh(o[2], o[3]);
            *(LAS u32x2*)(stg + li * 72 + 16 * s + 4 * lg) = w;
        }
        LDS_WAIT(); asm volatile("" ::: "memory");
#pragma unroll
        for (int i = 0; i < 2; ++i) { const int chl = (lane >> 3) + 8 * i, seg = lane & 7;
            const u32x4 v = *(const LAS u32x4*)(stg + chl * 72 + 8 * seg);
            *(u32x4*)(FILT + (size_t)(ch0 + chl) * FILT_T + t0 + 8 * seg) = v; }
        LDS_WAIT(); asm volatile("" ::: "memory");
    }
}

__device__ __forceinline__ void shw_tasks(Frame& F) {
    LOCAL_IDS();
    const int gw = F.vcu * NWAVES + wave, NGW = F.G * NWAVES;
    const float* MOD = (const float*)(F.ws + WS_MOD); float* SHW = (float*)(F.ws + WS_SHW);
    for (int n = gw; n < 5632 + 3072 + 5632; n += NGW) {
        const f16* wrow; const float* sh; float* dst; int N;
        if (n < 5632) { wrow = (const f16*)(F.ws + WS_WGU0) + (size_t)n * 1024; sh = MOD + 3072; dst = SHW + n; N = 5632; }
        else if (n < 5632 + 3072) { const int j = n - 5632; wrow = (const f16*)(F.ws + WS_WQKV) + (size_t)j * 1024; sh = MOD + 3 * 6144; dst = SHW + 3 * 5632 + j; N = 3072; }
        else { const int j = n - 5632 - 3072; wrow = (const f16*)(F.ws + WS_WGU1) + (size_t)j * 1024; sh = MOD + 3 * 6144 + 3072; dst = SHW + 3 * 5632 + 3 * 3072 + j; N = 5632; }
        const f16x8 w0 = *(const f16x8*)(wrow + 16 * lane), w1 = *(const f16x8*)(wrow + 16 * lane + 8);
        float a[3];
#pragma unroll
        for (int r = 0; r < 3; ++r) { const float* sp = sh + r * 6144 + 16 * lane; float acc = 0.f;
#pragma unroll
            for (int e = 0; e < 8; ++e) acc += sp[e] * (float)w0[e] + sp[8 + e] * (float)w1[e];
            a[r] = wave_sum(acc); }
        if (lane == 0) { dst[0] = a[0]; dst[N] = a[1]; dst[2 * N] = a[2]; }
    }
}

__device__ __forceinline__ void cm_frag(f16* T, int ld, int col, int row, const f32x4 v) { u32x2 w; w.x = pkh(v[0], v[1]); w.y = pkh(v[2], v[3]); *(u32x2*)(T + (size_t)col * ld + row) = w; }
struct ResidP { const float* baseL; const float* baseC; float* dstL; float* dstC; const float* gate; f16* An; const float* gamma; const float* scale; float* ssq; };
template <bool NEXT> __device__ __forceinline__ float resid_frag(const ResidP& P, int row, int col, const f32x4 acc) {
    const bool lat = row < MLAT; const int rmod = lat ? (row >> 13) : 2;
    const size_t ro = (lat ? (size_t)row : (size_t)(row - MLAT)) * DM + col;
    const f32x4 b = *(const f32x4*)((lat ? P.baseL : P.baseC) + ro), gg = *(const f32x4*)(P.gate + rmod * 6144 + col);
    const f32x4 hn = b + gg * acc;
    *(f32x4*)((lat ? P.dstL : P.dstC) + ro) = hn;
    if (!NEXT) return 0.f;
    const f32x4 ga = *(const f32x4*)(P.gamma + col), sc = *(const f32x4*)(P.scale + rmod * 6144 + col);
    const f32x4 a = hn * ga * (sc + 1.f);
    u32x2 w; w.x = pkh(a[0], a[1]); w.y = pkh(a[2], a[3]); *(u32x2*)(P.An + (size_t)row * DM + col) = w;
    return (hn[0] * hn[0] + hn[1] * hn[1]) + (hn[2] * hn[2] + hn[3] * hn[3]);
}
template <bool NEXT> struct EpiResid {
    ResidP P;
    __device__ __forceinline__ void operator()(const f32x4 (&acc)[2][2][4][2], const pg8::Unit& u, int wr, int wc, int fr, int fq) const {
#pragma unroll
        for (int ai = 0; ai < 2; ++ai)
#pragma unroll
            for (int m = 0; m < 4; ++m) { const int row = u.pm * 256 + ai * 128 + wr * 64 + m * 16 + fr;
                float sq = 0.f;
#pragma unroll
                for (int bj = 0; bj < 2; ++bj)
#pragma unroll
                    for (int n = 0; n < 2; ++n) sq += resid_frag<NEXT>(P, row, u.pn * 256 + bj * 128 + wc * 32 + n * 16 + 4 * fq, acc[ai][bj][m][n]);
                if (NEXT) { sq += __shfl_xor(sq, 16); sq += __shfl_xor(sq, 32); if (fq == 0) atomicAdd(P.ssq + row, sq); } }
    }
};
struct EpiCM {
    f16* T; int ld;
    __device__ __forceinline__ void operator()(const f32x4 (&acc)[2][2][4][2], const pg8::Unit& u, int wr, int wc, int fr, int fq) const {
#pragma unroll
        for (int ai = 0; ai < 2; ++ai)
#pragma unroll
            for (int m = 0; m < 4; ++m) { const int row = u.pm * 256 + ai * 128 + wr * 64 + m * 16 + 4 * fq;
#pragma unroll
                for (int bj = 0; bj < 2; ++bj)
#pragma unroll
                    for (int n = 0; n < 2; ++n) cm_frag(T, ld, u.pn * 256 + bj * 128 + wc * 32 + n * 16 + fr, row, acc[ai][bj][m][n]); }
    }
};
struct GuP { f16* ACT; const float* ssq; const float* shw; };
__device__ __forceinline__ void gu_frag(const GuP& P, int row, int hcol, int gcol, const f32x4 ga, const f32x4 ua, float rstd, int rmod) {
    const f32x4 g = ga * rstd + *(const f32x4*)(P.shw + rmod * 5632 + gcol), up = ua * rstd + *(const f32x4*)(P.shw + rmod * 5632 + gcol + 128);
    float o[4];
#pragma unroll
    for (int e = 0; e < 4; ++e) o[e] = g[e] * __builtin_amdgcn_rcpf(1.f + __builtin_amdgcn_exp2f(-LOG2E * g[e])) * up[e];
    u32x2 w; w.x = pkh(o[0], o[1]); w.y = pkh(o[2], o[3]); *(u32x2*)(P.ACT + (size_t)row * DFF + hcol) = w;
}
struct EpiGU {
    GuP P;
    __device__ __forceinline__ void operator()(const f32x4 (&acc)[2][2][4][2], const pg8::Unit& u, int wr, int wc, int fr, int fq) const {
#pragma unroll
        for (int ai = 0; ai < 2; ++ai)
#pragma unroll
            for (int m = 0; m < 4; ++m) { const int row = u.pm * 256 + ai * 128 + wr * 64 + m * 16 + fr;
                const int rmod = row < MLAT ? (row >> 13) : 2; const float rstd = 1.f / sqrtf(P.ssq[row] * (1.f / DM) + RMS_EPS);
#pragma unroll
                for (int n = 0; n < 2; ++n) gu_frag(P, row, u.pn * 128 + wc * 32 + n * 16 + 4 * fq, u.pn * 256 + wc * 32 + n * 16 + 4 * fq, acc[ai][0][m][n], acc[ai][1][m][n], rstd, rmod); }
    }
};
struct QkvP { f16* Q; f16* KC; float qscale; const float* ssq; const float* shw; };
__device__ __forceinline__ void qkv_frag(const QkvP& P, int row, int c, const f32x4 acc, float rstd) {
    const bool lat = row < MLAT; const int which = c >> 10, col = c & 1023, h = col >> 6, d = col & 63;
    const int b = lat ? (row >> 13) : ((row - MLAT) >> 8), t = lat ? (row & 8191) : ((row - MLAT) & 255), rmod = lat ? b : 2;
    f16* dst = lat ? P.Q + (size_t)which * (16u << 20) + (((size_t)(b * NHEAD + h) * SEQ + t) * HD + d)
                   : P.KC + (size_t)(which > 0 ? which - 1 : 0) * (512u << 10) + (((size_t)(b * NHEAD + h) * CTXL + t) * HD + d);
    const float sc = which == 0 ? P.qscale : 1.f;
    const f32x4 v = (acc * rstd + *(const f32x4*)(P.shw + rmod * 3072 + c)) * sc; u32x2 w; w.x = pkh(v[0], v[1]); w.y = pkh(v[2], v[3]); *(u32x2*)dst = w;
}
struct EpiQKV {
    QkvP P;
    __device__ __forceinline__ void operator()(const f32x4 (&acc)[2][2][4][2], const pg8::Unit& u, int wr, int wc, int fr, int fq) const {
#pragma unroll
        for (int ai = 0; ai < 2; ++ai)
#pragma unroll
            for (int m = 0; m < 4; ++m) { const int row = u.pm * 256 + ai * 128 + wr * 64 + m * 16 + fr;
                const float rstd = 1.f / sqrtf(P.ssq[row] * (1.f / DM) + RMS_EPS);
#pragma unroll
                for (int bj = 0; bj < 2; ++bj)
#pragma unroll
                    for (int n = 0; n < 2; ++n) qkv_frag(P, row, u.pn * 256 + bj * 128 + wc * 32 + n * 16 + 4 * fq, acc[ai][bj][m][n], rstd); }
    }
};

__device__ __forceinline__ unsigned ctx_slot(int r, int c) { return (unsigned)(r * 512 + (((c & 16) | ((c & 15) ^ (r & 15))) << 4)); }
template <bool SWAPT> __device__ __forceinline__ void ctx_tile_mm(LAS unsigned char* lds, const f16* a0, const f16* blo, const f16* bhi, int K, int tid, int wr, int rb0, int rb1, int fr, int fq, f32x4& c0, f32x4& c1) {
    c0 = (f32x4){0.f, 0.f, 0.f, 0.f}; c1 = c0;
    const int sr = tid >> 5, sc = tid & 31;
    u32x4 ra[4], rb[4];
    const int nch = K >> 8;
#define CTX_LD(kc) do { _Pragma("unroll") for (int i = 0; i < 4; ++i) { const int r = sr + 16 * i; ra[i] = *(const u32x4*)(a0 + (size_t)r * K + (kc) * 256 + 8 * sc); \
        rb[i] = *(const u32x4*)((r < 32 ? blo + (size_t)r * K : bhi + (size_t)(r - 32) * K) + (kc) * 256 + 8 * sc); } } while (0)
#define CTX_ST(buf) do { _Pragma("unroll") for (int i = 0; i < 4; ++i) { const int r = sr + 16 * i; *(LAS u32x4*)(lds + (buf) * 65536 + ctx_slot(r, sc)) = ra[i]; *(LAS u32x4*)(lds + (buf) * 65536 + 32768 + ctx_slot(r, sc)) = rb[i]; } } while (0)
    __syncthreads();
    CTX_LD(0); CTX_ST(0);
    __syncthreads();
    for (int kc = 0; kc < nch; ++kc) {
        const int buf = kc & 1;
        if (kc + 1 < nch) CTX_LD(kc + 1);
#pragma unroll
        for (int j = 0; j < 8; ++j) {
            const f16x8 a = *(const LAS f16x8*)(lds + buf * 65536 + ctx_slot(16 * wr + fr, 4 * j + fq));
            const f16x8 b0 = *(const LAS f16x8*)(lds + buf * 65536 + 32768 + ctx_slot(rb0 + fr, 4 * j + fq));
            const f16x8 b1 = *(const LAS f16x8*)(lds + buf * 65536 + 32768 + ctx_slot(rb1 + fr, 4 * j + fq));
            if (SWAPT) { c0 = __builtin_amdgcn_mfma_f32_16x16x32_f16(a, b0, c0, 0, 0, 0); c1 = __builtin_amdgcn_mfma_f32_16x16x32_f16(a, b1, c1, 0, 0, 0); }
            else { c0 = __builtin_amdgcn_mfma_f32_16x16x32_f16(b0, a, c0, 0, 0, 0); c1 = __builtin_amdgcn_mfma_f32_16x16x32_f16(b1, a, c1, 0, 0, 0); }
        }
        if (kc + 1 < nch) { CTX_ST(buf ^ 1); }
        __syncthreads();
    }
#undef CTX_LD
#undef CTX_ST
}
#define CTX_TILE_SETUP(NT) LOCAL_IDS(); const int fr = lane & 15, fq = lane >> 4, wr = wave >> 1, wc = wave & 1; (void)fq; \
    for (int t = F.vcu; t < 8 * (NT); t += F.G) { const int tm = t / (NT), tn = t % (NT); const int row0 = MLAT + tm * 64, row = row0 + wr * 16;
__device__ __forceinline__ void ctx_inproj(Frame& F) {
    const f16* U = (const f16*)(F.ws + WS_U); const f16* W = (const f16*)(F.ws + WS_WIN); f16* PT = (f16*)(F.ws + WS_PT);
    CTX_TILE_SETUP(32)
        const int col = tn * 64 + wc * 32; f32x4 c0, c1;
        ctx_tile_mm<true>(F.lds, U + (size_t)row0 * DM, W + (size_t)(tn * 64) * DM, W + (size_t)(tn * 64 + 32) * DM, DM, tid, wr, wc * 32, wc * 32 + 16, fr, fq, c0, c1);
        cm_frag(PT, PT_LD, col + fr, row + 4 * fq, c0); cm_frag(PT, PT_LD, col + 16 + fr, row + 4 * fq, c1);
    }
}
template <bool NEXT> __device__ __forceinline__ void ctx_resid(Frame& F, const f16* A, int K, const f16* W, const ResidP& P) {
    CTX_TILE_SETUP(16)
        const int col = tn * 64 + wc * 32; f32x4 c0, c1;
        ctx_tile_mm<false>(F.lds, A + (size_t)row0 * K, W + (size_t)(tn * 64) * K, W + (size_t)(tn * 64 + 32) * K, K, tid, wr, wc * 32, wc * 32 + 16, fr, fq, c0, c1);
        float sq = resid_frag<NEXT>(P, row + fr, col + 4 * fq, c0) + resid_frag<NEXT>(P, row + fr, col + 16 + 4 * fq, c1);
        if (NEXT) { sq += __shfl_xor(sq, 16); sq += __shfl_xor(sq, 32); if (fq == 0) atomicAdd(P.ssq + row + fr, sq); }
    }
}
__device__ __forceinline__ void ctx_gu(Frame& F, const f16* A, const f16* W, const GuP& P) {
    CTX_TILE_SETUP(88)
        const int ht = tn * 32, gt = (ht >> 7) * 256 + (ht & 127); f32x4 c0, c1;
        ctx_tile_mm<false>(F.lds, A + (size_t)row0 * DM, W + (size_t)gt * DM, W + (size_t)(gt + 128) * DM, DM, tid, wr, wc * 16, 32 + wc * 16, fr, fq, c0, c1);
        const float rstd = 1.f / sqrtf(P.ssq[row + fr] * (1.f / DM) + RMS_EPS);
        gu_frag(P, row + fr, ht + wc * 16 + 4 * fq, gt + wc * 16 + 4 * fq, c0, c1, rstd, 2);
    }
}
__device__ __forceinline__ void ctx_kv(Frame& F, const f16* A, const f16* W, const QkvP& P) {
    CTX_TILE_SETUP(32)
        const int col = 1024 + tn * 64 + wc * 32; f32x4 c0, c1;
        ctx_tile_mm<false>(F.lds, A + (size_t)row0 * DM, W + (size_t)(1024 + tn * 64) * DM, W + (size_t)(1024 + tn * 64 + 32) * DM, DM, tid, wr, wc * 32, wc * 32 + 16, fr, fq, c0, c1);
        const float rstd = 1.f / sqrtf(P.ssq[row + fr] * (1.f / DM) + RMS_EPS);
        qkv_frag(P, row + fr, col + 4 * fq, c0, rstd); qkv_frag(P, row + fr, col + 16 + 4 * fq, c1, rstd);
    }
}

__device__ constexpr float C32T[16] = {1.f, 0.98078528040323f, 0.92387953251129f, 0.83146961230255f, 0.70710678118655f, 0.55557023301960f, 0.38268343236509f, 0.19509032201613f,
                                       0.f, -0.19509032201613f, -0.38268343236509f, -0.55557023301960f, -0.70710678118655f, -0.83146961230255f, -0.92387953251129f, -0.98078528040323f};
__device__ constexpr float S32T[16] = {0.f, 0.19509032201613f, 0.38268343236509f, 0.55557023301960f, 0.70710678118655f, 0.83146961230255f, 0.92387953251129f, 0.98078528040323f,
                                       1.f, 0.98078528040323f, 0.92387953251129f, 0.83146961230255f, 0.70710678118655f, 0.55557023301960f, 0.38268343236509f, 0.19509032201613f};
__device__ constexpr int BR5[32] = {0,16,8,24,4,20,12,28,2,18,10,26,6,22,14,30,1,17,9,25,5,21,13,29,3,19,11,27,7,23,15,31};
__device__ constexpr int BR4[16] = {0,8,4,12,2,10,6,14,1,9,5,13,3,11,7,15};
__device__ constexpr int BR3[8] = {0,4,2,6,1,5,3,7};
__device__ __forceinline__ constexpr int brev(int i, int bits) { return bits == 5 ? BR5[i] : (bits == 4 ? BR4[i] : BR3[i]); }
template <int R> __device__ __forceinline__ void dif_fwd(float (&re)[R], float (&im)[R]) {
    constexpr int LG = R == 32 ? 5 : (R == 16 ? 4 : (R == 8 ? 3 : (R == 4 ? 2 : 1)));
#pragma unroll
    for (int st = 0; st < LG; ++st) {
        const int m = R >> st, hm = m >> 1, ts = 32 / m;
#pragma unroll
        for (int b = 0; b < R; b += m)
#pragma unroll
            for (int j = 0; j < hm; ++j) {
                const int i0 = b + j, i1 = b + j + hm, tw = j * ts;
                const float ar = re[i0], ai = im[i0], cr = re[i1], ci = im[i1];
                re[i0] = ar + cr; im[i0] = ai + ci;
                const float dr = ar - cr, di = ai - ci;
                if (tw == 0) { re[i1] = dr; im[i1] = di; }
                else if (tw == 8) { re[i1] = di; im[i1] = -dr; }
                else { const float c = C32T[tw], s = S32T[tw]; re[i1] = dr * c + di * s; im[i1] = di * c - dr * s; }
            }
    }
}
template <int R> __device__ __forceinline__ void dit_inv(float (&re)[R], float (&im)[R]) {
    constexpr int LG = R == 32 ? 5 : (R == 16 ? 4 : (R == 8 ? 3 : (R == 4 ? 2 : 1)));
#pragma unroll
    for (int st = LG - 1; st >= 0; --st) {
        const int m = R >> st, hm = m >> 1, ts = 32 / m;
#pragma unroll
        for (int b = 0; b < R; b += m)
#pragma unroll
            for (int j = 0; j < hm; ++j) {
                const int i0 = b + j, i1 = b + j + hm, tw = j * ts;
                const float ar = re[i0], ai = im[i0], cr = re[i1], ci = im[i1];
                float tr, ti;
                if (tw == 0) { tr = cr; ti = ci; }
                else if (tw == 8) { tr = -ci; ti = cr; }
                else { const float c = C32T[tw], s = S32T[tw]; tr = cr * c - ci * s; ti = ci * c + cr * s; }
                re[i0] = ar + tr; im[i0] = ai + ti; re[i1] = ar - tr; im[i1] = ai - ti;
            }
    }
}
__device__ __forceinline__ int fpad(int i) { return i + (i >> 5); }
__device__ __forceinline__ void tw_fwd(float& x, float& y, float rev) { const float c = __builtin_amdgcn_cosf(rev), s = __builtin_amdgcn_sinf(rev); const float a = x * c + y * s, b = y * c - x * s; x = a; y = b; }
__device__ __forceinline__ void tw_inv(float& x, float& y, float rev) { const float c = __builtin_amdgcn_cosf(rev), s = __builtin_amdgcn_sinf(rev); const float a = x * c - y * s, b = y * c + x * s; x = a; y = b; }

template <int NB, bool REVP, bool FWD> __device__ __forceinline__ void tw_tree(float (&re)[1 << NB], float (&im)[1 << NB], float rev1, float rev0 = 0.f, bool has0 = false) {
    float wc[NB], ws[NB];
#pragma unroll
    for (int i = 0; i < NB; ++i) { const float r = __builtin_amdgcn_fractf(rev1 * (float)(1 << i)); wc[i] = __builtin_amdgcn_cosf(r); ws[i] = FWD ? -__builtin_amdgcn_sinf(r) : __builtin_amdgcn_sinf(r); }
    float c0 = 1.f, s0 = 0.f;
    if (has0) { const float r = __builtin_amdgcn_fractf(rev0); c0 = __builtin_amdgcn_cosf(r); s0 = FWD ? -__builtin_amdgcn_sinf(r) : __builtin_amdgcn_sinf(r); }
    float pc[NB + 1], ps[NB + 1];
    pc[0] = c0; ps[0] = s0;
#pragma unroll
    for (int p = 0; p < (1 << NB); ++p) {
#pragma unroll
        for (int lvl = 0; lvl < NB; ++lvl) {
            const int b = NB - 1 - lvl;
            if ((p & ((1 << b) - 1)) == 0) {
                const int kb = REVP ? (NB - 1 - b) : b;
                if ((p >> b) & 1) { pc[lvl + 1] = pc[lvl] * wc[kb] - ps[lvl] * ws[kb]; ps[lvl + 1] = pc[lvl] * ws[kb] + ps[lvl] * wc[kb]; }
                else { pc[lvl + 1] = pc[lvl]; ps[lvl + 1] = ps[lvl]; }
            }
        }
        if (p != 0 || has0) { const float x = re[p], y = im[p]; re[p] = x * pc[NB] - y * ps[NB]; im[p] = x * ps[NB] + y * pc[NB]; }
    }
}

__device__ __forceinline__ void fft_s2_fwd(LAS f32x2* buf, int tid) {
    asm volatile("" : "+v"(tid));
    const int kk = tid >> 5, n3 = tid & 31;
    LAS f32x2* pb = buf + fpad(kk * 1024 + n3);
    float re[32], im[32];
#pragma unroll
    for (int n2 = 0; n2 < 32; ++n2) { const f32x2 v = pb[33 * n2]; re[n2] = v.x; im[n2] = v.y; }
    dif_fwd<32>(re, im);
    tw_tree<5, true, true>(re, im, (float)n3 * (1.f / 1024.f));
#pragma unroll
    for (int p = 0; p < 32; ++p) pb[33 * brev(p, 5)] = (f32x2){re[p], im[p]};
}
__device__ __forceinline__ void fft_s2_inv(LAS f32x2* buf, int tid) {
    asm volatile("" : "+v"(tid));
    const int k1 = tid >> 5, n3 = tid & 31;
    LAS f32x2* pb = buf + fpad(k1 * 1024 + n3);
    float re[32], im[32];
#pragma unroll
    for (int p = 0; p < 32; ++p) { const f32x2 v = pb[33 * brev(p, 5)]; re[p] = v.x; im[p] = v.y; }
    dit_inv<32>(re, im);
    tw_tree<5, false, false>(re, im, (float)k1 * (1.f / 512.f), (float)(n3 * k1) * (1.f / 16384.f), true);
#pragma unroll
    for (int n2 = 0; n2 < 32; ++n2) pb[33 * n2] = (f32x2){re[n2], im[n2]};
}
__device__ __forceinline__ void fft_s3_conv(LAS f32x2* buf, int tid, const unsigned* H) {
    asm volatile("" : "+v"(tid));
    const int k2 = tid & 31;
    LAS f32x2* pb = buf + fpad((tid >> 5) * 1024 + k2 * 32);
    const unsigned* hp = H + tid;
    float re[32], im[32];
#pragma unroll
    for (int n3 = 0; n3 < 32; ++n3) { const f32x2 v = pb[n3]; re[n3] = v.x; im[n3] = v.y; }
    dif_fwd<32>(re, im);
#pragma unroll
    for (int p = 0; p < 32; ++p) { const f16x2 hh = __builtin_bit_cast(f16x2, hp[p * 512]); const float hx = (float)hh[0] * (1.f / 16384.f), hy = (float)hh[1] * (1.f / 16384.f);
        const float a = re[p] * hx - im[p] * hy, b = re[p] * hy + im[p] * hx; re[p] = a; im[p] = b; }
    dit_inv<32>(re, im);
    tw_tree<5, false, false>(re, im, (float)k2 * (1.f / 1024.f));
#pragma unroll
    for (int n3 = 0; n3 < 32; ++n3) pb[n3] = (f32x2){re[n3], im[n3]};
}

__device__ __forceinline__ void hyena_task(Frame& F, int c) {
    LAS f32x2* buf = (LAS f32x2*)F.lds;
    LAS float* scr = (LAS float*)(F.lds + SCR_OFF);
    int tid = threadIdx.x; asm volatile("" : "+v"(tid));
    const int lane = tid & 63, wave = __builtin_amdgcn_readfirstlane(tid >> 6);
    u16* PT = (u16*)(F.ws + WS_PT);
    const u16* FILT = (const u16*)(F.ws + WS_FILT);
    unsigned* HS = (unsigned*)(F.ws + WS_HS) + (size_t)blockIdx.x * 32768;
    unsigned* XS = (unsigned*)(F.ws + WS_XS) + (size_t)blockIdx.x * (32 * 512);
    const float* cw = F.in[13]; const float* cb = F.in[14]; const float* skip = F.in[21];
    {
        const u16* f1 = FILT + (size_t)(c) * FILT_T; const u16* f2 = FILT + (size_t)(512 + c) * FILT_T;
        const u16* b1 = FILT + (size_t)(1024 + c) * FILT_T; const u16* b2 = FILT + (size_t)(1536 + c) * FILT_T;
        float a1 = 0.f, a2 = 0.f;
        if (tid == 0) { a1 = fabsf(h2f(b1[0])); a2 = fabsf(h2f(b2[0])); }
#pragma unroll
        for (int jj = 0; jj < 2; ++jj) {
            __builtin_amdgcn_sched_barrier(0); int j = tid + 512 * jj; asm volatile("" : "+v"(j));
            float re[16], im[16];
#pragma unroll
            for (int n1 = 0; n1 < 16; ++n1) { const int n = n1 * 1024 + j;
                if (n1 < 8) { re[n1] = h2f(f1[n]); im[n1] = h2f(f2[n]); }
                else if (n == 8192) { re[n1] = 0.f; im[n1] = 0.f; }
                else { re[n1] = h2f(b1[16384 - n]); im[n1] = h2f(b2[16384 - n]); }
                a1 += fabsf(re[n1]); a2 += fabsf(im[n1]); }
            dif_fwd<16>(re, im);
#pragma unroll
            for (int p = 0; p < 1; ++p) tw_tree<4, true, true>(re, im, (float)j * (1.f / 16384.f));
#pragma unroll
        for (int p = 0; p < 16; ++p) (buf + fpad(j))[1056 * brev(p, 4)] = (f32x2){re[p], im[p]};
        }
        a1 = wave_sum(a1); a2 = wave_sum(a2);
        if (lane == 0) { scr[wave * 2] = a1; scr[wave * 2 + 1] = a2; }
        __syncthreads();
        float n1s = 0.f, n2s = 0.f;
#pragma unroll
        for (int w = 0; w < 8; ++w) { n1s += scr[2 * w]; n2s += scr[2 * w + 1]; }
        const float inv1 = 0.5f / n1s, inv2 = 0.5f / n2s;
        const float ska = skip[c], skb = skip[512 + c];
        fft_s2_fwd(buf, tid);
        __syncthreads();
        {
            const int k1 = tid >> 5, k2 = tid & 31;
            LAS f32x2* pb = buf + fpad(k1 * 1024 + k2 * 32);
            float re[32], im[32];
#pragma unroll
            for (int n3 = 0; n3 < 32; ++n3) { const f32x2 v = pb[n3]; re[n3] = v.x; im[n3] = v.y; }
            dif_fwd<32>(re, im);
#pragma unroll
            for (int p = 0; p < 32; ++p) pb[brev(p, 5)] = (f32x2){re[p], im[p]};
            __syncthreads();
            unsigned* hp = HS + tid;
#pragma unroll
            for (int p = 0; p < 32; ++p) {
                const int k = k1 + 16 * k2 + 512 * brev(p, 5), km = (16384 - k) & 16383;
                const f32x2 zm = buf[fpad((km & 15) * 1024 + ((km >> 4) & 31) * 32 + (km >> 9))];
                const float sr = re[p] + zm.x, si = im[p] - zm.y;
                const float dr = re[p] - zm.x, di = im[p] + zm.y;
                hp[p * 512] = pkh(sr * inv1 + ska, si * inv1);
                hp[16384 + p * 512] = pkh(di * inv2 + skb, -dr * inv2);
                if ((p & 3) == 3) __builtin_amdgcn_sched_barrier(0);
            }
        }
        __syncthreads();
    }
    unsigned vpk[16];
    {
        LAS u16* raw = (LAS u16*)F.lds;
#pragma unroll
        for (int w = 0; w < 3; ++w) {
            const u16* row = PT + (size_t)(512 + 512 * w + c) * PT_LD;
#pragma unroll
            for (int i = 0; i < 4; ++i) { const int e = (i * 512 + tid) * 8;
                *(LAS u32x4*)(raw + w * 16384 + e) = *(const u32x4*)(row + e); }
        }
        __syncthreads();
#pragma unroll
        for (int w = 0; w < 3; ++w) {
            const int ch = 512 * w + c;
            const float w0 = cw[ch], w1 = cw[1536 + ch], w2 = cw[3072 + ch], bias = cb[ch];
#pragma unroll
            for (int idx = 0; idx < 16; ++idx) { const int n = (idx & 7) * 1024 + tid + 512 * (idx >> 3);
                const LAS u16* p0 = raw + w * 16384 + n; const LAS u16* p1 = p0 + SEQ;
                const float a0 = n > 0 ? h2f(p0[-1]) : 0.f, a1 = h2f(p0[0]), a2 = n < SEQ - 1 ? h2f(p0[1]) : 0.f;
                const float c0 = n > 0 ? h2f(p1[-1]) : 0.f, c1 = h2f(p1[0]), c2 = n < SEQ - 1 ? h2f(p1[1]) : 0.f;
                const unsigned pk = pkh(w0 * a0 + w1 * a1 + w2 * a2 + bias, w0 * c0 + w1 * c1 + w2 * c2 + bias);
                if (w < 2) XS[(w * 16 + idx) * 512 + tid] = pk; else vpk[idx] = pk;
                if ((idx & 3) == 3) __builtin_amdgcn_sched_barrier(0); }
        }
        __syncthreads();
    }
#define XS_LD(w, idx, lo, hi) do { const f16x2 _v = __builtin_bit_cast(f16x2, XS[((w) * 16 + (idx)) * 512 + tid]); lo = (float)_v[0]; hi = (float)_v[1]; } while (0)
#pragma unroll
    for (int jj = 0; jj < 2; ++jj) {
        __builtin_amdgcn_sched_barrier(0); int j = tid + 512 * jj; asm volatile("" : "+v"(j));
        float re[16], im[16];
#pragma unroll
        for (int n1 = 0; n1 < 8; ++n1) { const f16x2 v = __builtin_bit_cast(f16x2, vpk[jj * 8 + n1]); re[n1] = (float)v[0]; im[n1] = (float)v[1]; }
#pragma unroll
        for (int n1 = 8; n1 < 16; ++n1) { re[n1] = 0.f; im[n1] = 0.f; }
        dif_fwd<16>(re, im);
#pragma unroll
        for (int p = 0; p < 1; ++p) tw_tree<4, true, true>(re, im, (float)j * (1.f / 16384.f));
#pragma unroll
        for (int p = 0; p < 16; ++p) (buf + fpad(j))[1056 * brev(p, 4)] = (f32x2){re[p], im[p]};
    }
    __syncthreads();
    fft_s2_fwd(buf, tid); __syncthreads();
    fft_s3_conv(buf, tid, HS); __syncthreads();
    fft_s2_inv(buf, tid); __syncthreads();
#pragma unroll
    for (int jj = 0; jj < 2; ++jj) {
        __builtin_amdgcn_sched_barrier(0); int j = tid + 512 * jj; asm volatile("" : "+v"(j));
        float re[16], im[16];
#pragma unroll
        for (int p = 0; p < 16; ++p) { const f32x2 v = (buf + fpad(j))[1056 * brev(p, 4)]; re[p] = v.x; im[p] = v.y; }
        dit_inv<16>(re, im);
#pragma unroll
        for (int n1 = 0; n1 < 8; ++n1) { float x0, x1; XS_LD(0, jj * 8 + n1, x0, x1); re[n1] *= x0; im[n1] *= x1; }
#pragma unroll
        for (int n1 = 8; n1 < 16; ++n1) { re[n1] = 0.f; im[n1] = 0.f; }
        dif_fwd<16>(re, im);
#pragma unroll
        for (int p = 0; p < 1; ++p) tw_tree<4, true, true>(re, im, (float)j * (1.f / 16384.f));
#pragma unroll
        for (int p = 0; p < 16; ++p) (buf + fpad(j))[1056 * brev(p, 4)] = (f32x2){re[p], im[p]};
    }
    __syncthreads();
    fft_s2_fwd(buf, tid); __syncthreads();
    fft_s3_conv(buf, tid, HS + 16384); __syncthreads();
    fft_s2_inv(buf, tid); __syncthreads();
    u16* yrow = PT + (size_t)(512 + c) * PT_LD;
#pragma unroll
    for (int jj = 0; jj < 2; ++jj) {
        __builtin_amdgcn_sched_barrier(0); int j = tid + 512 * jj; asm volatile("" : "+v"(j));
        float re[16], im[16];
#pragma unroll
        for (int p = 0; p < 16; ++p) { const f32x2 v = (buf + fpad(j))[1056 * brev(p, 4)]; re[p] = v.x; im[p] = v.y; }
        dit_inv<16>(re, im);
#pragma unroll
        for (int n1 = 0; n1 < 8; ++n1) { float x0, x1; XS_LD(1, jj * 8 + n1, x0, x1);
            yrow[n1 * 1024 + j] = __builtin_bit_cast(u16, (f16)(x0 * re[n1])); yrow[SEQ + n1 * 1024 + j] = __builtin_bit_cast(u16, (f16)(x1 * im[n1])); }
    }
#undef XS_LD
    __syncthreads();
}

__device__ __forceinline__ void fourier_task(Frame& F, int task) {
    LAS f32x2* buf = (LAS f32x2*)F.lds;
    int tid = threadIdx.x; asm volatile("" : "+v"(tid));
    const int b = task >> 7, g = (task >> 5) & 3, q = task & 31;
    u16* PT = (u16*)(F.ws + WS_PT);
    const int mA[2] = {q, q == 0 ? 32 : 64 - q};
    const size_t tok0 = (size_t)b * SEQ;
#pragma unroll
    for (int f = 0; f < 2; ++f) {
        const u16* rA = PT + (size_t)(128 * g + mA[f]) * PT_LD + tok0; const u16* rB = PT + (size_t)(128 * g + 64 + mA[f]) * PT_LD + tok0;
        const float sg = (f == 0 && q == 0) ? 1.f : -1.f;
#pragma unroll
        for (int jj = 0; jj < 2; ++jj) {
            __builtin_amdgcn_sched_barrier(0); int j = tid + 512 * jj; asm volatile("" : "+v"(j));
            float re[8], im[8];
#pragma unroll
            for (int n1 = 0; n1 < 8; ++n1) { re[n1] = h2f(rA[n1 * 1024 + j]); im[n1] = sg * h2f(rB[n1 * 1024 + j]); }
            dif_fwd<8>(re, im);
#pragma unroll
            for (int p = 0; p < 1; ++p) tw_tree<3, true, true>(re, im, (float)j * (1.f / 8192.f));
#pragma unroll
            for (int p = 0; p < 8; ++p) (buf + fpad(j))[1056 * (f * 8 + brev(p, 3))] = (f32x2){re[p], im[p]};
        }
    }
    __syncthreads();
    fft_s2_fwd(buf, tid);
    __syncthreads();
    {
        const int kk = tid >> 5, k2 = tid & 31, f = kk >> 3, k1 = kk & 7;
        LAS f32x2* pb = buf + fpad(kk * 1024 + k2 * 32);
        float re[32], im[32];
#pragma unroll
        for (int n3 = 0; n3 < 32; ++n3) { const f32x2 v = pb[n3]; re[n3] = v.x; im[n3] = v.y; }
        dif_fwd<32>(re, im);
        __syncthreads();
        { LAS f32x2* pn = buf + fpad(f * 8192 + k1 + 8 * k2);
#pragma unroll
        for (int p = 0; p < 32; ++p) pn[264 * brev(p, 5)] = (f32x2){re[p], im[p]}; }
    }
    __syncthreads();
#pragma unroll
    for (int f = 0; f < 2; ++f) {
        const bool packed = (f == 0 && q == 0);
        const int m = mA[f];
        u16* o1 = PT + (size_t)(128 * g + (packed ? 0 : m)) * PT_LD + tok0;
        u16* o2 = PT + (size_t)(128 * g + (packed ? 64 : 128 - m)) * PT_LD + tok0;
        for (int l = tid; l < SEQ; l += 512) {
            const f32x2 a = buf[fpad(f * 8192 + l)], c = buf[fpad(f * 8192 + ((SEQ - l) & (SEQ - 1)))];
            const float y1 = packed ? 0.5f * (a.x + c.x) : a.x, y2 = packed ? 0.5f * (a.y + c.y) : c.x;
            o1[l] = __builtin_bit_cast(u16, (f16)y1); o2[l] = __builtin_bit_cast(u16, (f16)y2);
        }
    }
    __syncthreads();
}

__device__ __forceinline__ void fourier_ctx_task(Frame& F, int task) {
    LAS float* zr = (LAS float*)F.lds;
    LAS float* zi = zr + 512;
    LAS float* tc = zr + 1024;
    LAS float* ts = zr + 1280;
    LAS float* fr = zr + 1536;
    LAS float* fi = zr + 2048;
    int tid = threadIdx.x; asm volatile("" : "+v"(tid));
    const int f = tid >> 8, k = tid & 255;
    const int b = task >> 7, g = (task >> 5) & 3, q = task & 31;
    u16* PT = (u16*)(F.ws + WS_PT);
    const int m = f == 0 ? q : (q == 0 ? 32 : 64 - q);
    const bool packed = (f == 0 && q == 0);
    const size_t tok0 = (size_t)MLAT + (size_t)b * CTXL;
    const u16* rA = PT + (size_t)(128 * g + m) * PT_LD + tok0; const u16* rB = PT + (size_t)(128 * g + 64 + m) * PT_LD + tok0;
    zr[tid] = h2f(rA[k]); zi[tid] = (packed ? 1.f : -1.f) * h2f(rB[k]);
    if (tid < 256) { tc[tid] = cos_rev((float)tid * (1.f / 256.f)); ts[tid] = sin_rev((float)tid * (1.f / 256.f)); }
    __syncthreads();
    float ar = 0.f, ai = 0.f;
    for (int l = 0; l < 256; ++l) { const float x = zr[f * 256 + l], y = zi[f * 256 + l]; const int e = (k * l) & 255; const float c = tc[e], s = ts[e];
        ar += x * c + y * s; ai += y * c - x * s; }
    fr[tid] = ar; fi[tid] = ai;
    __syncthreads();
    const int km = f * 256 + ((256 - k) & 255);
    const float sc = 5.656854249492381f;
    const float y1 = packed ? 0.5f * (ar + fr[km]) : ar, y2 = packed ? 0.5f * (ai + fi[km]) : fr[km];
    u16* o1 = PT + (size_t)(128 * g + (packed ? 0 : m)) * PT_LD + tok0; u16* o2 = PT + (size_t)(128 * g + (packed ? 64 : 128 - m)) * PT_LD + tok0;
    o1[k] = __builtin_bit_cast(u16, (f16)(y1 * sc)); o2[k] = __builtin_bit_cast(u16, (f16)(y2 * sc));
    __syncthreads();
}
__device__ __forceinline__ void hyena_ctx_wave(Frame& F, int c, int b, int lane, LAS float* wl) {
    LAS float* hh = wl;
    LAS float* vv = wl + 1024;
    u16* PT = (u16*)(F.ws + WS_PT);
    const u16* FILT = (const u16*)(F.ws + WS_FILT);
    const float* cw = F.in[13]; const float* cb = F.in[14]; const float* skip = F.in[21];
    float n0 = 0.f, n1 = 0.f;
#pragma unroll
    for (int j = 0; j < 4; ++j) { const int t = lane + 64 * j;
        const float f0 = h2f(FILT[(size_t)(c) * FILT_T + SEQ + t]), f1 = h2f(FILT[(size_t)(512 + c) * FILT_T + SEQ + t]);
        const float g0 = h2f(FILT[(size_t)(1024 + c) * FILT_T + SEQ + t]), g1 = h2f(FILT[(size_t)(1536 + c) * FILT_T + SEQ + t]);
        hh[255 + t] = f0; hh[512 + 255 + t] = f1; if (t > 0) { hh[255 - t] = g0; hh[512 + 255 - t] = g1; }
        n0 += fabsf(f0) + fabsf(g0); n1 += fabsf(f1) + fabsf(g1); }
    if (lane == 0) { hh[511] = 0.f; hh[1023] = 0.f; }
    n0 = wave_sum(n0); n1 = wave_sum(n1);
    const float i0 = 1.f / n0, i1 = 1.f / n1;
    const size_t tokb = (size_t)MLAT + (size_t)b * CTXL;
    float x1[4], x2[4], v[4];
#pragma unroll
    for (int w = 0; w < 3; ++w) { const int ch = 512 * w + c; const u16* p = PT + (size_t)(512 + ch) * PT_LD + tokb + 4 * lane;
        const float w0 = cw[ch], w1 = cw[1536 + ch], w2 = cw[3072 + ch], bias = cb[ch];
        float a[6];
        a[0] = lane > 0 ? h2f(p[-1]) : 0.f; a[5] = lane < 63 ? h2f(p[4]) : 0.f;
#pragma unroll
        for (int j = 0; j < 4; ++j) a[1 + j] = h2f(p[j]);
#pragma unroll
        for (int j = 0; j < 4; ++j) { const float r = w0 * a[j] + w1 * a[j + 1] + w2 * a[j + 2] + bias; if (w == 0) x1[j] = r; else if (w == 1) x2[j] = r; else v[j] = r; } }
#pragma unroll
    for (int o = 0; o < 2; ++o) {
        *(LAS f32x4*)(vv + 4 * lane) = (f32x4){v[0], v[1], v[2], v[3]};
        LDS_WAIT(); asm volatile("" ::: "memory");
        float y0 = 0.f, y1 = 0.f, y2 = 0.f, y3 = 0.f;
        const LAS float* ho = hh + 512 * o + 255 + 4 * lane;
        float w0 = ho[0], w1 = ho[1], w2 = ho[2], w3 = ho[3];
#pragma unroll 8
        for (int s = 0; s < 256; ++s) { const float u = vv[s];
            y0 += u * w0; y1 += u * w1; y2 += u * w2; y3 += u * w3;
            w3 = w2; w2 = w1; w1 = w0; const int idx = 255 + 4 * lane - s - 1; w0 = idx >= 0 ? ho[-s - 1] : 0.f; }
        const float inv = o == 0 ? i0 : i1, sk = skip[o * 512 + c];
        v[0] = (o == 0 ? x1[0] : x2[0]) * (y0 * inv + sk * v[0]); v[1] = (o == 0 ? x1[1] : x2[1]) * (y1 * inv + sk * v[1]);
        v[2] = (o == 0 ? x1[2] : x2[2]) * (y2 * inv + sk * v[2]); v[3] = (o == 0 ? x1[3] : x2[3]) * (y3 * inv + sk * v[3]);
        LDS_WAIT(); asm volatile("" ::: "memory");
    }
    u32x2 w; w.x = pkh(v[0], v[1]); w.y = pkh(v[2], v[3]);
    *(u32x2*)(PT + (size_t)(512 + c) * PT_LD + tokb + 4 * lane) = w;
}
__device__ __forceinline__ void hyena_ctx_all(Frame& F) {
    LOCAL_IDS();
    if ((wave & 1) == 0) { LAS float* wl = (LAS float*)(F.lds + wave * 8192);
        for (int task = F.vcu + 256 * (wave >> 1); task < 1024; task += 4 * F.G) hyena_ctx_wave(F, task >> 1, task & 1, lane, wl); }
    __syncthreads();
}
#ifdef PROBE_P3
#define P3T(k, stmt) do { const unsigned long long t0_ = __builtin_amdgcn_s_memrealtime(); stmt; if (PROBE_P3 == (k)) F.pacc += __builtin_amdgcn_s_memrealtime() - t0_; } while (0)
#else
#define P3T(k, stmt) do { stmt; } while (0)
#endif
__device__ __forceinline__ void p3_fft(Frame& F) {
    P3T(1, for (int c = F.vcu; c < 512; c += F.G) hyena_task(F, c));
    P3T(2, for (int t = F.vcu; t < 256; t += F.G) fourier_task(F, t));
    P3T(3, for (int t = F.vcu; t < 256; t += F.G) fourier_ctx_task(F, t));
    P3T(4, hyena_ctx_all(F));
}

__device__ __forceinline__ void p4_transpose(Frame& F) {
    LOCAL_IDS();
    const int gw = F.vcu * NWAVES + wave, NGW = F.G * NWAVES;
    const u16* YT = (const u16*)(F.ws + WS_PT); u16* Y = (u16*)(F.ws + WS_Y);
    LAS u16* scr = (LAS u16*)(F.lds + wave * 16384);
    constexpr int NRB = MALL / 64;
    for (int it = gw; it < 16 * NRB; it += NGW) {
        const int cb = it / NRB, rb = it % NRB;
#pragma unroll
        for (int i = 0; i < 8; ++i) { const int ch = (lane >> 3) + 8 * i, seg = lane & 7;
            const u32x4 v = *(const u32x4*)(YT + (size_t)(cb * 64 + ch) * PT_LD + rb * 64 + 8 * seg);
            *(LAS u32x4*)(scr + ch * 72 + 8 * seg) = v; }
        LDS_WAIT(); asm volatile("" ::: "memory");
#pragma unroll
        for (int i = 0; i < 8; ++i) { const int tk = (lane >> 3) + 8 * i, seg = lane & 7;
            unsigned w[4];
#pragma unroll
            for (int e = 0; e < 4; ++e) { const unsigned lo = scr[(8 * seg + 2 * e) * 72 + tk], hi = scr[(8 * seg + 2 * e + 1) * 72 + tk]; w[e] = lo | (hi << 16); }
            *(u32x4*)(Y + (size_t)(rb * 64 + tk) * DM + cb * 64 + 8 * seg) = (u32x4){w[0], w[1], w[2], w[3]}; }
        LDS_WAIT(); asm volatile("" ::: "memory");
    }
}

constexpr int NA_KOFF = 0, NA_VOFF = 73728, NA_BIAS = 147456;
typedef short v4i16_t __attribute__((ext_vector_type(4)));
__device__ __forceinline__ f16x4 lds_tr(unsigned addr) { return __builtin_bit_cast(f16x4, __builtin_amdgcn_ds_read_tr16_b64_v4i16((LAS v4i16_t*)addr)); }
template <int NCH> __device__ __forceinline__ void na_ld(u32x4 (&r)[NCH], const f16* src, int nchunk, int tid) {
#pragma unroll
    for (int i = 0; i < NCH; ++i) { const int cidx = tid + 512 * i; const int cc = cidx < nchunk ? cidx : 0; r[i] = *(const u32x4*)(src + (size_t)cc * 8); }
}
template <int NCH, bool VSWZ> __device__ __forceinline__ void na_st(const u32x4 (&r)[NCH], unsigned ldsbase, int nchunk, int tid) {
#pragma unroll
    for (int i = 0; i < NCH; ++i) { const int cidx = tid + 512 * i; if (cidx < nchunk) { const int key = cidx >> 3, ch = cidx & 7;
        const int slot = VSWZ ? ((((ch >> 1) ^ ((key >> 1) & 3)) << 1) | (ch & 1)) : (ch ^ (key & 7));
        *(LAS u32x4*)(ldsbase + key * 128 + slot * 16) = r[i]; } }
}
__device__ __forceinline__ void p11_na(Frame& F) {
    LOCAL_IDS();
    const f16* Q = (const f16*)(F.ws + WS_Q); const f16* K = (const f16*)(F.ws + WS_K); const f16* V = (const f16*)(F.ws + WS_V);
    const f16* KC = (const f16*)(F.ws + WS_KC); const f16* VC = (const f16*)(F.ws + WS_VC); f16* O = (f16*)(F.ws + WS_O);
    const unsigned lds0 = (unsigned)(uintptr_t)F.lds;
    for (int it = F.vcu * 8; it < 2048; it += F.G * 8) {
        { const int h = (it >> 6) & 15; const float* src = F.in[24] + (size_t)h * 465; LAS float* tb = (LAS float*)(F.lds + NA_BIAS);
          __syncthreads();
          if (tid < 465) tb[tid] = src[tid] * LOG2E;
        }
        u32x4 kl[9];
        { const int bh = it >> 6, rp = it & 63, r0 = 2 * rp; const int rsA = r0 - 4 < 0 ? 0 : (r0 - 4 > 120 ? 120 : r0 - 4), rsB = r0 - 3 < 0 ? 0 : (r0 - 3 > 120 ? 120 : r0 - 3);
          const int nch = (8 + rsB - rsA) * 512;
          na_ld<9>(kl, K + ((size_t)bh * SEQ + rsA * 64) * HD, nch, tid); }
#pragma unroll 1
        for (int ii = 0; ii < 8; ++ii) {
            const int item = it + ii; if (item >= 2048) break;
            const int bh = item >> 6, rp = item & 63, b = bh >> 4, h = bh & 15;
            const int r0 = 2 * rp, r = r0 + (wave >> 2), chunk = wave & 3;
            const int rsA = r0 - 4 < 0 ? 0 : (r0 - 4 > 120 ? 120 : r0 - 4);
            const int rs = r - 4 < 0 ? 0 : (r - 4 > 120 ? 120 : r - 4);
            const int rsB = r0 + 1 - 4 < 0 ? 0 : (r0 + 1 - 4 > 120 ? 120 : r0 + 1 - 4);
            const int nrows = 8 + (rsB - rsA);
            __syncthreads();
            { u32x4 vl[9]; na_ld<9>(vl, V + ((size_t)bh * SEQ + rsA * 64) * HD, nrows * 512, tid);
              na_st<9, false>(kl, lds0 + NA_KOFF, nrows * 512, tid); na_st<9, true>(vl, lds0 + NA_VOFF, nrows * 512, tid); }
            asm volatile("" ::: "memory");
            u32x4 kc[4], vc[4];
            na_ld<4>(kc, KC + (size_t)bh * CTXL * HD, 2048, tid); na_ld<4>(vc, VC + (size_t)bh * CTXL * HD, 2048, tid);
            const int q = lane & 15, g = lane >> 4;
            const int kstart = chunk == 0 ? 0 : (chunk == 1 ? 8 : (chunk == 2 ? 24 : 32));
            const int off = chunk == 0 ? 15 : (chunk == 3 ? -1 : 7);
            const int ws = chunk == 0 ? (q > 8 ? q - 8 : 0) : (chunk == 3 ? (q + 8 < 16 ? q + 8 : 16) : q);
            const f16* Qp = Q + ((size_t)bh * SEQ + r * 64 + 16 * chunk + q) * HD + 8 * g;
            const f16x8 q0 = *(const f16x8*)Qp, q1 = *(const f16x8*)(Qp + 32);
            const int lr = rs - rsA;
            unsigned ka[2][2];
#pragma unroll
            for (int kb = 0; kb < 2; ++kb)
#pragma unroll
                for (int ks = 0; ks < 2; ++ks) { const int key = 64 * lr + kstart + 16 * kb + q; ka[kb][ks] = lds0 + NA_KOFF + key * 128 + (((4 * ks + g) ^ (key & 7)) << 4); }
            unsigned va[4];
            { const int qq = (lane & 15) >> 2, p = lane & 3; const int key = 64 * lr + kstart + 4 * g + qq;
#pragma unroll
              for (int db = 0; db < 4; ++db) va[db] = lds0 + NA_VOFF + key * 128 + ((db ^ ((key >> 1) & 3)) << 5) + 8 * p; }
            int bidx[2][4];
#pragma unroll
            for (int kb = 0; kb < 2; ++kb)
#pragma unroll
                for (int e = 0; e < 4; ++e) { const int kc_ = 16 * kb + 4 * g + e; const bool ok = kc_ >= ws && kc_ < ws + 16; const int dc = kc_ - q + off; bidx[kb][e] = ok ? ((rs - r + 7) * 31 + dc) : -1; }
            f32x4 o[4];
#pragma unroll
            for (int db = 0; db < 4; ++db) o[db] = (f32x4){0.f, 0.f, 0.f, 0.f};
            float m = -INFINITY, l = 0.f;
            const LAS float* rpb = (const LAS float*)(F.lds + NA_BIAS);
            __syncthreads();
#define NA_STEP(S0, S1, KA00, KA01, KA10, KA11, VOFF) do { \
                S0 = __builtin_amdgcn_mfma_f32_16x16x32_f16(*(const LAS f16x8*)(KA00), q0, S0, 0, 0, 0); \
                S0 = __builtin_amdgcn_mfma_f32_16x16x32_f16(*(const LAS f16x8*)(KA01), q1, S0, 0, 0, 0); \
                S1 = __builtin_amdgcn_mfma_f32_16x16x32_f16(*(const LAS f16x8*)(KA10), q0, S1, 0, 0, 0); \
                S1 = __builtin_amdgcn_mfma_f32_16x16x32_f16(*(const LAS f16x8*)(KA11), q1, S1, 0, 0, 0); \
                float mx_ = fmaxf(fmaxf(fmaxf(S0[0], S0[1]), fmaxf(S0[2], S0[3])), fmaxf(fmaxf(S1[0], S1[1]), fmaxf(S1[2], S1[3]))); \
                mx_ = fmaxf(mx_, __shfl_xor(mx_, 16)); mx_ = fmaxf(mx_, __shfl_xor(mx_, 32)); \
                const float mn_ = fmaxf(m, mx_); const float alpha_ = __builtin_amdgcn_exp2f(m - mn_); m = mn_; \
                f16x8 pf_; float ps_ = 0.f; \
                _Pragma("unroll") for (int e = 0; e < 4; ++e) { const float p0_ = __builtin_amdgcn_exp2f(S0[e] - mn_), p1_ = __builtin_amdgcn_exp2f(S1[e] - mn_); ps_ += p0_ + p1_; pf_[e] = (f16)p0_; pf_[4 + e] = (f16)p1_; } \
                l = l * alpha_ + ps_; \
                _Pragma("unroll") for (int db = 0; db < 4; ++db) { const f16x4 v0_ = lds_tr(va[db] + (VOFF)), v1_ = lds_tr(va[db] + (VOFF) + 2048); \
                    const f16x8 vv_ = {v0_[0], v0_[1], v0_[2], v0_[3], v1_[0], v1_[1], v1_[2], v1_[3]}; \
                    o[db] = __builtin_amdgcn_mfma_f32_16x16x32_f16(vv_, pf_, o[db] * alpha_, 0, 0, 0); } } while (0)
#pragma unroll 2
            for (int i = 0; i < 8; ++i) {
                f32x4 s0, s1;
#pragma unroll
                for (int e = 0; e < 4; ++e) { s0[e] = bidx[0][e] >= 0 ? rpb[bidx[0][e] + 31 * i] : -INFINITY; s1[e] = bidx[1][e] >= 0 ? rpb[bidx[1][e] + 31 * i] : -INFINITY; }
                NA_STEP(s0, s1, ka[0][0] + 8192 * i, ka[0][1] + 8192 * i, ka[1][0] + 8192 * i, ka[1][1] + 8192 * i, 8192 * i);
            }
            __syncthreads();
            na_st<4, false>(kc, lds0 + NA_KOFF, 2048, tid); na_st<4, true>(vc, lds0 + NA_VOFF, 2048, tid);
            asm volatile("" ::: "memory");
            if (ii + 1 < 8 && item + 1 < 2048) { const int it2 = item + 1, bh2 = it2 >> 6, rp2 = it2 & 63, r02 = 2 * rp2;
                const int rsA2 = r02 - 4 < 0 ? 0 : (r02 - 4 > 120 ? 120 : r02 - 4), rsB2 = r02 - 3 < 0 ? 0 : (r02 - 3 > 120 ? 120 : r02 - 3);
                const int nch2 = (8 + rsB2 - rsA2) * 512;
                na_ld<9>(kl, K + ((size_t)bh2 * SEQ + rsA2 * 64) * HD, nch2, tid); }
            unsigned kc2[2][2];
#pragma unroll
            for (int kb = 0; kb < 2; ++kb)
#pragma unroll
                for (int ks = 0; ks < 2; ++ks) { const int key = 16 * kb + q; kc2[kb][ks] = lds0 + NA_KOFF + key * 128 + (((4 * ks + g) ^ (key & 7)) << 4); }
            { const int qq = (lane & 15) >> 2, p = lane & 3; const int key = 4 * g + qq;
#pragma unroll
              for (int db = 0; db < 4; ++db) va[db] = lds0 + NA_VOFF + key * 128 + ((db ^ ((key >> 1) & 3)) << 5) + 8 * p; }
            __syncthreads();
#pragma unroll 2
            for (int i = 0; i < 8; ++i) {
                f32x4 s0 = {0.f, 0.f, 0.f, 0.f}, s1 = s0;
                NA_STEP(s0, s1, kc2[0][0] + 4096 * i, kc2[0][1] + 4096 * i, kc2[1][0] + 4096 * i, kc2[1][1] + 4096 * i, 4096 * i);
            }
#undef NA_STEP
            l += __shfl_xor(l, 16); l += __shfl_xor(l, 32);
            const float rinv = 1.f / l;
            f16* op = O + ((size_t)b * SEQ + r * 64 + 16 * chunk + q) * DM + h * 64 + 4 * g;
#pragma unroll
            for (int db = 0; db < 4; ++db) { const f32x4 v = o[db] * rinv; u32x2 w; w.x = pkh(v[0], v[1]); w.y = pkh(v[2], v[3]); *(u32x2*)(op + 16 * db) = w; }
        }
    }
    __syncthreads();
}

struct Args { const float* in[26]; float* out; unsigned char* ws; int ph_lo, ph_hi; };
constexpr int NPHASE = 14;

__global__ void __launch_bounds__(NWAVES * 64, 2) fwd_kernel(Args args) {
    extern __shared__ __attribute__((aligned(16))) unsigned char lds[];
    Frame F;
    F.lds = (LAS unsigned char*)lds;
    F.G = gridDim.x; { const int bx = blockIdx.x; F.vcu = (F.G % 8 == 0) ? (bx % 8) * (F.G / 8) + bx / 8 : bx; }
    F.in = args.in;
    F.out = args.out; F.ws = args.ws;
    volatile LAS unsigned* MISC = (volatile LAS unsigned*)(F.lds + MISC_OFF);
    if (threadIdx.x < 64) MISC[threadIdx.x] = 0u;
    __syncthreads();
    unsigned* ctl = (unsigned*)(F.ws + WS_CTL);
    XcdBarrier bar; bar.bar = ctl + CW_BAR; bar.x = 0; bar.st = nullptr;
    const int lo = args.ph_lo, hi = args.ph_hi;
    if (hi - lo > 1) bar = xcd_barrier_post(ctl + CW_BAR, MISC + 8);
#define REFRESH() do { \
        { int z_ = 0; asm volatile("" : "+s"(z_)); F.in = args.in + z_; F.ws = args.ws + z_; F.out = args.out + z_; } \
        ws = F.ws; MOD = (const float*)(ws + WS_MOD); HC = (float*)(ws + WS_HC); SSQ = (float*)(ws + WS_SSQ); SHW = (const float*)(ws + WS_SHW); } while (0)
#ifndef PH_MASK
#define PH_MASK 0x3FFF
#endif
#define IN(k) (((PH_MASK >> (k)) & 1) && lo <= (k) && (k) < hi)
#define SEAM(k) do { if (lo <= (k) && (k) + 1 < hi) xcd_barrier(bar); } while (0)
    unsigned char* ws; const float* MOD; float* HC; float* SSQ; const float* SHW;
    LAS unsigned char* ring = F.lds;

    F.pacc = 0;
#ifdef PROBE_MASK
    unsigned long long probe_acc = 0;
#endif
    for (int ph = lo; ph < hi; ++ph) {
#ifdef PROBE_MASK
        const unsigned long long probe_t0 = __builtin_amdgcn_s_memrealtime();
#endif
        REFRESH();
        switch (ph) {
    case 0: if (!((PH_MASK >> 0) & 1)) break; { p0_prep(F); } break;
    case 1: if (!((PH_MASK >> 1) & 1)) break; { norm_phase(F, F.in[0], F.in[2], F.in[6], 0, 0, 1024, (f16*)(ws + WS_U), MALL); filt_gemm(F); shw_tasks(F); } break;
    case 2: if (!((PH_MASK >> 2) & 1)) break; {
        pg8::Gemm g{(const f16*)(ws + WS_U), (const f16*)(ws + WS_WIN), MLAT, 2048, 1024}; pg8::StaticOrder S; S.init(MLAT, 2048, F.G, (int)blockIdx.x);
        EpiCM E{(f16*)(ws + WS_PT), PT_LD};
        pg8::gemm_phase<EpiCM, pg8::StaticOrder, true>(ring, g, S, E);
        ctx_inproj(F);
    } break;
    case 3: if (!((PH_MASK >> 3) & 1)) break; { p3_fft(F); } break;
    case 4: if (!((PH_MASK >> 4) & 1)) break; { p4_transpose(F); } break;
    case 5: if (!((PH_MASK >> 5) & 1)) break; {
        pg8::Gemm g{(const f16*)(ws + WS_Y), (const f16*)(ws + WS_WOUT0), MLAT, 1024, 1024}; pg8::StaticOrder S; S.init(MLAT, 1024, F.G, (int)blockIdx.x);
        EpiResid<true> E{{F.in[0], F.in[2], F.out, HC, MOD + 2048, (f16*)(ws + WS_U2), F.in[7], MOD + 4096, SSQ}};
        pg8::gemm_phase<EpiResid<true>, pg8::StaticOrder, false>(ring, g, S, E);
        ctx_resid<true>(F, (const f16*)(ws + WS_Y), 1024, (const f16*)(ws + WS_WOUT0), E.P);
    } break;
    case 6: if (!((PH_MASK >> 6) & 1)) break; {
        pg8::Gemm g{(const f16*)(ws + WS_U2), (const f16*)(ws + WS_WGU0), MLAT, 2 * DFF, 1024}; pg8::StaticOrder S; S.init(MLAT, 2 * DFF, F.G, (int)blockIdx.x);
        EpiGU E{{(f16*)(ws + WS_ACT), SSQ, SHW}};
        pg8::gemm_phase<EpiGU, pg8::StaticOrder, false>(ring, g, S, E);
        ctx_gu(F, (const f16*)(ws + WS_U2), (const f16*)(ws + WS_WGU0), E.P);
    } break;
    case 7: if (!((PH_MASK >> 7) & 1)) break; {
        pg8::Gemm g{(const f16*)(ws + WS_ACT), (const f16*)(ws + WS_WD0), MLAT, 1024, DFF}; pg8::StaticOrder S; S.init(MLAT, 1024, F.G, (int)blockIdx.x);
        EpiResid<true> E{{F.out, HC, F.out, HC, MOD + 5120, (f16*)(ws + WS_U1), F.in[6] + 1024, MOD + 3 * 6144 + 1024, SSQ + MALL}};
        pg8::gemm_phase<EpiResid<true>, pg8::StaticOrder, false>(ring, g, S, E);
        ctx_resid<true>(F, (const f16*)(ws + WS_ACT), DFF, (const f16*)(ws + WS_WD0), E.P);
    } break;
    case 8: if (!((PH_MASK >> 8) & 1)) break; {
        pg8::Gemm g{(const f16*)(ws + WS_U1), (const f16*)(ws + WS_WQKV), MLAT, 3072, 1024}; pg8::StaticOrder S; S.init(MLAT, 3072, F.G, (int)blockIdx.x);
        EpiQKV E{{(f16*)(ws + WS_Q), (f16*)(ws + WS_KC), 0.125f * LOG2E, SSQ + MALL, SHW + 3 * 5632}};
        static_assert(WS_K - WS_Q == 32 * MiB && WS_V - WS_K == 32 * MiB && WS_VC - WS_KC == 1 * MiB, "EpiQKV strides");
        pg8::gemm_phase<EpiQKV, pg8::StaticOrder, false>(ring, g, S, E);
        ctx_kv(F, (const f16*)(ws + WS_U1), (const f16*)(ws + WS_WQKV), E.P);
    } break;
    case 9: if (!((PH_MASK >> 9) & 1)) break; { p11_na(F); } break;
    case 10: if (!((PH_MASK >> 10) & 1)) break; {
        pg8::Gemm g{(const f16*)(ws + WS_O), (const f16*)(ws + WS_WO1), MLAT, 1024, 1024}; pg8::StaticOrder S; S.init(MLAT, 1024, F.G, (int)blockIdx.x);
        EpiResid<true> E{{F.out, HC, F.out, HC, MOD + 3 * 6144 + 2048, (f16*)(ws + WS_U3), F.in[7] + 1024, MOD + 3 * 6144 + 4096, SSQ + 2 * MALL}};
        pg8::gemm_phase<EpiResid<true>, pg8::StaticOrder, false>(ring, g, S, E);
    } break;
    case 11: if (!((PH_MASK >> 11) & 1)) break; {
        pg8::Gemm g{(const f16*)(ws + WS_U3), (const f16*)(ws + WS_WGU1), MLAT, 2 * DFF, 1024}; pg8::StaticOrder S; S.init(MLAT, 2 * DFF, F.G, (int)blockIdx.x);
        EpiGU E{{(f16*)(ws + WS_ACT1), SSQ + 2 * MALL, SHW + 3 * 5632 + 3 * 3072}};
        pg8::gemm_phase<EpiGU, pg8::StaticOrder, false>(ring, g, S, E);
    } break;
    case 12: if (!((PH_MASK >> 12) & 1)) break; {
        pg8::Gemm g{(const f16*)(ws + WS_ACT1), (const f16*)(ws + WS_WD1), MLAT, 1024, DFF}; pg8::StaticOrder S; S.init(MLAT, 1024, F.G, (int)blockIdx.x);
        EpiResid<false> E{{F.out, HC, F.out, HC, MOD + 3 * 6144 + 5120, nullptr, nullptr, nullptr, nullptr}};
        pg8::gemm_phase<EpiResid<false>, pg8::StaticOrder, false>(ring, g, S, E);
    } break;
    case 13: if (!((PH_MASK >> 13) & 1)) break; { final_phase(F); } break;
        default: break;
        }
        if (ph + 1 < hi) xcd_barrier(bar);
#ifdef PROBE_MASK
        if ((PROBE_MASK >> ph) & 1) probe_acc += __builtin_amdgcn_s_memrealtime() - probe_t0;
#endif
    }
#ifdef PROBE_MASK
    if (blockIdx.x == 0) { const unsigned long long t0 = __builtin_amdgcn_s_memrealtime(); while (__builtin_amdgcn_s_memrealtime() - t0 < (unsigned long long)PROBE_AMP * (probe_acc + F.pacc)) __builtin_amdgcn_s_sleep(8); }
#endif
#undef IN
#undef SEAM
}

#ifdef DBG_STOP
__global__ void dbg_dump(const u16* src, float* out, size_t n, size_t nvalid) { for (size_t i = (size_t)blockIdx.x * blockDim.x + threadIdx.x; i < n; i += (size_t)gridDim.x * blockDim.x) out[i] = i < nvalid ? h2f(src[i]) : 0.f; }
__global__ void dbg_dump32(const float* src, float* out, size_t n, size_t nvalid) { for (size_t i = (size_t)blockIdx.x * blockDim.x + threadIdx.x; i < n; i += (size_t)gridDim.x * blockDim.x) out[i] = i < nvalid ? src[i] : 0.f; }
#endif
extern "C" void kernel_launch(void* const* d_in, const int* in_sizes, int n_in, void* d_out, int out_size, void* d_ws, size_t ws_size, hipStream_t stream) {
    static int grid = 0;
    if (grid == 0) {
        if (n_in != 26 || out_size != MLAT * DM || ws_size < WS_END) { fprintf(stderr, "kernel_launch: unexpected shapes (n_in %d out %d ws %zu)\n", n_in, out_size, ws_size); grid = -1; return; }
        int dev = 0, cus = 0;
        if (hipGetDevice(&dev) != hipSuccess || hipDeviceGetAttribute(&cus, hipDeviceAttributeMultiprocessorCount, dev) != hipSuccess) { grid = -1; return; }
        if (hipFuncSetAttribute((const void*)fwd_kernel, hipFuncAttributeMaxDynamicSharedMemorySize, LDS_BYTES) != hipSuccess) { fprintf(stderr, "kernel_launch: hipFuncSetAttribute failed\n"); grid = -1; return; }
        int per_cu = 0;
        if (hipOccupancyMaxActiveBlocksPerMultiprocessor(&per_cu, (const void*)fwd_kernel, NWAVES * 64, LDS_BYTES) != hipSuccess || per_cu < 1) fprintf(stderr, "kernel_launch: occupancy query reports %d\n", per_cu);
        (void)hipGetLastError();
        grid = cus;
    }
    if (grid < 0) return;
    (void)hipMemsetAsync((char*)d_ws + WS_CTL, 0, CTL_ZERO_BYTES, stream);
    Args a{};
    for (int i = 0; i < 26; ++i) a.in[i] = (const float*)d_in[i];
    a.out = (float*)d_out; a.ws = (unsigned char*)d_ws;
#ifdef DBG_STOP
    for (int p = 0; p <= DBG_STOP; ++p) { a.ph_lo = p; a.ph_hi = p + 1; hipLaunchKernelGGL(fwd_kernel, dim3(grid), dim3(NWAVES * 64), LDS_BYTES, stream, a); }
#if DBG_F32 == 2
#elif DBG_F32
    hipLaunchKernelGGL(dbg_dump32, dim3(2048), dim3(256), 0, stream, (const float*)((const char*)d_ws + DBG_OFF), (float*)d_out, (size_t)MLAT * DM, (size_t)DBG_N);
#else
    hipLaunchKernelGGL(dbg_dump, dim3(2048), dim3(256), 0, stream, (const u16*)((const char*)d_ws + DBG_OFF), (float*)d_out, (size_t)MLAT * DM, (size_t)DBG_N);
#endif
#elif MK_PER_PHASE
    for (int p = 0; p < NPHASE; ++p) { a.ph_lo = p; a.ph_hi = p + 1; hipLaunchKernelGGL(fwd_kernel, dim3(grid), dim3(NWAVES * 64), LDS_BYTES, stream, a); }
#else
    a.ph_lo = 0; a.ph_hi = NPHASE;
    hipLaunchKernelGGL(fwd_kernel, dim3(grid), dim3(NWAVES * 64), LDS_BYTES, stream, a);
#endif
}
```

```cpp
#include <hip/hip_runtime.h>
#include <cstdio>
#include <cstdint>

#ifndef MK_PER_PHASE
#define MK_PER_PHASE 0
#endif

#define LAS __attribute__((address_space(3)))
#define GAS __attribute__((address_space(1)))
typedef _Float16 f16;
typedef _Float16 f16x8 __attribute__((ext_vector_type(8)));
typedef _Float16 f16x4 __attribute__((ext_vector_type(4)));
typedef _Float16 f16x2 __attribute__((ext_vector_type(2)));
typedef float f32x4 __attribute__((ext_vector_type(4)));
typedef float f32x2 __attribute__((ext_vector_type(2)));
typedef unsigned u32x4 __attribute__((ext_vector_type(4)));
typedef unsigned u32x2 __attribute__((ext_vector_type(2)));
typedef unsigned short u16;

__device__ __forceinline__ unsigned pkh(float lo, float hi) { f16x2 v = {(f16)lo, (f16)hi}; return __builtin_bit_cast(unsigned, v); }
__device__ __forceinline__ float h2f(u16 b) { return (float)__builtin_bit_cast(f16, b); }

constexpr int DM = 1024, BATCH = 2, SEQ = 8192, CTXL = 256, DFF = 2816;
constexpr int MLAT = BATCH * SEQ;
constexpr int MCTX = BATCH * CTXL;
constexpr int MALL = MLAT + MCTX;
constexpr int NHEAD = 16, HD = 64;
constexpr int FILT_T = SEQ + CTXL;
constexpr float RMS_EPS = 1e-6f;
constexpr float LOG2E = 1.4426950408889634f;

typedef short v4i16_t __attribute__((ext_vector_type(4)));
__device__ __forceinline__ f16x4 lds_tr16(unsigned addr) { return __builtin_bit_cast(f16x4, __builtin_amdgcn_ds_read_tr16_b64_v4i16((LAS v4i16_t*)addr)); }
namespace pg8 {
constexpr int BM = 256, BK = 64, HALF = 128, HTB = HALF * BK * 2, STAGE_BYTES = 8 * HTB, NXCD = 8, WGM = 8;
__host__ __device__ __forceinline__ int lds_byte(int r, int c) { const int st = (r >> 4) * 2 + (c >> 5), rr = r & 15, cc = c & 31, ob = rr * 64 + cc * 2; return st * 1024 + (ob ^ (((ob >> 9) & 1) << 5)); }
__host__ __device__ __forceinline__ void stage_rc(int b, int& R, int& C) { const int st = b / 1024, sb = b % 1024, swz = sb ^ (((sb >> 9) & 1) << 5); R = (st >> 1) * 16 + swz / 64; C = (st & 1) * 32 + (swz % 64) / 2; }

struct Unit { int pm, pn; };
struct Gemm { const f16* A; const f16* Bt; int M, N, K; int lda = 0; };

struct StaticOrder {
    int nM, nN, nwg, G, c;
    __device__ void init(int M, int N, int G_, int c_) { nM = M / BM; nN = N / BM; nwg = nM * nN; G = G_; c = c_; }
    __device__ bool next(int i, Unit& u) const {
        const long L = (long)i * G + c; if (L >= nwg) return false;
        int wgid = (int)L; { const int q = nwg / NXCD, r = nwg % NXCD, xcd = wgid % NXCD, off = wgid / NXCD; wgid = (xcd < r ? xcd * (q + 1) : r * (q + 1) + (xcd - r) * q) + off; }
        const int nig = WGM * nN, gid = wgid / nig, fm = gid * WGM, gsz = (nM - fm) < WGM ? (nM - fm) : WGM;
        u.pm = fm + ((wgid % nig) % gsz); u.pn = (wgid % nig) / gsz; return true;
    }
};
struct QkvOrder {
    int G, c;
    __device__ bool next(int i, Unit& u) const {
        const long L = (long)i * G + c; if (L >= 784) return false;
        if (L >= 768) { const int r = (int)L - 768; u.pm = 64 + (r & 1); u.pn = 4 + (r >> 1); return true; }
        int wgid = (int)L; { const int q = 768 / NXCD, xcd = wgid % NXCD, off = wgid / NXCD; wgid = xcd * q + off; }
        const int nig = WGM * 12, gid = wgid / nig, fm = gid * WGM;
        u.pm = fm + ((wgid % nig) % WGM); u.pn = (wgid % nig) / WGM; return true;
    }
};

template <class Epi, class Sched, bool SWAP, bool ATR = false>
__device__ __forceinline__ void gemm_phase(LAS unsigned char* lds, const Gemm g, const Sched& S, const Epi& E) {
    int tid = threadIdx.x; asm volatile("" : "+v"(tid));
    const int wid = __builtin_amdgcn_readfirstlane(tid >> 6), lane = tid & 63, wr = wid >> 2, wc = wid & 3, fr = lane & 15, fq = lane >> 4;
    const int K = g.K, nt = K / BK;
    unsigned voffA[2];
#pragma unroll
    for (int i = 0; i < 2; ++i) { int R, C; stage_rc(tid * 16 + i * 8192, R, C); voffA[i] = (unsigned)(R * K + C) * 2u; }
    const size_t kstep = (size_t)(BK * 2);
    const size_t hstep = (size_t)HALF * K * 2;
    const size_t tstep = 2 * hstep;
    const size_t kstepA = ATR ? (size_t)BK * g.lda * 2 : kstep, hstepA = ATR ? (size_t)HALF * 2 : hstep, tstepA = 2 * hstepA;
    unsigned voffAT[2];
#pragma unroll
    for (int i = 0; i < 2; ++i) { const int pos = wid * 64 + lane + 512 * i, k = pos >> 4, u = pos & 15, mb = (u >> 1) ^ ((k & 3) | (((k >> 3) & 1) << 2));
        voffAT[i] = (unsigned)(k * g.lda + mb * 16 + (u & 1) * 8) * 2u; }
    unsigned tra[4];
    { const int qq = (lane & 15) >> 2, p = lane & 3, fl = qq | ((fq & 1) << 2);
#pragma unroll
      for (int m = 0; m < 4; ++m) tra[m] = (unsigned)(uintptr_t)lds + (unsigned)((8 * fq + qq) * 256 + 8 * p + (((wr * 4 + m) ^ fl) << 5)); }
    const unsigned ldsw = (unsigned)wid * 1024u;
    const int aoff = lds_byte(wr * 64 + fr, fq * 8), boff = lds_byte(wc * 32 + fr, fq * 8);
#define PG8_SA(b, h) (((b) * 2 + (h)) * HTB)
#define PG8_SB(b, h) ((4 + (b) * 2 + (h)) * HTB)
#define PG8_STAGE(bufoff, gbase) do { _Pragma("unroll") for (int _i = 0; _i < 2; ++_i) \
        __builtin_amdgcn_global_load_lds((const unsigned*)((const char*)(gbase) + voffA[_i]), (LAS unsigned*)(lds + (bufoff) + ldsw + _i * 8192), 16, 0, 0); } while (0)
#define PG8_STAGEA(bufoff, gbase) do { if (ATR) { _Pragma("unroll") for (int _i = 0; _i < 2; ++_i) \
        __builtin_amdgcn_global_load_lds((const unsigned*)((const char*)(gbase) + voffAT[_i]), (LAS unsigned*)(lds + (bufoff) + ldsw + _i * 8192), 16, 0, 0); } else PG8_STAGE(bufoff, gbase); } while (0)
#define PG8_LDA(dst, b, h) do { if (ATR) { _Pragma("unroll") for (int m = 0; m < 4; ++m) _Pragma("unroll") for (int k = 0; k < 2; ++k) { \
            const f16x4 v0_ = lds_tr16(tra[m] + PG8_SA(b, h) + k * 8192), v1_ = lds_tr16(tra[m] + PG8_SA(b, h) + k * 8192 + 1024); \
            dst[m][k] = (f16x8){v0_[0], v0_[1], v0_[2], v0_[3], v1_[0], v1_[1], v1_[2], v1_[3]}; } } \
        else { _Pragma("unroll") for (int m = 0; m < 4; ++m) _Pragma("unroll") for (int k = 0; k < 2; ++k) dst[m][k] = *(const LAS f16x8*)(lds + PG8_SA(b, h) + aoff + m * 2048 + k * 1024); } } while (0)
#define PG8_LDB(dst, b, h) do { _Pragma("unroll") for (int n = 0; n < 2; ++n) _Pragma("unroll") for (int k = 0; k < 2; ++k) dst[n][k] = *(const LAS f16x8*)(lds + PG8_SB(b, h) + boff + n * 2048 + k * 1024); } while (0)
#define PG8_MMA(ai, bj, At, Bt) do { __builtin_amdgcn_s_setprio(1); _Pragma("unroll") for (int m = 0; m < 4; ++m) _Pragma("unroll") for (int n = 0; n < 2; ++n) _Pragma("unroll") for (int k = 0; k < 2; ++k) \
        acc[ai][bj][m][n] = SWAP ? __builtin_amdgcn_mfma_f32_16x16x32_f16(At[m][k], Bt[n][k], acc[ai][bj][m][n], 0, 0, 0) \
                                 : __builtin_amdgcn_mfma_f32_16x16x32_f16(Bt[n][k], At[m][k], acc[ai][bj][m][n], 0, 0, 0); __builtin_amdgcn_s_setprio(0); } while (0)
#define PG8_WAIT_V(n) asm volatile("s_waitcnt vmcnt(" #n ")" ::: "memory")
#define PG8_WAIT_L(n) asm volatile("s_waitcnt lgkmcnt(" #n ")" ::: "memory")
#define PG8_BAR __builtin_amdgcn_s_barrier()
#define PG8_SCHED __builtin_amdgcn_sched_barrier(0)
    Unit cur, nxt; int ui = 0;
    if (!S.next(0, cur)) return;
    f32x4 acc[2][2][4][2];
#pragma unroll
    for (int a = 0; a < 2; ++a)
#pragma unroll
        for (int b = 0; b < 2; ++b)
#pragma unroll
            for (int m = 0; m < 4; ++m)
#pragma unroll
                for (int n = 0; n < 2; ++n) acc[a][b][m][n] = (f32x4){0.f, 0.f, 0.f, 0.f};
    f16x8 At[4][2], B0[2][2], B1[2][2];
    const char* cA = (const char*)g.A + (size_t)cur.pm * tstepA; const char* cB = (const char*)g.Bt + (size_t)cur.pn * tstep;
    PG8_STAGE(PG8_SB(0, 0), cB); PG8_STAGE(PG8_SB(0, 1), cB + hstep); PG8_STAGEA(PG8_SA(0, 0), cA); PG8_STAGEA(PG8_SA(0, 1), cA + hstepA);
    if (wr == 1) PG8_BAR;
    PG8_WAIT_V(2); PG8_BAR;
    PG8_STAGE(PG8_SB(1, 0), cB + kstep); PG8_STAGEA(PG8_SA(1, 0), cA + kstepA); PG8_STAGE(PG8_SB(1, 1), cB + hstep + kstep);
    PG8_WAIT_V(6); PG8_BAR;
    for (;;) {
        const bool has_next = S.next(ui + 1, nxt);
        const char* nA = has_next ? (const char*)g.A + (size_t)nxt.pm * tstepA : cA; const char* nB = has_next ? (const char*)g.Bt + (size_t)nxt.pn * tstep : cB;
        for (int t = 0; t < nt; t += 2) {
            const bool last = (t == nt - 2);
            const char* a1 = cA + (size_t)(t + 1) * kstepA;
            const char* a2 = last ? nA : cA + (size_t)(t + 2) * kstepA; const char* b2 = last ? nB : cB + (size_t)(t + 2) * kstep;
            const char* a3 = a2 + kstepA; const char* b3 = b2 + kstep;
            PG8_LDB(B0, 0, 0); PG8_LDB(B1, 0, 1); PG8_SCHED; PG8_LDA(At, 0, 0); PG8_STAGEA(PG8_SA(1, 1), a1 + hstepA);
            PG8_WAIT_V(8); PG8_WAIT_L(0); PG8_BAR; PG8_MMA(0, 0, At, B0); PG8_MMA(0, 1, At, B1); PG8_BAR; PG8_SCHED;
            PG8_LDA(At, 0, 1); PG8_STAGE(PG8_SB(0, 0), b2); PG8_STAGE(PG8_SB(0, 1), b2 + hstep); PG8_STAGEA(PG8_SA(0, 0), a2);
            PG8_WAIT_V(8); PG8_WAIT_L(0); PG8_BAR; PG8_MMA(1, 0, At, B0); PG8_MMA(1, 1, At, B1); PG8_BAR; PG8_SCHED;
            PG8_LDB(B0, 1, 0); PG8_LDB(B1, 1, 1); PG8_SCHED; PG8_LDA(At, 1, 0); PG8_STAGEA(PG8_SA(0, 1), a2 + hstepA);
            PG8_WAIT_V(8); PG8_WAIT_L(0); PG8_BAR; PG8_MMA(0, 0, At, B0); PG8_MMA(0, 1, At, B1); PG8_BAR; PG8_SCHED;
            PG8_LDA(At, 1, 1); PG8_STAGE(PG8_SB(1, 0), b3); PG8_STAGE(PG8_SB(1, 1), b3 + hstep); PG8_STAGEA(PG8_SA(1, 0), a3);
            PG8_WAIT_V(8); PG8_WAIT_L(0); PG8_BAR; PG8_MMA(1, 0, At, B0); PG8_MMA(1, 1, At, B1); PG8_BAR; PG8_SCHED;
        }
        if (wr == 0) PG8_BAR;
        E(acc, cur, wr, wc, fr, fq);
        if (!has_next) break;
#pragma unroll
        for (int a = 0; a < 2; ++a)
#pragma unroll
            for (int b = 0; b < 2; ++b)
#pragma unroll
                for (int m = 0; m < 4; ++m)
#pragma unroll
                    for (int n = 0; n < 2; ++n) acc[a][b][m][n] = (f32x4){0.f, 0.f, 0.f, 0.f};
        cur = nxt; cA = nA; cB = nB; ++ui;
        if (wr == 1) PG8_BAR;
    }
    PG8_WAIT_V(0);
    PG8_BAR;
#undef PG8_SA
#undef PG8_SB
#undef PG8_STAGE
#undef PG8_STAGEA
#undef PG8_LDA
#undef PG8_LDB
#undef PG8_MMA
#undef PG8_WAIT_V
#undef PG8_WAIT_L
#undef PG8_BAR
#undef PG8_SCHED
}
}

constexpr size_t MiB = 1u << 20;
constexpr size_t WS_CTL = 0, CTL_ZERO_BYTES = 512 * 1024;
constexpr size_t WS_SSQ = 65536;
constexpr size_t WS_SHW = 1 * MiB + 256 * 1024;
constexpr size_t WS_MOD  = 1 * MiB;
constexpr size_t WS_HID2 = 2 * MiB;
constexpr size_t WS_HC   = 5 * MiB;
constexpr size_t WS_WIN  = 8 * MiB;
constexpr size_t WS_WOUT0 = 12 * MiB;
constexpr size_t WS_WGU0 = 14 * MiB;
constexpr size_t WS_WD0  = 26 * MiB;
constexpr size_t WS_WGU1 = 32 * MiB;
constexpr size_t WS_WD1  = 44 * MiB;
constexpr size_t WS_WQKV = 50 * MiB;
constexpr size_t WS_WO1  = 56 * MiB;
constexpr size_t WS_PT   = 64 * MiB;
constexpr size_t WS_FILT = 130 * MiB;
constexpr size_t WS_U    = 163 * MiB;
constexpr size_t WS_HS   = 163 * MiB;
constexpr size_t WS_XS   = 228 * MiB;
constexpr size_t WS_Y    = 130 * MiB;
constexpr size_t WS_U2   = 196 * MiB;
constexpr size_t WS_ACT  = 100 * MiB;
constexpr size_t WS_U1   = 64 * MiB;
constexpr size_t WS_Q    = 100 * MiB;
constexpr size_t WS_K    = 132 * MiB;
constexpr size_t WS_V    = 164 * MiB;
constexpr size_t WS_KC   = 198 * MiB;
constexpr size_t WS_VC   = 199 * MiB;
constexpr size_t WS_O    = 64 * MiB;
constexpr size_t WS_U3   = 100 * MiB;
constexpr size_t WS_ACT1 = 132 * MiB;
constexpr size_t WS_END  = 256 * MiB;
constexpr int PT_LD = MALL;

constexpr int CW_BAR = 4096;

constexpr int LDS_BYTES = 163840;
constexpr int FFT_BYTES = 16384 * 33 / 32 * 8;
constexpr int SCR_OFF = FFT_BYTES;
constexpr int MISC_OFF = LDS_BYTES - 256;
constexpr int NWAVES = 8;

#define RLX_AGENT __ATOMIC_RELAXED, __HIP_MEMORY_SCOPE_AGENT
#define LDS_WAIT() asm volatile("s_waitcnt lgkmcnt(0)" ::: "memory")
#define VM_WAIT() asm volatile("s_waitcnt vmcnt(0)" ::: "memory")

#define XB_TMO      128
#define XB_XCNT(j)  (256  + 64 * (j))
#define XB_XSUB(j)  (1280 + 64 * (j))
#define XB_XGEN(j)  (2304 + 64 * (j))
#define XB_TOP      3328
#define XB_TOPGEN   3392
#define XCD_BAR_WORDS 3456
#define XB_SPIN_CAP (1u << 18)
__device__ __forceinline__ unsigned xb_ld(unsigned* p)              { return __hip_atomic_load(p, __ATOMIC_RELAXED, __HIP_MEMORY_SCOPE_AGENT); }
__device__ __forceinline__ unsigned xb_add(unsigned* p, unsigned v) { return __hip_atomic_fetch_add(p, v, __ATOMIC_RELAXED, __HIP_MEMORY_SCOPE_AGENT); }
__device__ __forceinline__ unsigned xb_xcc_id() { return (unsigned)__builtin_amdgcn_s_getreg((3 << 11) | 20) & 0xFu; }
#define XB_SPIN(cond, bar) do { unsigned _sp = 0; while (cond) { __builtin_amdgcn_s_sleep(1); \
    if ((++_sp & 255u) == 0u) { if (xb_ld(&(bar)[XB_TMO])) break; if (_sp > XB_SPIN_CAP) { atomicAdd(&(bar)[XB_TMO], 1u); break; } } } } while (0)
struct XcdBarrier { unsigned* bar; unsigned x; volatile LAS unsigned* st; };
__device__ __forceinline__ XcdBarrier xcd_barrier_post(unsigned* bar, volatile LAS unsigned* st) {
    XcdBarrier b; b.bar = bar; b.x = xb_xcc_id(); b.st = st;
    if (threadIdx.x == 0) (void)xb_add(&bar[XB_XCNT(b.x)], 1u);
    return b;
}
__device__ __forceinline__ void xcd_barrier_complete(unsigned* bar, unsigned x, unsigned& nloc, unsigned& nx) {
    const unsigned G = gridDim.x * gridDim.y * gridDim.z;
    unsigned sum, cnt, mine, sp = 0u;
    for (;;) {
        sum = 0u; cnt = 0u; mine = 0u;
#pragma unroll
        for (unsigned j = 0; j < 16; ++j) { const unsigned c = xb_ld(&bar[XB_XCNT(j)]); sum += c; cnt += (c > 0u) ? 1u : 0u; mine = (j == x) ? c : mine; }
        if (sum == G) break;
        __builtin_amdgcn_s_sleep(1);
        if ((++sp & 255u) == 0u) { if (xb_ld(&bar[XB_TMO])) break; if (sp > XB_SPIN_CAP) { atomicAdd(&bar[XB_TMO], 1u); break; } }
    }
    nloc = mine > 0u ? mine : 1u; nx = cnt > 0u ? cnt : 1u;
}
__device__ __forceinline__ void xcd_barrier(const XcdBarrier& b) {
    asm volatile("s_waitcnt vmcnt(0)" ::: "memory");
    __syncthreads();
    if (threadIdx.x == 0) {
        unsigned* bar = b.bar;
        __builtin_amdgcn_s_waitcnt(0);
        unsigned nloc = b.st[0], nx = b.st[1];
        if (nloc == 0u) { xcd_barrier_complete(bar, b.x, nloc, nx); b.st[0] = nloc; b.st[1] = nx; }
        const unsigned old = xb_add(&bar[XB_XSUB(b.x)], 1u);
        const unsigned gen = old / nloc;
        if (old + 1u == (gen + 1u) * nloc) {
            __builtin_amdgcn_fence(__ATOMIC_RELEASE, "agent");
            asm volatile("s_waitcnt vmcnt(0)" ::: "memory");
            const unsigned og = xb_add(&bar[XB_TOP], 1u);
            const unsigned tg = og / nx;
            if (og + 1u == (tg + 1u) * nx) xb_add(&bar[XB_TOPGEN], 1u);
            else XB_SPIN(xb_ld(&bar[XB_TOPGEN]) == tg, bar);
            __builtin_amdgcn_fence(__ATOMIC_ACQUIRE, "agent");
            xb_add(&bar[XB_XGEN(b.x)], 1u);
            asm volatile("s_waitcnt vmcnt(0)" ::: "memory");
        } else {
            XB_SPIN(xb_ld(&bar[XB_XGEN(b.x)]) == gen, bar);
            __builtin_amdgcn_fence(__ATOMIC_ACQUIRE, "agent");
            asm volatile("s_waitcnt vmcnt(0)" ::: "memory");
        }
    }
    __syncthreads();
}

struct Frame {
    LAS unsigned char* lds;
    int vcu, G;
    unsigned long long pacc;
    const float* const* in;
    float* out; unsigned char* ws;
};
#define LOCAL_IDS() int tid = threadIdx.x; asm volatile("" : "+v"(tid)); const int lane = tid & 63; const int wave = __builtin_amdgcn_readfirstlane(tid >> 6); (void)lane; (void)wave
__device__ __forceinline__ float wave_sum(float v) {
#pragma unroll
    for (int o = 1; o < 64; o <<= 1) v += __shfl_xor(v, o);
    return v;
}
__device__ __forceinline__ float silu_f(float x) { return x / (1.f + __expf(-x)); }
__device__ __forceinline__ float sin_rev(float r) { return __builtin_amdgcn_sinf(__builtin_amdgcn_fractf(r)); }
__device__ __forceinline__ float cos_rev(float r) { return __builtin_amdgcn_cosf(__builtin_amdgcn_fractf(r)); }
__device__ __forceinline__ float sin_rad(float x) { return sin_rev(x * 0.15915494309189535f); }

__device__ __forceinline__ void transpose_item(const float* W, int N, f16* WT, int ldt, int k0, int n0, int drow0, LAS float* scr, int lane) {
    { f32x4 v[8];
#pragma unroll
      for (int i = 0; i < 8; ++i) v[i] = *(const f32x4*)(W + (size_t)(k0 + 8 * i + (lane >> 3)) * N + n0 + 4 * (lane & 7));
#pragma unroll
      for (int i = 0; i < 8; ++i) { LAS float* d = scr + (8 * i + (lane >> 3)) * 33 + 4 * (lane & 7); d[0] = v[i][0]; d[1] = v[i][1]; d[2] = v[i][2]; d[3] = v[i][3]; } }
    LDS_WAIT(); asm volatile("" ::: "memory");
    const int c = lane & 7;
#pragma unroll
    for (int j = 0; j < 4; ++j) { const int n = (lane >> 3) + 8 * j; const LAS float* s = scr + (8 * c) * 33 + n;
        u32x4 o; o.x = pkh(s[0 * 33], s[1 * 33]); o.y = pkh(s[2 * 33], s[3 * 33]); o.z = pkh(s[4 * 33], s[5 * 33]); o.w = pkh(s[6 * 33], s[7 * 33]);
        *(u32x4*)(WT + (size_t)(drow0 + n0 + n) * ldt + k0 + 8 * c) = o; }
    LDS_WAIT(); asm volatile("" ::: "memory");
}
__device__ __forceinline__ void fold_item(const float* Win, f16* WT, int g, int k0, LAS float* scr, int lane) {
    LAS float* wrow = scr;
    LAS float* tcs = scr + 256;
#pragma unroll
    for (int i = 0; i < 4; ++i) { const int e = i * 64 + lane; wrow[e] = Win[(size_t)(k0 + (e >> 7)) * 2048 + 128 * g + (e & 127)]; }
    { const float r0 = (float)lane * (1.f / 128.f), r1 = (float)(lane + 64) * (1.f / 128.f);
      tcs[lane] = cos_rev(r0); tcs[lane + 64] = cos_rev(r1); tcs[128 + lane] = sin_rev(r0); tcs[128 + lane + 64] = sin_rev(r1); }
    LDS_WAIT(); asm volatile("" ::: "memory");
#pragma unroll
    for (int half = 0; half < 2; ++half) {
        const int mp = lane + 64 * half;
        const int m = (mp <= 64) ? mp : mp - 64; const int tb = (mp <= 64) ? 0 : 128;
        float a0 = 0.f, a1 = 0.f, b0 = 0.f, b1 = 0.f;
#pragma unroll 8
        for (int c = 0; c < 128; c += 2) { const float f0 = tcs[tb + ((m * c) & 127)], f1 = tcs[tb + ((m * (c + 1)) & 127)];
            a0 += wrow[c] * f0; a1 += wrow[128 + c] * f0; b0 += wrow[c + 1] * f1; b1 += wrow[128 + c + 1] * f1; }
        const float s = 1.f / 1024.f;
        *(unsigned*)(WT + (size_t)(128 * g + mp) * 1024 + k0) = pkh((a0 + b0) * s, (a1 + b1) * s);
    }
    LDS_WAIT(); asm volatile("" ::: "memory");
}
__device__ __forceinline__ void hid_rows(Frame& F, int gw, int NGW) {
    LOCAL_IDS();
    const float* w1 = F.in[15]; const float* b1 = F.in[16]; const float* fr = F.in[17]; const float* w2 = F.in[18]; const float* b2 = F.in[19];
    float* HID2 = (float*)(F.ws + WS_HID2);
    LAS float* wl = (LAS float*)F.lds;
    __syncthreads();
    for (int e = tid; e < 33 * 64; e += 512) wl[e] = w1[e];
    for (int e = tid; e < 64 * 64; e += 512) wl[33 * 64 + e] = w2[e];
    __syncthreads();
    const int j = lane;
    const float bb1 = b1[j], bb2 = b2[j], fq = fr[j];
    for (int t = gw; t < FILT_T; t += NGW) {
        const int L = t < SEQ ? SEQ : CTXL, tt = t < SEQ ? t : t - SEQ;
        float z = 0.f;
        if (j == 0) z = (float)tt / (float)(L - 1);
        else if (j < 33) { const int bnd = (j - 1) & 15; const float band = 1e-4f + (float)bnd * ((15.f - 1e-4f) / 15.f);
            const float rev = (float)tt * band / (float)L;
            z = (j <= 16) ? cos_rev(rev) : -sin_rev(rev); }
        float a1 = bb1;
#pragma unroll
        for (int i = 0; i < 33; ++i) a1 += __builtin_bit_cast(float, __builtin_amdgcn_readlane(__builtin_bit_cast(int, z), i)) * wl[i * 64 + j];
        const float h1 = sin_rad(fq * a1);
        float a2 = bb2;
#pragma unroll
        for (int i = 0; i < 64; ++i) a2 += __builtin_bit_cast(float, __builtin_amdgcn_readlane(__builtin_bit_cast(int, h1), i)) * wl[(33 + i) * 64 + j];
        HID2[(size_t)t * 64 + j] = sin_rad(fq * a2);
    }
    __syncthreads();
}
__device__ __forceinline__ void ada_items(Frame& F) {
    LOCAL_IDS();
    const float* c = F.in[1]; const float* cctx = F.in[3]; const float* aw = F.in[4]; const float* ab = F.in[5];
    float* MOD = (float*)(F.ws + WS_MOD);
    LAS float* sl = (LAS float*)F.lds;
    LAS float* red = (LAS float*)(F.lds + 16384);
    bool have = false;
    for (int it = F.vcu; it < 192; it += F.G) {
        if (!have) { for (int e = tid; e < 3072; e += 512) { const int r = e >> 10, k = e & 1023; const float v = r < 2 ? c[r * 1024 + k] : cctx[k]; sl[e] = silu_f(v); } have = true; __syncthreads(); }
        const int layer = it / 96, n0 = (it % 96) * 64;
        const int kq = tid >> 4, cq = tid & 15;
        f32x4 a0 = {0.f, 0.f, 0.f, 0.f}, a1 = a0, a2 = a0;
        const float* wp = aw + ((size_t)layer * 1024) * 6144 + n0 + 4 * cq;
#pragma unroll 4
        for (int kk = kq; kk < 1024; kk += 32) { const f32x4 w = *(const f32x4*)(wp + (size_t)kk * 6144);
            a0 += w * sl[kk]; a1 += w * sl[1024 + kk]; a2 += w * sl[2048 + kk]; }
#pragma unroll
        for (int e = 0; e < 4; ++e) { red[(kq * 3 + 0) * 64 + 4 * cq + e] = a0[e]; red[(kq * 3 + 1) * 64 + 4 * cq + e] = a1[e]; red[(kq * 3 + 2) * 64 + 4 * cq + e] = a2[e]; }
        __syncthreads();
        if (tid < 192) { const int r = tid >> 6, col = tid & 63; float s = ab[layer * 6144 + n0 + col];
            for (int q = 0; q < 32; ++q) s += red[(q * 3 + r) * 64 + col];
            MOD[(size_t)(layer * 3 + r) * 6144 + n0 + col] = s; }
        __syncthreads();
    }
}
__device__ __forceinline__ void p0_prep(Frame& F) {
    LOCAL_IDS();
    const int gw = F.vcu * NWAVES + wave, NGW = F.G * NWAVES;
    ada_items(F);
    __syncthreads();
    LAS float* scr = (LAS float*)(F.lds + wave * 16384);
    f16* Win_t = (f16*)(F.ws + WS_WIN);
    constexpr int I_WIN = 16 * 48, I_WOUT = 16 * 32, I_G = 16 * 88, I_D = 44 * 32, I_QKV = 16 * 96, I_O1 = 16 * 32;
    constexpr int NIT = I_WIN + I_WOUT + 4 * I_G + 2 * I_D + I_QKV + I_O1;
    for (int it = gw; it < NIT; it += NGW) {
        int r = it;
        if (r < I_WIN) { const int kb = r / 48, nb = r % 48; transpose_item(F.in[11], 2048, Win_t, 1024, 64 * kb, 512 + 32 * nb, 0, scr, lane); continue; } r -= I_WIN;
        if (r < I_WOUT) { const int kb = r / 32, nb = r % 32; transpose_item(F.in[12], 1024, (f16*)(F.ws + WS_WOUT0), 1024, 64 * kb, 32 * nb, 0, scr, lane); continue; } r -= I_WOUT;
        if (r < 4 * I_G) { const int which = r / I_G, rr = r % I_G, layer = which >> 1, up = which & 1; const int kb = rr / 88, nb = rr % 88, n0 = 32 * nb;
            const float* src = (up ? F.in[9] : F.in[8]) + (size_t)layer * 1024 * DFF;
            f16* dst = (f16*)(F.ws + (layer ? WS_WGU1 : WS_WGU0));
            const int drow0 = (n0 >> 7) * 256 + (up ? 128 : 0) + (n0 & 127) - n0;
            transpose_item(src, DFF, dst, 1024, 64 * kb, n0, drow0, scr, lane); continue; } r -= 4 * I_G;
        if (r < 2 * I_D) { const int layer = r / I_D, rr = r % I_D; const int kb = rr / 32, nb = rr % 32;
            transpose_item(F.in[10] + (size_t)layer * DFF * 1024, 1024, (f16*)(F.ws + (layer ? WS_WD1 : WS_WD0)), DFF, 64 * kb, 32 * nb, 0, scr, lane); continue; } r -= 2 * I_D;
        if (r < I_QKV) { const int kb = r / 96, nb = r % 96; transpose_item(F.in[22], 3072, (f16*)(F.ws + WS_WQKV), 1024, 64 * kb, 32 * nb, 0, scr, lane); continue; } r -= I_QKV;
        { const int kb = r / 32, nb = r % 32; transpose_item(F.in[23], 1024, (f16*)(F.ws + WS_WO1), 1024, 64 * kb, 32 * nb, 0, scr, lane); }
    }
    for (int it = gw; it < 2048; it += NGW) fold_item(F.in[11], Win_t, it >> 9, (it & 511) * 2, scr, lane);
    hid_rows(F, gw, NGW);
}

__device__ __forceinline__ void norm_mod_row(const float* xrow, const float* g, const float* sh, const float* sc, f16* orow, int lane) {
    const f32x4* xr = (const f32x4*)xrow + lane;
    f32x4 v[4]; float s = 0.f;
#pragma unroll
    for (int j = 0; j < 4; ++j) { v[j] = xr[64 * j]; s += (v[j].x * v[j].x + v[j].y * v[j].y) + (v[j].z * v[j].z + v[j].w * v[j].w); }
    const float rstd = 1.f / sqrtf(wave_sum(s) * (1.f / DM) + RMS_EPS);
    u32x2* o8 = (u32x2*)orow + lane;
#pragma unroll
    for (int j = 0; j < 4; ++j) { const f32x4 gg = ((const f32x4*)g)[lane + 64 * j], s1 = ((const f32x4*)sc)[lane + 64 * j], s0 = ((const f32x4*)sh)[lane + 64 * j];
        const f32x4 y = (v[j] * rstd) * gg * (s1 + 1.f) + s0;
        u32x2 w; w.x = pkh(y.x, y.y); w.y = pkh(y.z, y.w); o8[64 * j] = w; }
}
__device__ __forceinline__ void norm_phase(Frame& F, const float* hl, const float* hc, const float* g, int layer, int sh_off, int sc_off, f16* U, int nrows) {
    LOCAL_IDS();
    const int gw = F.vcu * NWAVES + wave, NGW = F.G * NWAVES;
    const float* MOD = (const float*)(F.ws + WS_MOD) + (size_t)layer * 3 * 6144;
    for (int m0 = gw; m0 < nrows; m0 += 2 * NGW) {
        const int m1 = m0 + NGW; const bool two = m1 < nrows;
        const float* s0 = m0 < MLAT ? hl + (size_t)m0 * DM : hc + (size_t)(m0 - MLAT) * DM;
        const float* s1 = two ? (m1 < MLAT ? hl + (size_t)m1 * DM : hc + (size_t)(m1 - MLAT) * DM) : s0;
        const f32x4* x0 = (const f32x4*)s0 + lane; const f32x4* x1 = (const f32x4*)s1 + lane;
        f32x4 v0[4], v1[4]; float q0 = 0.f, q1 = 0.f;
#pragma unroll
        for (int j = 0; j < 4; ++j) { v0[j] = x0[64 * j]; v1[j] = x1[64 * j]; }
#pragma unroll
        for (int j = 0; j < 4; ++j) { q0 += (v0[j].x * v0[j].x + v0[j].y * v0[j].y) + (v0[j].z * v0[j].z + v0[j].w * v0[j].w); q1 += (v1[j].x * v1[j].x + v1[j].y * v1[j].y) + (v1[j].z * v1[j].z + v1[j].w * v1[j].w); }
        const float rs0 = 1.f / sqrtf(wave_sum(q0) * (1.f / DM) + RMS_EPS), rs1 = 1.f / sqrtf(wave_sum(q1) * (1.f / DM) + RMS_EPS);
        const int r0 = m0 < MLAT ? (m0 >> 13) : 2, r1 = m1 < MLAT ? (m1 >> 13) : 2;
#pragma unroll
        for (int j = 0; j < 4; ++j) { const f32x4 gg = ((const f32x4*)g)[lane + 64 * j];
            { const f32x4 sc = ((const f32x4*)(MOD + r0 * 6144 + sc_off))[lane + 64 * j], sh = ((const f32x4*)(MOD + r0 * 6144 + sh_off))[lane + 64 * j];
              const f32x4 y = (v0[j] * rs0) * gg * (sc + 1.f) + sh; u32x2 w; w.x = pkh(y.x, y.y); w.y = pkh(y.z, y.w); ((u32x2*)(U + (size_t)m0 * DM))[lane + 64 * j] = w; }
            if (two) { const f32x4 sc = ((const f32x4*)(MOD + r1 * 6144 + sc_off))[lane + 64 * j], sh = ((const f32x4*)(MOD + r1 * 6144 + sh_off))[lane + 64 * j];
              const f32x4 y = (v1[j] * rs1) * gg * (sc + 1.f) + sh; u32x2 w; w.x = pkh(y.x, y.y); w.y = pkh(y.z, y.w); ((u32x2*)(U + (size_t)m1 * DM))[lane + 64 * j] = w; } }
    }
}
__device__ __forceinline__ void final_phase(Frame& F) {
    LOCAL_IDS();
    const int gw = F.vcu * NWAVES + wave, NGW = F.G * NWAVES;
    const float* g = F.in[25];
    for (int m = gw; m < MLAT; m += NGW) {
        f32x4* xr = (f32x4*)(F.out + (size_t)m * DM) + lane;
        f32x4 v[4]; float s = 0.f;
#pragma unroll
        for (int j = 0; j < 4; ++j) { v[j] = xr[64 * j]; s += (v[j].x * v[j].x + v[j].y * v[j].y) + (v[j].z * v[j].z + v[j].w * v[j].w); }
        const float rstd = 1.f / sqrtf(wave_sum(s) * (1.f / DM) + RMS_EPS);
#pragma unroll
        for (int j = 0; j < 4; ++j) xr[64 * j] = (v[j] * rstd) * ((const f32x4*)g)[lane + 64 * j];
    }
}

__device__ __forceinline__ void filt_gemm(Frame& F) {
    LOCAL_IDS();
    const int gw = F.vcu * NWAVES + wave, NGW = F.G * NWAVES;
    const float* HID2 = (const float*)(F.ws + WS_HID2); const float* w3 = F.in[20];
    f16* FILT = (f16*)(F.ws + WS_FILT);
    const int li = lane & 15, lg = lane >> 4;
    constexpr int NTB = FILT_T / 64;
    LAS u16* stg = (LAS u16*)(F.lds + wave * 4096);
    const int cb = gw & 127, ch0 = cb * 16;
    f16x8 bw[2];
#pragma unroll
    for (int ks = 0; ks < 2; ++ks)
#pragma unroll
        for (int j = 0; j < 8; ++j) bw[ks][j] = (f16)w3[(size_t)(32 * ks + 8 * lg + j) * 2048 + ch0 + li];
    const int c = (ch0 + li) & 511;
    const float mind = -3.0701134573253945f, maxd = -15.350567286626973f;
    const float delta = fabsf(mind + (float)c * ((maxd - mind) / 511.f));
    for (int tb = gw >> 7; tb < NTB; tb += NGW >> 7) {
        const int t0 = tb * 64;
#pragma unroll
        for (int s = 0; s < 4; ++s) {
            f32x4 acc = {0.f, 0.f, 0.f, 0.f};
            const f32x4* hp = (const f32x4*)(HID2 + (size_t)(t0 + 16 * s + li) * 64 + 8 * lg);
#pragma unroll
            for (int ks = 0; ks < 2; ++ks) { const f32x4 h0 = hp[8 * ks], h1 = hp[8 * ks + 1];
                f16x8 hi, lo;
#pragma unroll
                for (int e = 0; e < 4; ++e) { hi[e] = (f16)h0[e]; lo[e] = (f16)(h0[e] - (float)hi[e]); hi[4 + e] = (f16)h1[e]; lo[4 + e] = (f16)(h1[e] - (float)hi[4 + e]); }
                acc = __builtin_amdgcn_mfma_f32_16x16x32_f16(hi, bw[ks], acc, 0, 0, 0);
                acc = __builtin_amdgcn_mfma_f32_16x16x32_f16(lo, bw[ks], acc, 0, 0, 0); }
            const int tq = t0 + 16 * s + 4 * lg;
            float o[4];
#pragma unroll
            for (int e = 0; e < 4; ++e) { const int t = tq + e; const float t01 = t < SEQ ? (float)t * (1.f / (SEQ - 1)) : (float)(t - SEQ) * (1.f / (CTXL - 1)); o[e] = acc[e] * __expf(-t01 * delta); }
            u32x2 w; w.x = pkh(o[0], o[1]); w.y = pkh(o[2], o[3]);
            *(LAS u32x2*)(stg + li * 72 + 16 * s + 4 * lg) = w;
        }
        LDS_WAIT(); asm volatile("" ::: "memory");
#pragma unroll
        for (int i = 0; i < 2; ++i) { const int chl = (lane >> 3) + 8 * i, seg = lane & 7;
            const u32x4 v = *(const LAS u32x4*)(stg + chl * 72 + 8 * seg);
            *(u32x4*)(FILT + (size_t)(ch0 + chl) * FILT_T + t0 + 8 * seg) = v; }
        LDS_WAIT(); asm volatile("" ::: "memory");
    }
}

__device__ __forceinline__ void shw_tasks(Frame& F) {
    LOCAL_IDS();
    const int gw = F.vcu * NWAVES + wave, NGW = F.G * NWAVES;
    const float* MOD = (const float*)(F.ws + WS_MOD); float* SHW = (float*)(F.ws + WS_SHW);
    for (int n = gw; n < 5632 + 3072 + 5632; n += NGW) {
        const f16* wrow; const float* sh; float* dst; int N;
        if (n < 5632) { wrow = (const f16*)(F.ws + WS_WGU0) + (size_t)n * 1024; sh = MOD + 3072; dst = SHW + n; N = 5632; }
        else if (n < 5632 + 3072) { const int j = n - 5632; wrow = (const f16*)(F.ws + WS_WQKV) + (size_t)j * 1024; sh = MOD + 3 * 6144; dst = SHW + 3 * 5632 + j; N = 3072; }
        else { const int j = n - 5632 - 3072; wrow = (const f16*)(F.ws + WS_WGU1) + (size_t)j * 1024; sh = MOD + 3 * 6144 + 3072; dst = SHW + 3 * 5632 + 3 * 3072 + j; N = 5632; }
        const f16x8 w0 = *(const f16x8*)(wrow + 16 * lane), w1 = *(const f16x8*)(wrow + 16 * lane + 8);
        float a[3];
#pragma unroll
        for (int r = 0; r < 3; ++r) { const float* sp = sh + r * 6144 + 16 * lane; float acc = 0.f;
#pragma unroll
            for (int e = 0; e < 8; ++e) acc += sp[e] * (float)w0[e] + sp[8 + e] * (float)w1[e];
            a[r] = wave_sum(acc); }
        if (lane == 0) { dst[0] = a[0]; dst[N] = a[1]; dst[2 * N] = a[2]; }
    }
}

__device__ __forceinline__ void cm_frag(f16* T, int ld, int col, int row, const f32x4 v) { u32x2 w; w.x = pkh(v[0], v[1]); w.y = pkh(v[2], v[3]); *(u32x2*)(T + (size_t)col * ld + row) = w; }
struct ResidP { const float* baseL; const float* baseC; float* dstL; float* dstC; const float* gate; f16* An; const float* gamma; const float* scale; float* ssq; };
template <bool NEXT> __device__ __forceinline__ float resid_frag(const ResidP& P, int row, int col, const f32x4 acc) {
    const bool lat = row < MLAT; const int rmod = lat ? (row >> 13) : 2;
    const size_t ro = (lat ? (size_t)row : (size_t)(row - MLAT)) * DM + col;
    const f32x4 b = *(const f32x4*)((lat ? P.baseL : P.baseC) + ro), gg = *(const f32x4*)(P.gate + rmod * 6144 + col);
    const f32x4 hn = b + gg * acc;
    *(f32x4*)((lat ? P.dstL : P.dstC) + ro) = hn;
    if (!NEXT) return 0.f;
    const f32x4 ga = *(const f32x4*)(P.gamma + col), sc = *(const f32x4*)(P.scale + rmod * 6144 + col);
    const f32x4 a = hn * ga * (sc + 1.f);
    u32x2 w; w.x = pkh(a[0], a[1]); w.y = pkh(a[2], a[3]); *(u32x2*)(P.An + (size_t)row * DM + col) = w;
    return (hn[0] * hn[0] + hn[1] * hn[1]) + (hn[2] * hn[2] + hn[3] * hn[3]);
}
template <bool NEXT> struct EpiResid {
    ResidP P;
    __device__ __forceinline__ void operator()(const f32x4 (&acc)[2][2][4][2], const pg8::Unit& u, int wr, int wc, int fr, int fq) const {
#pragma unroll
        for (int ai = 0; ai < 2; ++ai)
#pragma unroll
            for (int m = 0; m < 4; ++m) { const int row = u.pm * 256 + ai * 128 + wr * 64 + m * 16 + fr;
                float sq = 0.f;
#pragma unroll
                for (int bj = 0; bj < 2; ++bj)
#pragma unroll
                    for (int n = 0; n < 2; ++n) sq += resid_frag<NEXT>(P, row, u.pn * 256 + bj * 128 + wc * 32 + n * 16 + 4 * fq, acc[ai][bj][m][n]);
                if (NEXT) { sq += __shfl_xor(sq, 16); sq += __shfl_xor(sq, 32); if (fq == 0) atomicAdd(P.ssq + row, sq); } }
    }
};
struct EpiCM {
    f16* T; int ld;
    __device__ __forceinline__ void operator()(const f32x4 (&acc)[2][2][4][2], const pg8::Unit& u, int wr, int wc, int fr, int fq) const {
#pragma unroll
        for (int ai = 0; ai < 2; ++ai)
#pragma unroll
            for (int m = 0; m < 4; ++m) { const int row = u.pm * 256 + ai * 128 + wr * 64 + m * 16 + 4 * fq;
#pragma unroll
                for (int bj = 0; bj < 2; ++bj)
#pragma unroll
                    for (int n = 0; n < 2; ++n) cm_frag(T, ld, u.pn * 256 + bj * 128 + wc * 32 + n * 16 + fr, row, acc[ai][bj][m][n]); }
    }
};
struct GuP { f16* ACT; const float* ssq; const float* shw; };
__device__ __forceinline__ void gu_frag(const GuP& P, int row, int hcol, int gcol, const f32x4 ga, const f32x4 ua, float rstd, int rmod) {
    const f32x4 g = ga * rstd + *(const f32x4*)(P.shw + rmod * 5632 + gcol), up = ua * rstd + *(const f32x4*)(P.shw + rmod * 5632 + gcol + 128);
    float o[4];
#pragma unroll
    for (int e = 0; e < 4; ++e) o[e] = g[e] * __builtin_amdgcn_rcpf(1.f + __builtin_amdgcn_exp2f(-LOG2E * g[e])) * up[e];
    u32x2 w; w.x = pkh(o[0], o[1]); w.y = pkh(o[2], o[3]); *(u32x2*)(P.ACT + (size_t)row * DFF + hcol) = w;
}
struct EpiGU {
    GuP P;
    __device__ __forceinline__ void operator()(const f32x4 (&acc)[2][2][4][2], const pg8::Unit& u, int wr, int wc, int fr, int fq) const {
#pragma unroll
        for (int ai = 0; ai < 2; ++ai)
#pragma unroll
            for (int m = 0; m < 4; ++m) { const int row = u.pm * 256 + ai * 128 + wr * 64 + m * 16 + fr;
                const int rmod = row < MLAT ? (row >> 13) : 2; const float rstd = 1.f / sqrtf(P.ssq[row] * (1.f / DM) + RMS_EPS);
#pragma unroll
                for (int n = 0; n < 2; ++n) gu_frag(P, row, u.pn * 128 + wc * 32 + n * 16 + 4 * fq, u.pn * 256 + wc * 32 + n * 16 + 4 * fq, acc[ai][0][m][n], acc[ai][1][m][n], rstd, rmod); }
    }
};
struct QkvP { f16* Q; f16* KC; float qscale; const float* ssq; const float* shw; };
__device__ __forceinline__ void qkv_frag(const QkvP& P, int row, int c, const f32x4 acc, float rstd) {
    const bool lat = row < MLAT; const int which = c >> 10, col = c & 1023, h = col >> 6, d = col & 63;
    const int b = lat ? (row >> 13) : ((row - MLAT) >> 8), t = lat ? (row & 8191) : ((row - MLAT) & 255), rmod = lat ? b : 2;
    f16* dst = lat ? P.Q + (size_t)which * (16u << 20) + (((size_t)(b * NHEAD + h) * SEQ + t) * HD + d)
                   : P.KC + (size_t)(which > 0 ? which - 1 : 0) * (512u << 10) + (((size_t)(b * NHEAD + h) * CTXL + t) * HD + d);
    const float sc = which == 0 ? P.qscale : 1.f;
    const f32x4 v = (acc * rstd + *(const f32x4*)(P.shw + rmod * 3072 + c)) * sc; u32x2 w; w.x = pkh(v[0], v[1]); w.y = pkh(v[2], v[3]); *(u32x2*)dst = w;
}
struct EpiQKV {
    QkvP P;
    __device__ __forceinline__ void operator()(const f32x4 (&acc)[2][2][4][2], const pg8::Unit& u, int wr, int wc, int fr, int fq) const {
#pragma unroll
        for (int ai = 0; ai < 2; ++ai)
#pragma unroll
            for (int m = 0; m < 4; ++m) { const int row = u.pm * 256 + ai * 128 + wr * 64 + m * 16 + fr;
                const float rstd = 1.f / sqrtf(P.ssq[row] * (1.f / DM) + RMS_EPS);
#pragma unroll
                for (int bj = 0; bj < 2; ++bj)
#pragma unroll
                    for (int n = 0; n < 2; ++n) qkv_frag(P, row, u.pn * 256 + bj * 128 + wc * 32 + n * 16 + 4 * fq, acc[ai][bj][m][n], rstd); }
    }
};

__device__ __forceinline__ unsigned ctx_slot(int r, int c) { return (unsigned)(r * 512 + (((c & 16) | ((c & 15) ^ (r & 15))) << 4)); }
template <bool SWAPT, bool AT = false> __device__ __forceinline__ void ctx_tile_mm(LAS unsigned char* lds, const f16* a0, const f16* blo, const f16* bhi, int K, int tid, int wr, int rb0, int rb1, int fr, int fq, f32x4& c0, f32x4& c1, int lda = 0) {
    c0 = (f32x4){0.f, 0.f, 0.f, 0.f}; c1 = c0;
    const int sr = tid >> 5, sc = tid & 31;
    u32x4 ra[4], rb[4];
    const int nch = K >> 8;
#define CTX_LD(kc) do { _Pragma("unroll") for (int i = 0; i < 4; ++i) { const int r = sr + 16 * i; \
        ra[i] = AT ? *(const u32x4*)(a0 + (size_t)((kc) * 256 + (tid >> 3) + 64 * i) * lda + 8 * (tid & 7)) : *(const u32x4*)(a0 + (size_t)r * K + (kc) * 256 + 8 * sc); \
        rb[i] = *(const u32x4*)((r < 32 ? blo + (size_t)r * K : bhi + (size_t)(r - 32) * K) + (kc) * 256 + 8 * sc); } } while (0)
#define CTX_ST(buf) do { _Pragma("unroll") for (int i = 0; i < 4; ++i) { const int r = sr + 16 * i; \
        if (AT) { const int kk = (tid >> 3) + 64 * i; _Pragma("unroll") for (int e = 0; e < 8; ++e) { const int m = 8 * (tid & 7) + e; \
            *(LAS u16*)(lds + (buf) * 65536 + ctx_slot(m, kk >> 3) + 2 * (kk & 7)) = (u16)((e & 1) ? (ra[i][e >> 1] >> 16) : (ra[i][e >> 1] & 0xffff)); } } \
        else *(LAS u32x4*)(lds + (buf) * 65536 + ctx_slot(r, sc)) = ra[i]; \
        *(LAS u32x4*)(lds + (buf) * 65536 + 32768 + ctx_slot(r, sc)) = rb[i]; } } while (0)
    __syncthreads();
    CTX_LD(0); CTX_ST(0);
    __syncthreads();
    for (int kc = 0; kc < nch; ++kc) {
        const int buf = kc & 1;
        if (kc + 1 < nch) CTX_LD(kc + 1);
#pragma unroll
        for (int j = 0; j < 8; ++j) {
            const f16x8 a = *(const LAS f16x8*)(lds + buf * 65536 + ctx_slot(16 * wr + fr, 4 * j + fq));
            const f16x8 b0 = *(const LAS f16x8*)(lds + buf * 65536 + 32768 + ctx_slot(rb0 + fr, 4 * j + fq));
            const f16x8 b1 = *(const LAS f16x8*)(lds + buf * 65536 + 32768 + ctx_slot(rb1 + fr, 4 * j + fq));
            if (SWAPT) { c0 = __builtin_amdgcn_mfma_f32_16x16x32_f16(a, b0, c0, 0, 0, 0); c1 = __builtin_amdgcn_mfma_f32_16x16x32_f16(a, b1, c1, 0, 0, 0); }
            else { c0 = __builtin_amdgcn_mfma_f32_16x16x32_f16(b0, a, c0, 0, 0, 0); c1 = __builtin_amdgcn_mfma_f32_16x16x32_f16(b1, a, c1, 0, 0, 0); }
        }
        if (kc + 1 < nch) { CTX_ST(buf ^ 1); }
        __syncthreads();
    }
#undef CTX_LD
#undef CTX_ST
}
#define CTX_TILE_SETUP(NT) LOCAL_IDS(); const int fr = lane & 15, fq = lane >> 4, wr = wave >> 1, wc = wave & 1; (void)fq; \
    for (int t = F.vcu; t < 8 * (NT); t += F.G) { const int tm = t / (NT), tn = t % (NT); const int row0 = MLAT + tm * 64, row = row0 + wr * 16;
__device__ __forceinline__ void ctx_inproj(Frame& F) {
    const f16* U = (const f16*)(F.ws + WS_U); const f16* W = (const f16*)(F.ws + WS_WIN); f16* PT = (f16*)(F.ws + WS_PT);
    CTX_TILE_SETUP(32)
        const int col = tn * 64 + wc * 32; f32x4 c0, c1;
        ctx_tile_mm<true>(F.lds, U + (size_t)row0 * DM, W + (size_t)(tn * 64) * DM, W + (size_t)(tn * 64 + 32) * DM, DM, tid, wr, wc * 32, wc * 32 + 16, fr, fq, c0, c1);
        cm_frag(PT, PT_LD, col + fr, row + 4 * fq, c0); cm_frag(PT, PT_LD, col + 16 + fr, row + 4 * fq, c1);
    }
}
template <bool NEXT, bool AT = false> __device__ __forceinline__ void ctx_resid(Frame& F, const f16* A, int K, const f16* W, const ResidP& P, int lda = 0) {
    CTX_TILE_SETUP(32)
        const int col = tn * 32 + wc * 16; f32x4 c0, c1;
        ctx_tile_mm<false, AT>(F.lds, AT ? A + row0 : A + (size_t)row0 * K, W + (size_t)(tn * 32) * K, W + (size_t)(tn * 32) * K, K, tid, wr, wc * 16, wc * 16, fr, fq, c0, c1, lda);
        float sq = resid_frag<NEXT>(P, row + fr, col + 4 * fq, c0);
        if (NEXT) { sq += __shfl_xor(sq, 16); sq += __shfl_xor(sq, 32); if (fq == 0) atomicAdd(P.ssq + row + fr, sq); }
    }
}
__device__ __forceinline__ void ctx_gu(Frame& F, const f16* A, const f16* W, const GuP& P) {
    const int nfull = 1408 - 5 * F.G; const bool split = (F.G == 256);
    if (split && (int)blockIdx.x < nfull) return;
    const int t_first = split ? (int)blockIdx.x - nfull : F.vcu, t_step = split ? F.G - nfull : F.G;
    LOCAL_IDS(); const int fr = lane & 15, fq = lane >> 4, wr = wave >> 1, wc = wave & 1;
    for (int t = t_first; t < 8 * 88; t += t_step) { const int tm = t / 88, tn = t % 88; const int row0 = MLAT + tm * 64, row = row0 + wr * 16;
        const int ht = tn * 32, gt = (ht >> 7) * 256 + (ht & 127); f32x4 c0, c1;
        ctx_tile_mm<false>(F.lds, A + (size_t)row0 * DM, W + (size_t)gt * DM, W + (size_t)(gt + 128) * DM, DM, tid, wr, wc * 16, 32 + wc * 16, fr, fq, c0, c1);
        const float rstd = 1.f / sqrtf(P.ssq[row + fr] * (1.f / DM) + RMS_EPS);
        gu_frag(P, row + fr, ht + wc * 16 + 4 * fq, gt + wc * 16 + 4 * fq, c0, c1, rstd, 2);
    }
}
__device__ __forceinline__ void ctx_kv(Frame& F, const f16* A, const f16* W, const QkvP& P) {
    CTX_TILE_SETUP(32)
        const int col = 1024 + tn * 64 + wc * 32; f32x4 c0, c1;
        ctx_tile_mm<false>(F.lds, A + (size_t)row0 * DM, W + (size_t)(1024 + tn * 64) * DM, W + (size_t)(1024 + tn * 64 + 32) * DM, DM, tid, wr, wc * 32, wc * 32 + 16, fr, fq, c0, c1);
        const float rstd = 1.f / sqrtf(P.ssq[row + fr] * (1.f / DM) + RMS_EPS);
        qkv_frag(P, row + fr, col + 4 * fq, c0, rstd); qkv_frag(P, row + fr, col + 16 + 4 * fq, c1, rstd);
    }
}

__device__ constexpr float C32T[16] = {1.f, 0.98078528040323f, 0.92387953251129f, 0.83146961230255f, 0.70710678118655f, 0.55557023301960f, 0.38268343236509f, 0.19509032201613f,
                                       0.f, -0.19509032201613f, -0.38268343236509f, -0.55557023301960f, -0.70710678118655f, -0.83146961230255f, -0.92387953251129f, -0.98078528040323f};
__device__ constexpr float S32T[16] = {0.f, 0.19509032201613f, 0.38268343236509f, 0.55557023301960f, 0.70710678118655f, 0.83146961230255f, 0.92387953251129f, 0.98078528040323f,
                                       1.f, 0.98078528040323f, 0.92387953251129f, 0.83146961230255f, 0.70710678118655f, 0.55557023301960f, 0.38268343236509f, 0.19509032201613f};
__device__ constexpr int BR5[32] = {0,16,8,24,4,20,12,28,2,18,10,26,6,22,14,30,1,17,9,25,5,21,13,29,3,19,11,27,7,23,15,31};
__device__ constexpr int BR4[16] = {0,8,4,12,2,10,6,14,1,9,5,13,3,11,7,15};
__device__ constexpr int BR3[8] = {0,4,2,6,1,5,3,7};
__device__ __forceinline__ constexpr int brev(int i, int bits) { return bits == 5 ? BR5[i] : (bits == 4 ? BR4[i] : BR3[i]); }
template <int R> __device__ __forceinline__ void dif_fwd(float (&re)[R], float (&im)[R]) {
    constexpr int LG = R == 32 ? 5 : (R == 16 ? 4 : (R == 8 ? 3 : (R == 4 ? 2 : 1)));
#pragma unroll
    for (int st = 0; st < LG; ++st) {
        const int m = R >> st, hm = m >> 1, ts = 32 / m;
#pragma unroll
        for (int b = 0; b < R; b += m)
#pragma unroll
            for (int j = 0; j < hm; ++j) {
                const int i0 = b + j, i1 = b + j + hm, tw = j * ts;
                const float ar = re[i0], ai = im[i0], cr = re[i1], ci = im[i1];
                re[i0] = ar + cr; im[i0] = ai + ci;
                const float dr = ar - cr, di = ai - ci;
                if (tw == 0) { re[i1] = dr; im[i1] = di; }
                else if (tw == 8) { re[i1] = di; im[i1] = -dr; }
                else { const float c = C32T[tw], s = S32T[tw]; re[i1] = dr * c + di * s; im[i1] = di * c - dr * s; }
            }
    }
}
template <int R> __device__ __forceinline__ void dit_inv(float (&re)[R], float (&im)[R]) {
    constexpr int LG = R == 32 ? 5 : (R == 16 ? 4 : (R == 8 ? 3 : (R == 4 ? 2 : 1)));
#pragma unroll
    for (int st = LG - 1; st >= 0; --st) {
        const int m = R >> st, hm = m >> 1, ts = 32 / m;
#pragma unroll
        for (int b = 0; b < R; b += m)
#pragma unroll
            for (int j = 0; j < hm; ++j) {
                const int i0 = b + j, i1 = b + j + hm, tw = j * ts;
                const float ar = re[i0], ai = im[i0], cr = re[i1], ci = im[i1];
                float tr, ti;
                if (tw == 0) { tr = cr; ti = ci; }
                else if (tw == 8) { tr = -ci; ti = cr; }
                else { const float c = C32T[tw], s = S32T[tw]; tr = cr * c - ci * s; ti = ci * c + cr * s; }
                re[i0] = ar + tr; im[i0] = ai + ti; re[i1] = ar - tr; im[i1] = ai - ti;
            }
    }
}
__device__ __forceinline__ int fpad(int i) { return i + (i >> 5); }
__device__ __forceinline__ void tw_fwd(float& x, float& y, float rev) { const float c = __builtin_amdgcn_cosf(rev), s = __builtin_amdgcn_sinf(rev); const float a = x * c + y * s, b = y * c - x * s; x = a; y = b; }
__device__ __forceinline__ void tw_inv(float& x, float& y, float rev) { const float c = __builtin_amdgcn_cosf(rev), s = __builtin_amdgcn_sinf(rev); const float a = x * c - y * s, b = y * c + x * s; x = a; y = b; }

template <int NB, bool REVP, bool FWD> __device__ __forceinline__ void tw_tree(float (&re)[1 << NB], float (&im)[1 << NB], float rev1, float rev0 = 0.f, bool has0 = false) {
    float wc[NB], ws[NB];
#pragma unroll
    for (int i = 0; i < NB; ++i) { const float r = __builtin_amdgcn_fractf(rev1 * (float)(1 << i)); wc[i] = __builtin_amdgcn_cosf(r); ws[i] = FWD ? -__builtin_amdgcn_sinf(r) : __builtin_amdgcn_sinf(r); }
    float c0 = 1.f, s0 = 0.f;
    if (has0) { const float r = __builtin_amdgcn_fractf(rev0); c0 = __builtin_amdgcn_cosf(r); s0 = FWD ? -__builtin_amdgcn_sinf(r) : __builtin_amdgcn_sinf(r); }
    float pc[NB + 1], ps[NB + 1];
    pc[0] = c0; ps[0] = s0;
#pragma unroll
    for (int p = 0; p < (1 << NB); ++p) {
#pragma unroll
        for (int lvl = 0; lvl < NB; ++lvl) {
            const int b = NB - 1 - lvl;
            if ((p & ((1 << b) - 1)) == 0) {
                const int kb = REVP ? (NB - 1 - b) : b;
                if ((p >> b) & 1) { pc[lvl + 1] = pc[lvl] * wc[kb] - ps[lvl] * ws[kb]; ps[lvl + 1] = pc[lvl] * ws[kb] + ps[lvl] * wc[kb]; }
                else { pc[lvl + 1] = pc[lvl]; ps[lvl + 1] = ps[lvl]; }
            }
        }
        if (p != 0 || has0) { const float x = re[p], y = im[p]; re[p] = x * pc[NB] - y * ps[NB]; im[p] = x * ps[NB] + y * pc[NB]; }
    }
}

__device__ __forceinline__ void fft_s2_fwd(LAS f32x2* buf, int tid) {
    asm volatile("" : "+v"(tid));
    const int kk = tid >> 5, n3 = tid & 31;
    LAS f32x2* pb = buf + fpad(kk * 1024 + n3);
    float re[32], im[32];
#pragma unroll
    for (int n2 = 0; n2 < 32; ++n2) { const f32x2 v = pb[33 * n2]; re[n2] = v.x; im[n2] = v.y; }
    dif_fwd<32>(re, im);
    tw_tree<5, true, true>(re, im, (float)n3 * (1.f / 1024.f));
#pragma unroll
    for (int p = 0; p < 32; ++p) pb[33 * brev(p, 5)] = (f32x2){re[p], im[p]};
}
__device__ __forceinline__ void fft_s2_inv(LAS f32x2* buf, int tid) {
    asm volatile("" : "+v"(tid));
    const int k1 = tid >> 5, n3 = tid & 31;
    LAS f32x2* pb = buf + fpad(k1 * 1024 + n3);
    float re[32], im[32];
#pragma unroll
    for (int p = 0; p < 32; ++p) { const f32x2 v = pb[33 * brev(p, 5)]; re[p] = v.x; im[p] = v.y; }
    dit_inv<32>(re, im);
    tw_tree<5, false, false>(re, im, (float)k1 * (1.f / 512.f), (float)(n3 * k1) * (1.f / 16384.f), true);
#pragma unroll
    for (int n2 = 0; n2 < 32; ++n2) pb[33 * n2] = (f32x2){re[n2], im[n2]};
}
__device__ __forceinline__ void fft_s3_conv(LAS f32x2* buf, int tid, const unsigned* H) {
    asm volatile("" : "+v"(tid));
    const int k2 = tid & 31;
    LAS f32x2* pb = buf + fpad((tid >> 5) * 1024 + k2 * 32);
    const unsigned* hp = H + tid;
    float re[32], im[32];
#pragma unroll
    for (int n3 = 0; n3 < 32; ++n3) { const f32x2 v = pb[n3]; re[n3] = v.x; im[n3] = v.y; }
    dif_fwd<32>(re, im);
#pragma unroll
    for (int p = 0; p < 32; ++p) { const f16x2 hh = __builtin_bit_cast(f16x2, hp[p * 512]); const float hx = (float)hh[0] * (1.f / 16384.f), hy = (float)hh[1] * (1.f / 16384.f);
        const float a = re[p] * hx - im[p] * hy, b = re[p] * hy + im[p] * hx; re[p] = a; im[p] = b; }
    dit_inv<32>(re, im);
    tw_tree<5, false, false>(re, im, (float)k2 * (1.f / 1024.f));
#pragma unroll
    for (int n3 = 0; n3 < 32; ++n3) pb[n3] = (f32x2){re[n3], im[n3]};
}

__device__ __forceinline__ void hyena_task(Frame& F, int c) {
    LAS f32x2* buf = (LAS f32x2*)F.lds;
    LAS float* scr = (LAS float*)(F.lds + SCR_OFF);
    int tid = threadIdx.x; asm volatile("" : "+v"(tid));
    const int lane = tid & 63, wave = __builtin_amdgcn_readfirstlane(tid >> 6);
    u16* PT = (u16*)(F.ws + WS_PT);
    const u16* FILT = (const u16*)(F.ws + WS_FILT);
    unsigned* HS = (unsigned*)(F.ws + WS_HS) + (size_t)blockIdx.x * 32768;
    unsigned* XS = (unsigned*)(F.ws + WS_XS) + (size_t)blockIdx.x * (32 * 512);
    const float* cw = F.in[13]; const float* cb = F.in[14]; const float* skip = F.in[21];
    {
        const u16* f1 = FILT + (size_t)(c) * FILT_T; const u16* f2 = FILT + (size_t)(512 + c) * FILT_T;
        const u16* b1 = FILT + (size_t)(1024 + c) * FILT_T; const u16* b2 = FILT + (size_t)(1536 + c) * FILT_T;
        float a1 = 0.f, a2 = 0.f;
        if (tid == 0) { a1 = fabsf(h2f(b1[0])); a2 = fabsf(h2f(b2[0])); }
#pragma unroll
        for (int jj = 0; jj < 2; ++jj) {
            __builtin_amdgcn_sched_barrier(0); int j = tid + 512 * jj; asm volatile("" : "+v"(j));
            float re[16], im[16];
#pragma unroll
            for (int n1 = 0; n1 < 16; ++n1) { const int n = n1 * 1024 + j;
                if (n1 < 8) { re[n1] = h2f(f1[n]); im[n1] = h2f(f2[n]); }
                else if (n == 8192) { re[n1] = 0.f; im[n1] = 0.f; }
                else { re[n1] = h2f(b1[16384 - n]); im[n1] = h2f(b2[16384 - n]); }
                a1 += fabsf(re[n1]); a2 += fabsf(im[n1]); }
            dif_fwd<16>(re, im);
#pragma unroll
            for (int p = 0; p < 1; ++p) tw_tree<4, true, true>(re, im, (float)j * (1.f / 16384.f));
#pragma unroll
        for (int p = 0; p < 16; ++p) (buf + fpad(j))[1056 * brev(p, 4)] = (f32x2){re[p], im[p]};
        }
        a1 = wave_sum(a1); a2 = wave_sum(a2);
        if (lane == 0) { scr[wave * 2] = a1; scr[wave * 2 + 1] = a2; }
        __syncthreads();
        float n1s = 0.f, n2s = 0.f;
#pragma unroll
        for (int w = 0; w < 8; ++w) { n1s += scr[2 * w]; n2s += scr[2 * w + 1]; }
        const float inv1 = 0.5f / n1s, inv2 = 0.5f / n2s;
        const float ska = skip[c], skb = skip[512 + c];
        fft_s2_fwd(buf, tid);
        __syncthreads();
        {
            const int k1 = tid >> 5, k2 = tid & 31;
            LAS f32x2* pb = buf + fpad(k1 * 1024 + k2 * 32);
            float re[32], im[32];
#pragma unroll
            for (int n3 = 0; n3 < 32; ++n3) { const f32x2 v = pb[n3]; re[n3] = v.x; im[n3] = v.y; }
            dif_fwd<32>(re, im);
#pragma unroll
            for (int p = 0; p < 32; ++p) pb[brev(p, 5)] = (f32x2){re[p], im[p]};
            __syncthreads();
            unsigned* hp = HS + tid;
#pragma unroll
            for (int p = 0; p < 32; ++p) {
                const int k = k1 + 16 * k2 + 512 * brev(p, 5), km = (16384 - k) & 16383;
                const f32x2 zm = buf[fpad((km & 15) * 1024 + ((km >> 4) & 31) * 32 + (km >> 9))];
                const float sr = re[p] + zm.x, si = im[p] - zm.y;
                const float dr = re[p] - zm.x, di = im[p] + zm.y;
                hp[p * 512] = pkh(sr * inv1 + ska, si * inv1);
                hp[16384 + p * 512] = pkh(di * inv2 + skb, -dr * inv2);
                if ((p & 3) == 3) __builtin_amdgcn_sched_barrier(0);
            }
        }
        __syncthreads();
    }
    unsigned vpk[16];
    {
        LAS u16* raw = (LAS u16*)F.lds;
#pragma unroll
        for (int w = 0; w < 3; ++w) {
            const u16* row = PT + (size_t)(512 + 512 * w + c) * PT_LD;
#pragma unroll
            for (int i = 0; i < 4; ++i) { const int e = (i * 512 + tid) * 8;
                *(LAS u32x4*)(raw + w * 16384 + e) = *(const u32x4*)(row + e); }
        }
        __syncthreads();
#pragma unroll
        for (int w = 0; w < 3; ++w) {
            const int ch = 512 * w + c;
            const float w0 = cw[ch], w1 = cw[1536 + ch], w2 = cw[3072 + ch], bias = cb[ch];
#pragma unroll
            for (int idx = 0; idx < 16; ++idx) { const int n = (idx & 7) * 1024 + tid + 512 * (idx >> 3);
                const LAS u16* p0 = raw + w * 16384 + n; const LAS u16* p1 = p0 + SEQ;
                const float a0 = n > 0 ? h2f(p0[-1]) : 0.f, a1 = h2f(p0[0]), a2 = n < SEQ - 1 ? h2f(p0[1]) : 0.f;
                const float c0 = n > 0 ? h2f(p1[-1]) : 0.f, c1 = h2f(p1[0]), c2 = n < SEQ - 1 ? h2f(p1[1]) : 0.f;
                const unsigned pk = pkh(w0 * a0 + w1 * a1 + w2 * a2 + bias, w0 * c0 + w1 * c1 + w2 * c2 + bias);
                if (w < 2) XS[(w * 16 + idx) * 512 + tid] = pk; else vpk[idx] = pk;
                if ((idx & 3) == 3) __builtin_amdgcn_sched_barrier(0); }
        }
        __syncthreads();
    }
#define XS_LD(w, idx, lo, hi) do { const f16x2 _v = __builtin_bit_cast(f16x2, XS[((w) * 16 + (idx)) * 512 + tid]); lo = (float)_v[0]; hi = (float)_v[1]; } while (0)
#pragma unroll
    for (int jj = 0; jj < 2; ++jj) {
        __builtin_amdgcn_sched_barrier(0); int j = tid + 512 * jj; asm volatile("" : "+v"(j));
        float re[16], im[16];
#pragma unroll
        for (int n1 = 0; n1 < 8; ++n1) { const f16x2 v = __builtin_bit_cast(f16x2, vpk[jj * 8 + n1]); re[n1] = (float)v[0]; im[n1] = (float)v[1]; }
#pragma unroll
        for (int n1 = 8; n1 < 16; ++n1) { re[n1] = 0.f; im[n1] = 0.f; }
        dif_fwd<16>(re, im);
#pragma unroll
        for (int p = 0; p < 1; ++p) tw_tree<4, true, true>(re, im, (float)j * (1.f / 16384.f));
#pragma unroll
        for (int p = 0; p < 16; ++p) (buf + fpad(j))[1056 * brev(p, 4)] = (f32x2){re[p], im[p]};
    }
    __syncthreads();
    fft_s2_fwd(buf, tid); __syncthreads();
    fft_s3_conv(buf, tid, HS); __syncthreads();
    fft_s2_inv(buf, tid); __syncthreads();
#pragma unroll
    for (int jj = 0; jj < 2; ++jj) {
        __builtin_amdgcn_sched_barrier(0); int j = tid + 512 * jj; asm volatile("" : "+v"(j));
        float re[16], im[16];
#pragma unroll
        for (int p = 0; p < 16; ++p) { const f32x2 v = (buf + fpad(j))[1056 * brev(p, 4)]; re[p] = v.x; im[p] = v.y; }
        dit_inv<16>(re, im);
#pragma unroll
        for (int n1 = 0; n1 < 8; ++n1) { float x0, x1; XS_LD(0, jj * 8 + n1, x0, x1); re[n1] *= x0; im[n1] *= x1; }
#pragma unroll
        for (int n1 = 8; n1 < 16; ++n1) { re[n1] = 0.f; im[n1] = 0.f; }
        dif_fwd<16>(re, im);
#pragma unroll
        for (int p = 0; p < 1; ++p) tw_tree<4, true, true>(re, im, (float)j * (1.f / 16384.f));
#pragma unroll
        for (int p = 0; p < 16; ++p) (buf + fpad(j))[1056 * brev(p, 4)] = (f32x2){re[p], im[p]};
    }
    __syncthreads();
    fft_s2_fwd(buf, tid); __syncthreads();
    fft_s3_conv(buf, tid, HS + 16384); __syncthreads();
    fft_s2_inv(buf, tid); __syncthreads();
    u16* yrow = PT + (size_t)(512 + c) * PT_LD;
#pragma unroll
    for (int jj = 0; jj < 2; ++jj) {
        __builtin_amdgcn_sched_barrier(0); int j = tid + 512 * jj; asm volatile("" : "+v"(j));
        float re[16], im[16];
#pragma unroll
        for (int p = 0; p < 16; ++p) { const f32x2 v = (buf + fpad(j))[1056 * brev(p, 4)]; re[p] = v.x; im[p] = v.y; }
        dit_inv<16>(re, im);
#pragma unroll
        for (int n1 = 0; n1 < 8; ++n1) { float x0, x1; XS_LD(1, jj * 8 + n1, x0, x1);
            yrow[n1 * 1024 + j] = __builtin_bit_cast(u16, (f16)(x0 * re[n1])); yrow[SEQ + n1 * 1024 + j] = __builtin_bit_cast(u16, (f16)(x1 * im[n1])); }
    }
#undef XS_LD
    __syncthreads();
}

__device__ __forceinline__ void fourier_task(Frame& F, int task) {
    LAS f32x2* buf = (LAS f32x2*)F.lds;
    int tid = threadIdx.x; asm volatile("" : "+v"(tid));
    const int b = task >> 7, g = (task >> 5) & 3, q = task & 31;
    u16* PT = (u16*)(F.ws + WS_PT);
    const int mA[2] = {q, q == 0 ? 32 : 64 - q};
    const size_t tok0 = (size_t)b * SEQ;
#pragma unroll
    for (int f = 0; f < 2; ++f) {
        const u16* rA = PT + (size_t)(128 * g + mA[f]) * PT_LD + tok0; const u16* rB = PT + (size_t)(128 * g + 64 + mA[f]) * PT_LD + tok0;
        const float sg = (f == 0 && q == 0) ? 1.f : -1.f;
#pragma unroll
        for (int jj = 0; jj < 2; ++jj) {
            __builtin_amdgcn_sched_barrier(0); int j = tid + 512 * jj; asm volatile("" : "+v"(j));
            float re[8], im[8];
#pragma unroll
            for (int n1 = 0; n1 < 8; ++n1) { re[n1] = h2f(rA[n1 * 1024 + j]); im[n1] = sg * h2f(rB[n1 * 1024 + j]); }
            dif_fwd<8>(re, im);
#pragma unroll
            for (int p = 0; p < 1; ++p) tw_tree<3, true, true>(re, im, (float)j * (1.f / 8192.f));
#pragma unroll
            for (int p = 0; p < 8; ++p) (buf + fpad(j))[1056 * (f * 8 + brev(p, 3))] = (f32x2){re[p], im[p]};
        }
    }
    __syncthreads();
    fft_s2_fwd(buf, tid);
    __syncthreads();
    {
        const int kk = tid >> 5, k2 = tid & 31, f = kk >> 3, k1 = kk & 7;
        LAS f32x2* pb = buf + fpad(kk * 1024 + k2 * 32);
        float re[32], im[32];
#pragma unroll
        for (int n3 = 0; n3 < 32; ++n3) { const f32x2 v = pb[n3]; re[n3] = v.x; im[n3] = v.y; }
        dif_fwd<32>(re, im);
        __syncthreads();
        { LAS f32x2* pn = buf + fpad(f * 8192 + k1 + 8 * k2);
#pragma unroll
        for (int p = 0; p < 32; ++p) pn[264 * brev(p, 5)] = (f32x2){re[p], im[p]}; }
    }
    __syncthreads();
#pragma unroll
    for (int f = 0; f < 2; ++f) {
        const bool packed = (f == 0 && q == 0);
        const int m = mA[f];
        u16* o1 = PT + (size_t)(128 * g + (packed ? 0 : m)) * PT_LD + tok0;
        u16* o2 = PT + (size_t)(128 * g + (packed ? 64 : 128 - m)) * PT_LD + tok0;
        for (int l = tid; l < SEQ; l += 512) {
            const f32x2 a = buf[fpad(f * 8192 + l)], c = buf[fpad(f * 8192 + ((SEQ - l) & (SEQ - 1)))];
            const float y1 = packed ? 0.5f * (a.x + c.x) : a.x, y2 = packed ? 0.5f * (a.y + c.y) : c.x;
            o1[l] = __builtin_bit_cast(u16, (f16)y1); o2[l] = __builtin_bit_cast(u16, (f16)y2);
        }
    }
    __syncthreads();
}

__device__ __forceinline__ void fourier_ctx_task(Frame& F, int task) {
    LAS float* zr = (LAS float*)F.lds;
    LAS float* zi = zr + 512;
    LAS float* tc = zr + 1024;
    LAS float* ts = zr + 1280;
    LAS float* fr = zr + 1536;
    LAS float* fi = zr + 2048;
    int tid = threadIdx.x; asm volatile("" : "+v"(tid));
    const int f = tid >> 8, k = tid & 255;
    const int b = task >> 7, g = (task >> 5) & 3, q = task & 31;
    u16* PT = (u16*)(F.ws + WS_PT);
    const int m = f == 0 ? q : (q == 0 ? 32 : 64 - q);
    const bool packed = (f == 0 && q == 0);
    const size_t tok0 = (size_t)MLAT + (size_t)b * CTXL;
    const u16* rA = PT + (size_t)(128 * g + m) * PT_LD + tok0; const u16* rB = PT + (size_t)(128 * g + 64 + m) * PT_LD + tok0;
    zr[tid] = h2f(rA[k]); zi[tid] = (packed ? 1.f : -1.f) * h2f(rB[k]);
    if (tid < 256) { tc[tid] = cos_rev((float)tid * (1.f / 256.f)); ts[tid] = sin_rev((float)tid * (1.f / 256.f)); }
    __syncthreads();
    float ar = 0.f, ai = 0.f;
    for (int l = 0; l < 256; ++l) { const float x = zr[f * 256 + l], y = zi[f * 256 + l]; const int e = (k * l) & 255; const float c = tc[e], s = ts[e];
        ar += x * c + y * s; ai += y * c - x * s; }
    fr[tid] = ar; fi[tid] = ai;
    __syncthreads();
    const int km = f * 256 + ((256 - k) & 255);
    const float sc = 5.656854249492381f;
    const float y1 = packed ? 0.5f * (ar + fr[km]) : ar, y2 = packed ? 0.5f * (ai + fi[km]) : fr[km];
    u16* o1 = PT + (size_t)(128 * g + (packed ? 0 : m)) * PT_LD + tok0; u16* o2 = PT + (size_t)(128 * g + (packed ? 64 : 128 - m)) * PT_LD + tok0;
    o1[k] = __builtin_bit_cast(u16, (f16)(y1 * sc)); o2[k] = __builtin_bit_cast(u16, (f16)(y2 * sc));
    __syncthreads();
}
__device__ __forceinline__ void hyena_ctx_wave(Frame& F, int c, int b, int lane, LAS float* wl) {
    LAS float* hh = wl;
    LAS float* vv = wl + 1024;
    u16* PT = (u16*)(F.ws + WS_PT);
    const u16* FILT = (const u16*)(F.ws + WS_FILT);
    const float* cw = F.in[13]; const float* cb = F.in[14]; const float* skip = F.in[21];
    float n0 = 0.f, n1 = 0.f;
#pragma unroll
    for (int j = 0; j < 4; ++j) { const int t = lane + 64 * j;
        const float f0 = h2f(FILT[(size_t)(c) * FILT_T + SEQ + t]), f1 = h2f(FILT[(size_t)(512 + c) * FILT_T + SEQ + t]);
        const float g0 = h2f(FILT[(size_t)(1024 + c) * FILT_T + SEQ + t]), g1 = h2f(FILT[(size_t)(1536 + c) * FILT_T + SEQ + t]);
        hh[255 + t] = f0; hh[512 + 255 + t] = f1; if (t > 0) { hh[255 - t] = g0; hh[512 + 255 - t] = g1; }
        n0 += fabsf(f0) + fabsf(g0); n1 += fabsf(f1) + fabsf(g1); }
    if (lane == 0) { hh[511] = 0.f; hh[1023] = 0.f; }
    n0 = wave_sum(n0); n1 = wave_sum(n1);
    const float i0 = 1.f / n0, i1 = 1.f / n1;
    const size_t tokb = (size_t)MLAT + (size_t)b * CTXL;
    float x1[4], x2[4], v[4];
#pragma unroll
    for (int w = 0; w < 3; ++w) { const int ch = 512 * w + c; const u16* p = PT + (size_t)(512 + ch) * PT_LD + tokb + 4 * lane;
        const float w0 = cw[ch], w1 = cw[1536 + ch], w2 = cw[3072 + ch], bias = cb[ch];
        float a[6];
        a[0] = lane > 0 ? h2f(p[-1]) : 0.f; a[5] = lane < 63 ? h2f(p[4]) : 0.f;
#pragma unroll
        for (int j = 0; j < 4; ++j) a[1 + j] = h2f(p[j]);
#pragma unroll
        for (int j = 0; j < 4; ++j) { const float r = w0 * a[j] + w1 * a[j + 1] + w2 * a[j + 2] + bias; if (w == 0) x1[j] = r; else if (w == 1) x2[j] = r; else v[j] = r; } }
#pragma unroll
    for (int o = 0; o < 2; ++o) {
        *(LAS f32x4*)(vv + 4 * lane) = (f32x4){v[0], v[1], v[2], v[3]};
        LDS_WAIT(); asm volatile("" ::: "memory");
        float y0 = 0.f, y1 = 0.f, y2 = 0.f, y3 = 0.f;
        const LAS float* ho = hh + 512 * o + 255 + 4 * lane;
        float w0 = ho[0], w1 = ho[1], w2 = ho[2], w3 = ho[3];
#pragma unroll 8
        for (int s = 0; s < 256; ++s) { const float u = vv[s];
            y0 += u * w0; y1 += u * w1; y2 += u * w2; y3 += u * w3;
            w3 = w2; w2 = w1; w1 = w0; const int idx = 255 + 4 * lane - s - 1; w0 = idx >= 0 ? ho[-s - 1] : 0.f; }
        const float inv = o == 0 ? i0 : i1, sk = skip[o * 512 + c];
        v[0] = (o == 0 ? x1[0] : x2[0]) * (y0 * inv + sk * v[0]); v[1] = (o == 0 ? x1[1] : x2[1]) * (y1 * inv + sk * v[1]);
        v[2] = (o == 0 ? x1[2] : x2[2]) * (y2 * inv + sk * v[2]); v[3] = (o == 0 ? x1[3] : x2[3]) * (y3 * inv + sk * v[3]);
        LDS_WAIT(); asm volatile("" ::: "memory");
    }
    u32x2 w; w.x = pkh(v[0], v[1]); w.y = pkh(v[2], v[3]);
    *(u32x2*)(PT + (size_t)(512 + c) * PT_LD + tokb + 4 * lane) = w;
}
__device__ __forceinline__ void hyena_ctx_all(Frame& F) {
    LOCAL_IDS();
    if ((wave & 1) == 0) { LAS float* wl = (LAS float*)(F.lds + wave * 8192);
        for (int task = F.vcu + 256 * (wave >> 1); task < 1024; task += 4 * F.G) hyena_ctx_wave(F, task >> 1, task & 1, lane, wl); }
    __syncthreads();
}
#ifdef PROBE_P3
#define P3T(k, stmt) do { const unsigned long long t0_ = __builtin_amdgcn_s_memrealtime(); stmt; if (PROBE_P3 == (k)) F.pacc += __builtin_amdgcn_s_memrealtime() - t0_; } while (0)
#else
#define P3T(k, stmt) do { stmt; } while (0)
#endif
__device__ __forceinline__ void p3_fft(Frame& F) {
    P3T(1, for (int c = F.vcu; c < 512; c += F.G) hyena_task(F, c));
    P3T(2, for (int t = F.vcu; t < 256; t += F.G) fourier_task(F, t));
    P3T(3, for (int t = F.vcu; t < 256; t += F.G) fourier_ctx_task(F, t));
    P3T(4, hyena_ctx_all(F));
}

__device__ __forceinline__ void p4_transpose(Frame& F) {
    LOCAL_IDS();
    const int gw = F.vcu * NWAVES + wave, NGW = F.G * NWAVES;
    const u16* YT = (const u16*)(F.ws + WS_PT); u16* Y = (u16*)(F.ws + WS_Y);
    LAS u16* scr = (LAS u16*)(F.lds + wave * 16384);
    constexpr int NRB = MALL / 64;
    for (int it = gw; it < 16 * NRB; it += NGW) {
        const int cb = it / NRB, rb = it % NRB;
#pragma unroll
        for (int i = 0; i < 8; ++i) { const int ch = (lane >> 3) + 8 * i, seg = lane & 7;
            const u32x4 v = *(const u32x4*)(YT + (size_t)(cb * 64 + ch) * PT_LD + rb * 64 + 8 * seg);
            *(LAS u32x4*)(scr + ch * 72 + 8 * seg) = v; }
        LDS_WAIT(); asm volatile("" ::: "memory");
#pragma unroll
        for (int i = 0; i < 8; ++i) { const int tk = (lane >> 3) + 8 * i, seg = lane & 7;
            unsigned w[4];
#pragma unroll
            for (int e = 0; e < 4; ++e) { const unsigned lo = scr[(8 * seg + 2 * e) * 72 + tk], hi = scr[(8 * seg + 2 * e + 1) * 72 + tk]; w[e] = lo | (hi << 16); }
            *(u32x4*)(Y + (size_t)(rb * 64 + tk) * DM + cb * 64 + 8 * seg) = (u32x4){w[0], w[1], w[2], w[3]}; }
        LDS_WAIT(); asm volatile("" ::: "memory");
    }
}

constexpr int NA_KOFF = 0, NA_VOFF = 73728, NA_BIAS = 147456;
__device__ __forceinline__ f16x4 lds_tr(unsigned addr) { return __builtin_bit_cast(f16x4, __builtin_amdgcn_ds_read_tr16_b64_v4i16((LAS v4i16_t*)addr)); }
template <int NCH> __device__ __forceinline__ void na_ld(u32x4 (&r)[NCH], const f16* src, int nchunk, int tid) {
#pragma unroll
    for (int i = 0; i < NCH; ++i) { const int cidx = tid + 512 * i; const int cc = cidx < nchunk ? cidx : 0; r[i] = *(const u32x4*)(src + (size_t)cc * 8); }
}
template <int NCH, bool VSWZ> __device__ __forceinline__ void na_st(const u32x4 (&r)[NCH], unsigned ldsbase, int nchunk, int tid) {
#pragma unroll
    for (int i = 0; i < NCH; ++i) { const int cidx = tid + 512 * i; if (cidx < nchunk) { const int key = cidx >> 3, ch = cidx & 7;
        const int slot = VSWZ ? ((((ch >> 1) ^ ((key >> 1) & 3)) << 1) | (ch & 1)) : (ch ^ (key & 7));
        *(LAS u32x4*)(ldsbase + key * 128 + slot * 16) = r[i]; } }
}
__device__ __forceinline__ void p11_na(Frame& F) {
    LOCAL_IDS();
    const f16* Q = (const f16*)(F.ws + WS_Q); const f16* K = (const f16*)(F.ws + WS_K); const f16* V = (const f16*)(F.ws + WS_V);
    const f16* KC = (const f16*)(F.ws + WS_KC); const f16* VC = (const f16*)(F.ws + WS_VC); f16* O = (f16*)(F.ws + WS_O);
    const unsigned lds0 = (unsigned)(uintptr_t)F.lds;
    for (int it = F.vcu * 8; it < 2048; it += F.G * 8) {
        { const int h = (it >> 6) & 15; const float* src = F.in[24] + (size_t)h * 465; LAS float* tb = (LAS float*)(F.lds + NA_BIAS);
          __syncthreads();
          if (tid < 465) tb[tid] = src[tid] * LOG2E;
        }
        u32x4 kl[9];
        { const int bh = it >> 6, rp = it & 63, r0 = 2 * rp; const int rsA = r0 - 4 < 0 ? 0 : (r0 - 4 > 120 ? 120 : r0 - 4), rsB = r0 - 3 < 0 ? 0 : (r0 - 3 > 120 ? 120 : r0 - 3);
          const int nch = (8 + rsB - rsA) * 512;
          na_ld<9>(kl, K + ((size_t)bh * SEQ + rsA * 64) * HD, nch, tid); }
#pragma unroll 1
        for (int ii = 0; ii < 8; ++ii) {
            const int item = it + ii; if (item >= 2048) break;
            const int bh = item >> 6, rp = item & 63, b = bh >> 4, h = bh & 15;
            const int r0 = 2 * rp, r = r0 + (wave >> 2), chunk = wave & 3;
            const int rsA = r0 - 4 < 0 ? 0 : (r0 - 4 > 120 ? 120 : r0 - 4);
            const int rs = r - 4 < 0 ? 0 : (r - 4 > 120 ? 120 : r - 4);
            const int rsB = r0 + 1 - 4 < 0 ? 0 : (r0 + 1 - 4 > 120 ? 120 : r0 + 1 - 4);
            const int nrows = 8 + (rsB - rsA);
            __syncthreads();
            { u32x4 vl[9]; na_ld<9>(vl, V + ((size_t)bh * SEQ + rsA * 64) * HD, nrows * 512, tid);
              na_st<9, false>(kl, lds0 + NA_KOFF, nrows * 512, tid); na_st<9, true>(vl, lds0 + NA_VOFF, nrows * 512, tid); }
            asm volatile("" ::: "memory");
            u32x4 kc[4], vc[4];
            na_ld<4>(kc, KC + (size_t)bh * CTXL * HD, 2048, tid); na_ld<4>(vc, VC + (size_t)bh * CTXL * HD, 2048, tid);
            const int q = lane & 15, g = lane >> 4;
            const int kstart = chunk == 0 ? 0 : (chunk == 1 ? 8 : (chunk == 2 ? 24 : 32));
            const int off = chunk == 0 ? 15 : (chunk == 3 ? -1 : 7);
            const int ws = chunk == 0 ? (q > 8 ? q - 8 : 0) : (chunk == 3 ? (q + 8 < 16 ? q + 8 : 16) : q);
            const f16* Qp = Q + ((size_t)bh * SEQ + r * 64 + 16 * chunk + q) * HD + 8 * g;
            const f16x8 q0 = *(const f16x8*)Qp, q1 = *(const f16x8*)(Qp + 32);
            const int lr = rs - rsA;
            unsigned ka[2][2];
#pragma unroll
            for (int kb = 0; kb < 2; ++kb)
#pragma unroll
                for (int ks = 0; ks < 2; ++ks) { const int key = 64 * lr + kstart + 16 * kb + q; ka[kb][ks] = lds0 + NA_KOFF + key * 128 + (((4 * ks + g) ^ (key & 7)) << 4); }
            unsigned va[4];
            { const int qq = (lane & 15) >> 2, p = lane & 3; const int key = 64 * lr + kstart + 4 * g + qq;
#pragma unroll
              for (int db = 0; db < 4; ++db) va[db] = lds0 + NA_VOFF + key * 128 + ((db ^ ((key >> 1) & 3)) << 5) + 8 * p; }
            int bidx[2][4];
#pragma unroll
            for (int kb = 0; kb < 2; ++kb)
#pragma unroll
                for (int e = 0; e < 4; ++e) { const int kc_ = 16 * kb + 4 * g + e; const bool ok = kc_ >= ws && kc_ < ws + 16; const int dc = kc_ - q + off; bidx[kb][e] = ok ? ((rs - r + 7) * 31 + dc) : -1; }
            f32x4 o[4];
#pragma unroll
            for (int db = 0; db < 4; ++db) o[db] = (f32x4){0.f, 0.f, 0.f, 0.f};
            float m = -INFINITY, l = 0.f;
            const LAS float* rpb = (const LAS float*)(F.lds + NA_BIAS);
            __syncthreads();
#define NA_STEP(S0, S1, KA00, KA01, KA10, KA11, VOFF) do { \
                S0 = __builtin_amdgcn_mfma_f32_16x16x32_f16(*(const LAS f16x8*)(KA00), q0, S0, 0, 0, 0); \
                S0 = __builtin_amdgcn_mfma_f32_16x16x32_f16(*(const LAS f16x8*)(KA01), q1, S0, 0, 0, 0); \
                S1 = __builtin_amdgcn_mfma_f32_16x16x32_f16(*(const LAS f16x8*)(KA10), q0, S1, 0, 0, 0); \
                S1 = __builtin_amdgcn_mfma_f32_16x16x32_f16(*(const LAS f16x8*)(KA11), q1, S1, 0, 0, 0); \
                float mx_ = fmaxf(fmaxf(fmaxf(S0[0], S0[1]), fmaxf(S0[2], S0[3])), fmaxf(fmaxf(S1[0], S1[1]), fmaxf(S1[2], S1[3]))); \
                mx_ = fmaxf(mx_, __shfl_xor(mx_, 16)); mx_ = fmaxf(mx_, __shfl_xor(mx_, 32)); \
                const float mn_ = fmaxf(m, mx_); const float alpha_ = __builtin_amdgcn_exp2f(m - mn_); m = mn_; \
                f16x8 pf_; float ps_ = 0.f; \
                _Pragma("unroll") for (int e = 0; e < 4; ++e) { const float p0_ = __builtin_amdgcn_exp2f(S0[e] - mn_), p1_ = __builtin_amdgcn_exp2f(S1[e] - mn_); ps_ += p0_ + p1_; pf_[e] = (f16)p0_; pf_[4 + e] = (f16)p1_; } \
                l = l * alpha_ + ps_; \
                _Pragma("unroll") for (int db = 0; db < 4; ++db) { const f16x4 v0_ = lds_tr(va[db] + (VOFF)), v1_ = lds_tr(va[db] + (VOFF) + 2048); \
                    const f16x8 vv_ = {v0_[0], v0_[1], v0_[2], v0_[3], v1_[0], v1_[1], v1_[2], v1_[3]}; \
                    o[db] = __builtin_amdgcn_mfma_f32_16x16x32_f16(vv_, pf_, o[db] * alpha_, 0, 0, 0); } } while (0)
#pragma unroll 2
            for (int i = 0; i < 8; ++i) {
                f32x4 s0, s1;
#pragma unroll
                for (int e = 0; e < 4; ++e) { s0[e] = bidx[0][e] >= 0 ? rpb[bidx[0][e] + 31 * i] : -INFINITY; s1[e] = bidx[1][e] >= 0 ? rpb[bidx[1][e] + 31 * i] : -INFINITY; }
                NA_STEP(s0, s1, ka[0][0] + 8192 * i, ka[0][1] + 8192 * i, ka[1][0] + 8192 * i, ka[1][1] + 8192 * i, 8192 * i);
            }
            __syncthreads();
            na_st<4, false>(kc, lds0 + NA_KOFF, 2048, tid); na_st<4, true>(vc, lds0 + NA_VOFF, 2048, tid);
            asm volatile("" ::: "memory");
            if (ii + 1 < 8 && item + 1 < 2048) { const int it2 = item + 1, bh2 = it2 >> 6, rp2 = it2 & 63, r02 = 2 * rp2;
                const int rsA2 = r02 - 4 < 0 ? 0 : (r02 - 4 > 120 ? 120 : r02 - 4), rsB2 = r02 - 3 < 0 ? 0 : (r02 - 3 > 120 ? 120 : r02 - 3);
                const int nch2 = (8 + rsB2 - rsA2) * 512;
                na_ld<9>(kl, K + ((size_t)bh2 * SEQ + rsA2 * 64) * HD, nch2, tid); }
            unsigned kc2[2][2];
#pragma unroll
            for (int kb = 0; kb < 2; ++kb)
#pragma unroll
                for (int ks = 0; ks < 2; ++ks) { const int key = 16 * kb + q; kc2[kb][ks] = lds0 + NA_KOFF + key * 128 + (((4 * ks + g) ^ (key & 7)) << 4); }
            { const int qq = (lane & 15) >> 2, p = lane & 3; const int key = 4 * g + qq;
#pragma unroll
              for (int db = 0; db < 4; ++db) va[db] = lds0 + NA_VOFF + key * 128 + ((db ^ ((key >> 1) & 3)) << 5) + 8 * p; }
            __syncthreads();
#pragma unroll 2
            for (int i = 0; i < 8; ++i) {
                f32x4 s0 = {0.f, 0.f, 0.f, 0.f}, s1 = s0;
                NA_STEP(s0, s1, kc2[0][0] + 4096 * i, kc2[0][1] + 4096 * i, kc2[1][0] + 4096 * i, kc2[1][1] + 4096 * i, 4096 * i);
            }
#undef NA_STEP
            l += __shfl_xor(l, 16); l += __shfl_xor(l, 32);
            const float rinv = 1.f / l;
            f16* op = O + ((size_t)b * SEQ + r * 64 + 16 * chunk + q) * DM + h * 64 + 4 * g;
#pragma unroll
            for (int db = 0; db < 4; ++db) { const f32x4 v = o[db] * rinv; u32x2 w; w.x = pkh(v[0], v[1]); w.y = pkh(v[2], v[3]); *(u32x2*)(op + 16 * db) = w; }
        }
    }
    __syncthreads();
}

struct Args { const float* in[26]; float* out; unsigned char* ws; int ph_lo, ph_hi; };
constexpr int NPHASE = 13;

__global__ void __launch_bounds__(NWAVES * 64, 2) fwd_kernel(Args args) {
    extern __shared__ __attribute__((aligned(16))) unsigned char lds[];
    Frame F;
    F.lds = (LAS unsigned char*)lds;
    F.G = gridDim.x; { const int bx = blockIdx.x; F.vcu = (F.G % 8 == 0) ? (bx % 8) * (F.G / 8) + bx / 8 : bx; }
    F.in = args.in;
    F.out = args.out; F.ws = args.ws;
    volatile LAS unsigned* MISC = (volatile LAS unsigned*)(F.lds + MISC_OFF);
    if (threadIdx.x < 64) MISC[threadIdx.x] = 0u;
    __syncthreads();
    unsigned* ctl = (unsigned*)(F.ws + WS_CTL);
    XcdBarrier bar; bar.bar = ctl + CW_BAR; bar.x = 0; bar.st = nullptr;
    const int lo = args.ph_lo, hi = args.ph_hi;
    if (hi - lo > 1) bar = xcd_barrier_post(ctl + CW_BAR, MISC + 8);
#define REFRESH() do { \
        { int z_ = 0; asm volatile("" : "+s"(z_)); F.in = args.in + z_; F.ws = args.ws + z_; F.out = args.out + z_; } \
        ws = F.ws; MOD = (const float*)(ws + WS_MOD); HC = (float*)(ws + WS_HC); SSQ = (float*)(ws + WS_SSQ); SHW = (const float*)(ws + WS_SHW); } while (0)
#ifndef PH_MASK
#define PH_MASK 0x1FFF
#endif
#define IN(k) (((PH_MASK >> (k)) & 1) && lo <= (k) && (k) < hi)
#define SEAM(k) do { if (lo <= (k) && (k) + 1 < hi) xcd_barrier(bar); } while (0)
    unsigned char* ws; const float* MOD; float* HC; float* SSQ; const float* SHW;
    LAS unsigned char* ring = F.lds;

    F.pacc = 0;
#ifdef PROBE_MASK
    unsigned long long probe_acc = 0;
#endif
    for (int ph = lo; ph < hi; ++ph) {
#ifdef PROBE_MASK
        const unsigned long long probe_t0 = __builtin_amdgcn_s_memrealtime();
#endif
        REFRESH();
        switch (ph) {
    case 0: if (!((PH_MASK >> 0) & 1)) break; { p0_prep(F); } break;
    case 1: if (!((PH_MASK >> 1) & 1)) break; { norm_phase(F, F.in[0], F.in[2], F.in[6], 0, 0, 1024, (f16*)(ws + WS_U), MALL); filt_gemm(F); shw_tasks(F); } break;
    case 2: if (!((PH_MASK >> 2) & 1)) break; {
        pg8::Gemm g{(const f16*)(ws + WS_U), (const f16*)(ws + WS_WIN), MLAT, 2048, 1024}; pg8::StaticOrder S; S.init(MLAT, 2048, F.G, (int)blockIdx.x);
        EpiCM E{(f16*)(ws + WS_PT), PT_LD};
        pg8::gemm_phase<EpiCM, pg8::StaticOrder, true>(ring, g, S, E);
        ctx_inproj(F);
    } break;
    case 3: if (!((PH_MASK >> 3) & 1)) break; { p3_fft(F); } break;
    case 4: if (!((PH_MASK >> 4) & 1)) break; {
        pg8::Gemm g{(const f16*)(ws + WS_PT), (const f16*)(ws + WS_WOUT0), MLAT, 1024, 1024, PT_LD}; pg8::StaticOrder S; S.init(MLAT, 1024, F.G, (int)blockIdx.x);
        EpiResid<true> E{{F.in[0], F.in[2], F.out, HC, MOD + 2048, (f16*)(ws + WS_U2), F.in[7], MOD + 4096, SSQ}};
        pg8::gemm_phase<EpiResid<true>, pg8::StaticOrder, false, true>(ring, g, S, E);
        ctx_resid<true, true>(F, (const f16*)(ws + WS_PT), 1024, (const f16*)(ws + WS_WOUT0), E.P, PT_LD);
    } break;
    case 5: if (!((PH_MASK >> 5) & 1)) break; {
        pg8::Gemm g{(const f16*)(ws + WS_U2), (const f16*)(ws + WS_WGU0), MLAT, 2 * DFF, 1024}; pg8::StaticOrder S; S.init(MLAT, 2 * DFF, F.G, (int)blockIdx.x);
        EpiGU E{{(f16*)(ws + WS_ACT), SSQ, SHW}};
        pg8::gemm_phase<EpiGU, pg8::StaticOrder, false>(ring, g, S, E);
        ctx_gu(F, (const f16*)(ws + WS_U2), (const f16*)(ws + WS_WGU0), E.P);
    } break;
    case 6: if (!((PH_MASK >> 6) & 1)) break; {
        pg8::Gemm g{(const f16*)(ws + WS_ACT), (const f16*)(ws + WS_WD0), MLAT, 1024, DFF}; pg8::StaticOrder S; S.init(MLAT, 1024, F.G, (int)blockIdx.x);
        EpiResid<true> E{{F.out, HC, F.out, HC, MOD + 5120, (f16*)(ws + WS_U1), F.in[6] + 1024, MOD + 3 * 6144 + 1024, SSQ + MALL}};
        pg8::gemm_phase<EpiResid<true>, pg8::StaticOrder, false>(ring, g, S, E);
        ctx_resid<true>(F, (const f16*)(ws + WS_ACT), DFF, (const f16*)(ws + WS_WD0), E.P);
    } break;
    case 7: if (!((PH_MASK >> 7) & 1)) break; {
        pg8::Gemm g{(const f16*)(ws + WS_U1), (const f16*)(ws + WS_WQKV), MLAT, 3072, 1024}; pg8::StaticOrder S; S.init(MLAT, 3072, F.G, (int)blockIdx.x);
        EpiQKV E{{(f16*)(ws + WS_Q), (f16*)(ws + WS_KC), 0.125f * LOG2E, SSQ + MALL, SHW + 3 * 5632}};
        static_assert(WS_K - WS_Q == 32 * MiB && WS_V - WS_K == 32 * MiB && WS_VC - WS_KC == 1 * MiB, "EpiQKV strides");
        pg8::gemm_phase<EpiQKV, pg8::StaticOrder, false>(ring, g, S, E);
        ctx_kv(F, (const f16*)(ws + WS_U1), (const f16*)(ws + WS_WQKV), E.P);
    } break;
    case 8: if (!((PH_MASK >> 8) & 1)) break; { p11_na(F); } break;
    case 9: if (!((PH_MASK >> 9) & 1)) break; {
        pg8::Gemm g{(const f16*)(ws + WS_O), (const f16*)(ws + WS_WO1), MLAT, 1024, 1024}; pg8::StaticOrder S; S.init(MLAT, 1024, F.G, (int)blockIdx.x);
        EpiResid<true> E{{F.out, HC, F.out, HC, MOD + 3 * 6144 + 2048, (f16*)(ws + WS_U3), F.in[7] + 1024, MOD + 3 * 6144 + 4096, SSQ + 2 * MALL}};
        pg8::gemm_phase<EpiResid<true>, pg8::StaticOrder, false>(ring, g, S, E);
    } break;
    case 10: if (!((PH_MASK >> 10) & 1)) break; {
        pg8::Gemm g{(const f16*)(ws + WS_U3), (const f16*)(ws + WS_WGU1), MLAT, 2 * DFF, 1024}; pg8::StaticOrder S; S.init(MLAT, 2 * DFF, F.G, (int)blockIdx.x);
        EpiGU E{{(f16*)(ws + WS_ACT1), SSQ + 2 * MALL, SHW + 3 * 5632 + 3 * 3072}};
        pg8::gemm_phase<EpiGU, pg8::StaticOrder, false>(ring, g, S, E);
    } break;
    case 11: if (!((PH_MASK >> 11) & 1)) break; {
        pg8::Gemm g{(const f16*)(ws + WS_ACT1), (const f16*)(ws + WS_WD1), MLAT, 1024, DFF}; pg8::StaticOrder S; S.init(MLAT, 1024, F.G, (int)blockIdx.x);
        EpiResid<false> E{{F.out, HC, F.out, HC, MOD + 3 * 6144 + 5120, nullptr, nullptr, nullptr, nullptr}};
        pg8::gemm_phase<EpiResid<false>, pg8::StaticOrder, false>(ring, g, S, E);
    } break;
    case 12: if (!((PH_MASK >> 12) & 1)) break; { final_phase(F); } break;
        default: break;
        }
        if (ph + 1 < hi) xcd_barrier(bar);
#ifdef PROBE_MASK
        if ((PROBE_MASK >> ph) & 1) probe_acc += __builtin_amdgcn_s_memrealtime() - probe_t0;
#endif
    }
#ifdef PROBE_MASK
    if (blockIdx.x == 0) { const unsigned long long t0 = __builtin_amdgcn_s_memrealtime(); while (__builtin_amdgcn_s_memrealtime() - t0 < (unsigned long long)PROBE_AMP * (probe_acc + F.pacc)) __builtin_amdgcn_s_sleep(8); }
#endif
#undef IN
#undef SEAM
}

#ifdef DBG_STOP
__global__ void dbg_dump(const u16* src, float* out, size_t n, size_t nvalid) { for (size_t i = (size_t)blockIdx.x * blockDim.x + threadIdx.x; i < n; i += (size_t)gridDim.x * blockDim.x) out[i] = i < nvalid ? h2f(src[i]) : 0.f; }
__global__ void dbg_dump32(const float* src, float* out, size_t n, size_t nvalid) { for (size_t i = (size_t)blockIdx.x * blockDim.x + threadIdx.x; i < n; i += (size_t)gridDim.x * blockDim.x) out[i] = i < nvalid ? src[i] : 0.f; }
#endif
extern "C" void kernel_launch(void* const* d_in, const int* in_sizes, int n_in, void* d_out, int out_size, void* d_ws, size_t ws_size, hipStream_t stream) {
    static int grid = 0;
    if (grid == 0) {
        if (n_in != 26 || out_size != MLAT * DM || ws_size < WS_END) { fprintf(stderr, "kernel_launch: unexpected shapes (n_in %d out %d ws %zu)\n", n_in, out_size, ws_size); grid = -1; return; }
        int dev = 0, cus = 0;
        if (hipGetDevice(&dev) != hipSuccess || hipDeviceGetAttribute(&cus, hipDeviceAttributeMultiprocessorCount, dev) != hipSuccess) { grid = -1; return; }
        if (hipFuncSetAttribute((const void*)fwd_kernel, hipFuncAttributeMaxDynamicSharedMemorySize, LDS_BYTES) != hipSuccess) { fprintf(stderr, "kernel_launch: hipFuncSetAttribute failed\n"); grid = -1; return; }
        int per_cu = 0;
        if (hipOccupancyMaxActiveBlocksPerMultiprocessor(&per_cu, (const void*)fwd_kernel, NWAVES * 64, LDS_BYTES) != hipSuccess || per_cu < 1) fprintf(stderr, "kernel_launch: occupancy query reports %d\n", per_cu);
        (void)hipGetLastError();
        grid = cus;
    }
    if (grid < 0) return;
    (void)hipMemsetAsync((char*)d_ws + WS_CTL, 0, CTL_ZERO_BYTES, stream);
    Args a{};
    for (int i = 0; i < 26; ++i) a.in[i] = (const float*)d_in[i];
    a.out = (float*)d_out; a.ws = (unsigned char*)d_ws;
#ifdef DBG_STOP
    for (int p = 0; p <= DBG_STOP; ++p) { a.ph_lo = p; a.ph_hi = p + 1; hipLaunchKernelGGL(fwd_kernel, dim3(grid), dim3(NWAVES * 64), LDS_BYTES, stream, a); }
#if DBG_F32 == 2
#elif DBG_F32
    hipLaunchKernelGGL(dbg_dump32, dim3(2048), dim3(256), 0, stream, (const float*)((const char*)d_ws + DBG_OFF), (float*)d_out, (size_t)MLAT * DM, (size_t)DBG_N);
#else
    hipLaunchKernelGGL(dbg_dump, dim3(2048), dim3(256), 0, stream, (const u16*)((const char*)d_ws + DBG_OFF), (float*)d_out, (size_t)MLAT * DM, (size_t)DBG_N);
#endif
#elif MK_PER_PHASE
    for (int p = 0; p < NPHASE; ++p) { a.ph_lo = p; a.ph_hi = p + 1; hipLaunchKernelGGL(fwd_kernel, dim3(grid), dim3(NWAVES * 64), LDS_BYTES, stream, a); }
#else
    a.ph_lo = 0; a.ph_hi = NPHASE;
    hipLaunchKernelGGL(fwd_kernel, dim3(grid), dim3(NWAVES * 64), LDS_BYTES, stream, a);
#endif
}
```
